# Optimizing an MI355X kernel written in HIP

```python
import math
import jax, jax.numpy as jnp
from jax import lax
import numpy as np

D_MODEL = 2048
BATCH = 8
SEQ = 4096
DEPTH = 2
DEC_BATCH = 8
DEC_SEQ = 16
PAST_LEN = 1024

CHUNK = 64
Q_BLOCK = 128
N_A_LAYERS = DEPTH // 2
N_B_LAYERS = DEPTH - N_A_LAYERS
D_FF = 5632
RWKV_HEAD = 64
RWKV_HEADS = D_MODEL // RWKV_HEAD
DECAY_LORA = 96
ICLR_LORA = 96
GATE_LORA = 256
GN_EPS = 64e-5
DIFF_HEADS = 16
DIFF_DH = D_MODEL // DIFF_HEADS // 2
QK_DIM = 2 * DIFF_HEADS * DIFF_DH
V_DIM = DIFF_HEADS * 2 * DIFF_DH
KV_DIM = QK_DIM + V_DIM
LN_EPS = 1e-5
ALPHA = (2.0 * DEPTH) ** 0.25
BETA = (8.0 * DEPTH) ** -0.25

kernel_name = "rwkv7_diffattn_yoco_stream_step"


def layer_norm(x, g, b):
    xf = x.astype(jnp.float32)
    mu = jnp.mean(xf, -1, keepdims=True)
    var = jnp.mean(jnp.square(xf - mu), -1, keepdims=True)
    return ((xf - mu) * lax.rsqrt(var + LN_EPS) * g + b).astype(x.dtype)


def deepnorm(x, delta, g, b):
    return layer_norm(ALPHA * x + delta, g, b)


def swiglu(x, w_in, w_out):
    gate, up = jnp.split(x @ w_in, 2, axis=-1)
    return (jax.nn.silu(gate) * up) @ w_out


def rwkv7_time_mix(x, prev, s0, mu, w_rkv, w0, w1, w2, a0, a1, a2, g1, g2,
                   k_k, k_a, r_k, lnx_g, lnx_b, w_o):
    f32 = jnp.float32
    b, t, d = x.shape
    xx = prev - x
    mix = lambda j: x + xx * mu[j]
    heads = lambda z: z.reshape(b, t, RWKV_HEADS, RWKV_HEAD)
    r = heads(mix(0) @ w_rkv[0])
    w_log = -jax.nn.softplus(-(w0 + jnp.tanh(mix(1) @ w1) @ w2)) - 0.5
    k = mix(2) @ w_rkv[1]
    v = heads(mix(3) @ w_rkv[2])
    a = jax.nn.sigmoid(a0 + (mix(4) @ a1) @ a2)
    g = jax.nn.sigmoid(mix(5) @ g1) @ g2
    kk = heads(k * k_k).astype(f32)
    kk = kk * lax.rsqrt(jnp.maximum(jnp.sum(kk * kk, -1, keepdims=True), 1e-24))
    k = heads(k * (1.0 + (a - 1.0) * k_a))
    a = heads(a)
    decay = jnp.exp(-jnp.exp(heads(w_log).astype(f32)))

    def step(s, inp):
        r_t, d_t, k_t, v_t, kk_t, a_t = inp
        sa = jnp.einsum('bhvk,bhk->bhv', s, kk_t)
        s = (s * d_t[:, :, None, :]
             - sa[..., None] * (kk_t * a_t)[:, :, None, :]
             + v_t[..., None] * k_t[:, :, None, :])
        return s, jnp.einsum('bhvk,bhk->bhv', s, r_t)

    xs = tuple(jnp.swapaxes(z.astype(f32), 0, 1) for z in (r, decay, k, v, kk, a))
    s_final, y = lax.scan(step, s0.astype(f32), xs)
    y = jnp.swapaxes(y, 0, 1)
    y_mu = jnp.mean(y, -1, keepdims=True)
    y_var = jnp.mean(jnp.square(y - y_mu), -1, keepdims=True)
    y = ((y - y_mu) * lax.rsqrt(y_var + GN_EPS)).reshape(b, t, d) * lnx_g + lnx_b
    bonus = jnp.sum(r.astype(f32) * k.astype(f32) * r_k, -1, keepdims=True) * v.astype(f32)
    y = (y + bonus.reshape(b, t, d)) * g
    return y.astype(x.dtype) @ w_o, s_final.astype(s0.dtype)


def diff_lambda_full(lam, lambda_init):
    lam = lam.astype(jnp.float32)
    return jnp.exp(jnp.sum(lam[0] * lam[1])) - jnp.exp(jnp.sum(lam[2] * lam[3])) + lambda_init


def diff_attend(q, k, v, mask, lam_full, subln_g, lambda_init):
    b, tq = q.shape[:2]
    tk = k.shape[1]
    s = jnp.einsum('bqhd,bkhd->bhqk', q, k).astype(jnp.float32) * (DIFF_DH ** -0.5)
    if mask is not None:
        s = jnp.where(mask, s, -jnp.inf)
    p = jax.nn.softmax(s, axis=-1).reshape(b, DIFF_HEADS, 2, tq, tk)
    p = p[:, :, 0] - lam_full * p[:, :, 1]
    o = jnp.einsum('bhqk,bkhe->bqhe', p.astype(v.dtype), v).astype(jnp.float32)
    o = o * lax.rsqrt(jnp.mean(o * o, -1, keepdims=True) + LN_EPS) * subln_g * (1.0 - lambda_init)
    return o.reshape(b, tq, V_DIM).astype(q.dtype)


def diff_attn_prompt(q, k, v, lam_full, subln_g, lambda_init):
    b, t = q.shape[:2]
    nblk = t // Q_BLOCK
    q_blocks = jnp.swapaxes(q.reshape(b, nblk, Q_BLOCK, 2 * DIFF_HEADS, DIFF_DH), 0, 1)
    key_chunk = jnp.arange(t) // CHUNK

    def one_block(args):
        q_blk, blk = args
        q_chunk = (blk * Q_BLOCK + jnp.arange(Q_BLOCK)) // CHUNK
        mask = key_chunk[None, :] <= q_chunk[:, None]
        return diff_attend(q_blk, k, v, mask, lam_full, subln_g, lambda_init)

    out = lax.map(one_block, (q_blocks, jnp.arange(nblk)))
    return jnp.swapaxes(out, 0, 1).reshape(b, t, V_DIM)


def setup_inputs(seed: int = 0) -> dict:
    key = jax.random.key(seed)
    ks = iter(jax.random.split(key, 48))
    nrm = lambda shape, scale: scale * jax.random.normal(next(ks), shape, jnp.float32)
    D = D_MODEL
    nA, nB = N_A_LAYERS, N_B_LAYERS
    return {
        "x_prompt": nrm((BATCH, SEQ, D), 1.0),
        "x_sample": nrm((DEC_BATCH, DEC_SEQ, D), 1.0),
        "cache_k": nrm((DEC_BATCH, PAST_LEN, 2 * DIFF_HEADS, DIFF_DH), 1.0),
        "cache_v": nrm((DEC_BATCH, PAST_LEN, DIFF_HEADS, 2 * DIFF_DH), 1.0),
        "state_wkv": nrm((nA, DEC_BATCH, RWKV_HEADS, RWKV_HEAD, RWKV_HEAD), 0.5),
        "state_shift": nrm((nA, DEC_BATCH, D), 1.0),
        "ln_g": 1.0 + nrm((DEPTH, 3, D), 0.02),
        "ln_b": nrm((DEPTH, 3, D), 0.02),
        "ffn_w_in": nrm((DEPTH, 2, D, 2 * D_FF), D ** -0.5),
        "ffn_w_out": nrm((DEPTH, 2, D_FF, D), BETA * D_FF ** -0.5),
        "rwkv_mu": jax.random.uniform(next(ks), (nA, 6, D), jnp.float32),
        "rwkv_w_rkv": nrm((nA, 3, D, D), D ** -0.5),
        "rwkv_w0": -1.0 + nrm((nA, D), 1.0),
        "rwkv_w1": nrm((nA, D, DECAY_LORA), D ** -0.5),
        "rwkv_w2": nrm((nA, DECAY_LORA, D), 0.1 * DECAY_LORA ** -0.5),
        "rwkv_a0": nrm((nA, D), 0.1),
        "rwkv_a1": nrm((nA, D, ICLR_LORA), D ** -0.5),
        "rwkv_a2": nrm((nA, ICLR_LORA, D), 0.5 * ICLR_LORA ** -0.5),
        "rwkv_g1": nrm((nA, D, GATE_LORA), D ** -0.5),
        "rwkv_g2": nrm((nA, GATE_LORA, D), GATE_LORA ** -0.5),
        "rwkv_k_k": 0.85 + nrm((nA, D), 0.05),
        "rwkv_k_a": 1.0 + nrm((nA, D), 0.05),
        "rwkv_r_k": nrm((nA, RWKV_HEADS, RWKV_HEAD), 0.1),
        "rwkv_lnx_g": 1.0 + nrm((nA, D), 0.02),
        "rwkv_lnx_b": nrm((nA, D), 0.02),
        "rwkv_w_o": nrm((nA, D, D), BETA * D ** -0.5),
        "kv_w": nrm((D, KV_DIM), D ** -0.5),
        "diff_w_q": nrm((nB, D, QK_DIM), D ** -0.5),
        "diff_lambda": nrm((nB, 4, DIFF_DH), 0.1),
        "diff_subln_g": 1.0 + nrm((nB, 2 * DIFF_DH), 0.02),
        "diff_w_o": nrm((nB, V_DIM, D), BETA * V_DIM ** -0.5),
    }


def reference(x_prompt, x_sample, cache_k, cache_v, state_wkv, state_shift,
              ln_g, ln_b, ffn_w_in, ffn_w_out,
              rwkv_mu, rwkv_w_rkv, rwkv_w0, rwkv_w1, rwkv_w2, rwkv_a0, rwkv_a1, rwkv_a2,
              rwkv_g1, rwkv_g2, rwkv_k_k, rwkv_k_a, rwkv_r_k, rwkv_lnx_g, rwkv_lnx_b, rwkv_w_o,
              kv_w, diff_w_q, diff_lambda, diff_subln_g, diff_w_o):

    def trunk(x, past_k, past_v, wkv0, shift0):
        b, t, _ = x.shape
        new_wkv, new_shift = [], []
        k_sh = v_sh = None
        for i in range(DEPTH):
            x = deepnorm(x, 0.5 * swiglu(x, ffn_w_in[i, 0], ffn_w_out[i, 0]), ln_g[i, 0], ln_b[i, 0])
            if i < N_A_LAYERS:
                j = i
                prev = jnp.concatenate([shift0[j][:, None, :], x[:, :-1]], axis=1)
                h, s_new = rwkv7_time_mix(
                    x, prev, wkv0[j], rwkv_mu[j], rwkv_w_rkv[j], rwkv_w0[j], rwkv_w1[j], rwkv_w2[j],
                    rwkv_a0[j], rwkv_a1[j], rwkv_a2[j], rwkv_g1[j], rwkv_g2[j], rwkv_k_k[j],
                    rwkv_k_a[j], rwkv_r_k[j], rwkv_lnx_g[j], rwkv_lnx_b[j], rwkv_w_o[j])
                new_wkv.append(s_new)
                new_shift.append(x[:, -1])
            else:
                j = i - N_A_LAYERS
                lambda_init = 0.8 - 0.6 * math.exp(-0.3 * i)
                lam_full = diff_lambda_full(diff_lambda[j], lambda_init)
                q = (x @ diff_w_q[j]).reshape(b, t, 2 * DIFF_HEADS, DIFF_DH)
                if past_k is None:
                    o = diff_attn_prompt(q, k_sh, v_sh, lam_full, diff_subln_g[j], lambda_init)
                else:
                    keys = jnp.concatenate([past_k, k_sh], axis=1)
                    vals = jnp.concatenate([past_v, v_sh], axis=1)
                    o = diff_attend(q, keys, vals, None, lam_full, diff_subln_g[j], lambda_init)
                h = o @ diff_w_o[j]
            x = deepnorm(x, h, ln_g[i, 1], ln_b[i, 1])
            x = deepnorm(x, 0.5 * swiglu(x, ffn_w_in[i, 1], ffn_w_out[i, 1]), ln_g[i, 2], ln_b[i, 2])
            if i == N_A_LAYERS - 1:
                kv = x @ kv_w
                k_sh = kv[..., :QK_DIM].reshape(b, t, 2 * DIFF_HEADS, DIFF_DH)
                v_sh = kv[..., QK_DIM:].reshape(b, t, DIFF_HEADS, 2 * DIFF_DH)
        return x, k_sh, v_sh, jnp.stack(new_wkv), jnp.stack(new_shift)

    bp = x_prompt.shape[0]
    wkv_zero = jnp.zeros((N_A_LAYERS, bp, RWKV_HEADS, RWKV_HEAD, RWKV_HEAD), x_prompt.dtype)
    shift_zero = jnp.zeros((N_A_LAYERS, bp, D_MODEL), x_prompt.dtype)
    y_prompt, k_prompt, v_prompt, wkv_prompt, shift_prompt = trunk(
        x_prompt, None, None, wkv_zero, shift_zero)
    y_sample, k_sample, v_sample, wkv_sample, shift_sample = trunk(
        x_sample, cache_k, cache_v, state_wkv, state_shift)
    return (y_prompt, y_sample, k_prompt, v_prompt, wkv_prompt, shift_prompt,
            k_sample, v_sample, wkv_sample, shift_sample)
```

```cpp
#include <hip/hip_runtime.h>
#include <cstdio>
#include <cstdint>

#ifndef MK_SINGLE
#define MK_SINGLE 0
#endif

#define GAS __attribute__((address_space(1)))
#define LAS __attribute__((address_space(3)))
typedef unsigned short bf16;
typedef short bf16x8 __attribute__((ext_vector_type(8)));
typedef short s16x4 __attribute__((ext_vector_type(4)));
typedef float f32x2 __attribute__((ext_vector_type(2)));
typedef float f32x4 __attribute__((ext_vector_type(4)));
typedef float f32x16 __attribute__((ext_vector_type(16)));
typedef unsigned u32x2 __attribute__((ext_vector_type(2)));
typedef unsigned u32x4 __attribute__((ext_vector_type(4)));
typedef GAS unsigned gu32;

constexpr int DM = 2048, FF = 5632, T = 4096, NB = 8, TS = 16, PAST = 1024;
constexpr int RS = T + 1;
constexpr int SROW0 = NB * RS;
constexpr int SRS = TS + 1;
constexpr int NROWS = SROW0 + NB * SRS;
constexpr int MP = 33024;
constexpr int KVS = PAST + TS;
constexpr int KVROWS = NB * T + NB * KVS;
constexpr int NCAT = 6656, KCAT = 4096;
constexpr int NL2 = 6144, KL2 = 512;
constexpr float LN_EPS = 1e-5f, GN_EPS = 64e-5f;
constexpr float ALPHA = 1.41421356237f;
constexpr float LOG2E = 1.4426950408889634f;
constexpr float QSCALE = 0.125f * LOG2E;
constexpr float LAMBDA_INIT = 0.35550906f;

constexpr size_t MiB = 1u << 20;
constexpr size_t WS_CTL = 0, CTL_ZERO_BYTES = 1 * MiB;
constexpr size_t WS_WIN = 2 * MiB;
constexpr size_t WIN_STRIDE = (size_t)2 * FF * DM * 2;
constexpr size_t WS_WOUT = 178 * MiB;
constexpr size_t WOUT_STRIDE = (size_t)DM * FF * 2;
constexpr size_t WS_WCAT = 266 * MiB;
constexpr size_t WS_WL2 = 318 * MiB;
constexpr size_t WS_WOR = 324 * MiB, WS_WQ = 332 * MiB, WS_WOD = 340 * MiB, WS_WKV = 348 * MiB;
constexpr size_t WS_XF = 364 * MiB;
constexpr size_t WS_XBA = 623 * MiB;
constexpr size_t WS_XBB = 753 * MiB;
constexpr size_t WS_H = 883 * MiB;
constexpr size_t WS_END = 1240 * MiB;
constexpr size_t ACT_BYTES = (size_t)MP * DM * 2;
constexpr size_t WS_R = WS_H, WS_KR = WS_H + ACT_BYTES, WS_L = WS_H + 2 * ACT_BYTES;
constexpr size_t WS_KB = WS_H, WS_VB = WS_H + 161 * MiB;
constexpr size_t O_YP = 0, O_YS = 67108864, O_KP = 67371008, O_VP = 134479872, O_WKVP = 201588736, O_SHP = 202637312,
                 O_KS = 202653696, O_VS = 202915840, O_WKVS = 203177984, O_SHS = 204226560, O_TOTAL = 204242944;
constexpr size_t DO_Q = 0, DO_VV = 0, DO_WLD = ACT_BYTES, DO_AG = 2 * ACT_BYTES, DO_GG = 3 * ACT_BYTES;
static_assert(DO_GG + ACT_BYTES <= O_WKVP * 4, "d_out scratch overlays end before the wkv/shift outputs");
constexpr size_t ACT_ELEMS = (size_t)MP * DM;

constexpr int CW_TMO = 0, CW_BAR = 4096;

constexpr int RING_BYTES = 131072;
constexpr int LDSCTL_OFF = RING_BYTES, MISC_OFF = LDSCTL_OFF + 320;
constexpr int ATT_WSF_OFF = RING_BYTES + 1024;
constexpr int LDS_BYTES = 147456;
constexpr int NWAVES = 8;

#define LDS_WAIT() asm volatile("s_waitcnt lgkmcnt(0)" ::: "memory")
#define VM_WAIT() asm volatile("s_waitcnt vmcnt(0)" ::: "memory")
__device__ __forceinline__ unsigned f2bf(float f) { unsigned u = __builtin_bit_cast(unsigned, f); return (u + 0x7fffu + ((u >> 16) & 1u)) >> 16; }
__device__ __forceinline__ unsigned pk2(float lo, float hi) { return f2bf(lo) | (f2bf(hi) << 16); }
__device__ __forceinline__ float bf2f(unsigned short h) { return __builtin_bit_cast(float, (unsigned)h << 16); }
__device__ __forceinline__ float bflo(unsigned w) { return __builtin_bit_cast(float, w << 16); }
__device__ __forceinline__ float bfhi(unsigned w) { return __builtin_bit_cast(float, w & 0xffff0000u); }
__device__ __forceinline__ unsigned cvt_pk_bf16(float lo, float hi) { unsigned r; asm volatile("v_cvt_pk_bf16_f32 %0, %1, %2" : "=v"(r) : "v"(lo), "v"(hi)); return r; }
__device__ __forceinline__ float fexp2(float x) { return __builtin_amdgcn_exp2f(x); }
__device__ __forceinline__ float frcp(float x) { return __builtin_amdgcn_rcpf(x); }
__device__ __forceinline__ float sigmoidf_(float z) { return frcp(1.f + fexp2(-z * LOG2E)); }
__device__ __forceinline__ float wave_sum(float v) {
#pragma unroll
    for (int o = 1; o < 64; o <<= 1) v += __shfl_xor(v, o);
    return v;
}
template <int CTRL, int RMASK> __device__ __forceinline__ float dpp_f(float old, float v) {
    return __builtin_bit_cast(float, __builtin_amdgcn_update_dpp(__builtin_bit_cast(int, old), __builtin_bit_cast(int, v), CTRL, RMASK, 0xf, false));
}
__device__ __forceinline__ float wave_sum_dpp(float v) {
    v += dpp_f<0x121, 0xf>(0.f, v);
    v += dpp_f<0x122, 0xf>(0.f, v);
    v += dpp_f<0x124, 0xf>(0.f, v);
    v += dpp_f<0x128, 0xf>(0.f, v);
    v += dpp_f<0x142, 0xa>(0.f, v);
    v += dpp_f<0x143, 0xc>(0.f, v);
    return __builtin_bit_cast(float, __builtin_amdgcn_readlane(__builtin_bit_cast(int, v), 63));
}
__device__ __forceinline__ bool row_decode(int r, int& samp, int& b, int& t) {
    if (r < SROW0) { b = r / RS; t = r - b * RS - 1; samp = 0; return t >= 0; }
    if (r < NROWS) { const int q = r - SROW0; b = q / SRS; t = q - b * SRS - 1; samp = 1; return t >= 0; }
    samp = 0; b = 0; t = -1; return false;
}

#define XB_TMO      128
#define XB_XCNT(j)  (256  + 64 * (j))
#define XB_XSUB(j)  (1280 + 64 * (j))
#define XB_XGEN(j)  (2304 + 64 * (j))
#define XB_TOP      3328
#define XB_TOPGEN   3392
#define XCD_BAR_WORDS 3456
#define XB_SPIN_CAP (1u << 24)
__device__ __forceinline__ unsigned xb_ld(unsigned* p)              { return __hip_atomic_load(p, __ATOMIC_RELAXED, __HIP_MEMORY_SCOPE_AGENT); }
__device__ __forceinline__ unsigned xb_add(unsigned* p, unsigned v) { return __hip_atomic_fetch_add(p, v, __ATOMIC_RELAXED, __HIP_MEMORY_SCOPE_AGENT); }
__device__ __forceinline__ unsigned xb_xcc_id() { return (unsigned)__builtin_amdgcn_s_getreg((3 << 11) | 20) & 0xFu; }
#define XB_SPIN(cond, bar) do { unsigned _sp = 0; while (cond) { __builtin_amdgcn_s_sleep(1); \
    if ((++_sp & 255u) == 0u) { if (xb_ld(&(bar)[XB_TMO])) break; if (_sp > XB_SPIN_CAP) { atomicAdd(&(bar)[XB_TMO], 1u); break; } } } } while (0)
struct XcdBarrier { unsigned* bar; unsigned x; volatile LAS unsigned* st; };
__device__ __forceinline__ XcdBarrier xcd_barrier_post(unsigned* bar, volatile LAS unsigned* st) {
    XcdBarrier b; b.bar = bar; b.x = xb_xcc_id(); b.st = st;
    if (threadIdx.x == 0) (void)xb_add(&bar[XB_XCNT(b.x)], 1u);
    return b;
}
__device__ __forceinline__ void xcd_barrier_complete(unsigned* bar, unsigned x, unsigned& nloc, unsigned& nx) {
    const unsigned G = gridDim.x * gridDim.y * gridDim.z;
    unsigned sum, cnt, mine, sp = 0u;
    for (;;) {
        sum = 0u; cnt = 0u; mine = 0u;
#pragma unroll
        for (unsigned j = 0; j < 16; ++j) { const unsigned c = xb_ld(&bar[XB_XCNT(j)]); sum += c; cnt += (c > 0u) ? 1u : 0u; mine = (j == x) ? c : mine; }
        if (sum == G) break;
        __builtin_amdgcn_s_sleep(1);
        if ((++sp & 255u) == 0u) { if (xb_ld(&bar[XB_TMO])) break; if (sp > XB_SPIN_CAP) { atomicAdd(&bar[XB_TMO], 1u); break; } }
    }
    nloc = mine > 0u ? mine : 1u; nx = cnt > 0u ? cnt : 1u;
}
__device__ __forceinline__ void xcd_barrier(const XcdBarrier& b) {
    asm volatile("s_waitcnt vmcnt(0)" ::: "memory");
    __syncthreads();
    if (threadIdx.x == 0) {
        unsigned* bar = b.bar;
        __builtin_amdgcn_s_waitcnt(0);
        unsigned nloc = b.st[0], nx = b.st[1];
        if (nloc == 0u) { xcd_barrier_complete(bar, b.x, nloc, nx); b.st[0] = nloc; b.st[1] = nx; }
        const unsigned old = xb_add(&bar[XB_XSUB(b.x)], 1u);
        const unsigned gen = old / nloc;
        if (old + 1u == (gen + 1u) * nloc) {
            __builtin_amdgcn_fence(__ATOMIC_RELEASE, "agent");
            asm volatile("s_waitcnt vmcnt(0)" ::: "memory");
            const unsigned og = xb_add(&bar[XB_TOP], 1u);
            const unsigned tg = og / nx;
            if (og + 1u == (tg + 1u) * nx) xb_add(&bar[XB_TOPGEN], 1u);
            else XB_SPIN(xb_ld(&bar[XB_TOPGEN]) == tg, bar);
            __builtin_amdgcn_fence(__ATOMIC_ACQUIRE, "agent");
            xb_add(&bar[XB_XGEN(b.x)], 1u);
            asm volatile("s_waitcnt vmcnt(0)" ::: "memory");
        } else {
            XB_SPIN(xb_ld(&bar[XB_XGEN(b.x)]) == gen, bar);
            __builtin_amdgcn_fence(__ATOMIC_ACQUIRE, "agent");
            asm volatile("s_waitcnt vmcnt(0)" ::: "memory");
        }
    }
    __syncthreads();
}

namespace pg8 {
constexpr int BM = 256, BK = 64, HALF = 128, HTB = HALF * BK * 2, STAGE_BYTES = 8 * HTB, NXCD = 8, WGM = 8;
__host__ __device__ __forceinline__ int lds_byte(int r, int c) { const int st = (r >> 4) * 2 + (c >> 5), rr = r & 15, cc = c & 31, ob = rr * 64 + cc * 2; return st * 1024 + (ob ^ (((ob >> 9) & 1) << 5)); }
__host__ __device__ __forceinline__ void stage_rc(int b, int& R, int& C) { const int st = b / 1024, sb = b % 1024, swz = sb ^ (((sb >> 9) & 1) << 5); R = (st >> 1) * 16 + swz / 64; C = (st & 1) * 32 + (swz % 64) / 2; }
__host__ __device__ __forceinline__ int perm32(int rho) { const int n = rho >> 4, i = rho & 15; return 8 * (i >> 2) + 4 * n + (i & 3); }
struct Unit { int pm, pn; };
struct Gemm { const bf16* A; const bf16* Bt; int M, N, K, lda; };
struct StaticOrder {
    int nM, nN, nwg, G, c;
    __device__ void init(int M, int N, int G_, int c_) { nM = M / BM; nN = N / BM; nwg = nM * nN; G = G_; c = c_; }
    __device__ bool next(int i, Unit& u) const {
        const long L = (long)i * G + c; if (L >= nwg) return false;
        int wgid = (int)L; { const int q = nwg / NXCD, r = nwg % NXCD, xcd = wgid % NXCD, off = wgid / NXCD; wgid = (xcd < r ? xcd * (q + 1) : r * (q + 1) + (xcd - r) * q) + off; }
        const int nig = WGM * nN, gid = wgid / nig, fm = gid * WGM, gsz = (nM - fm) < WGM ? (nM - fm) : WGM;
        u.pm = fm + ((wgid % nig) % gsz); u.pn = (wgid % nig) / gsz; return true;
    }
};
template <class Epi, bool SHIFT>
__device__ __forceinline__ void gemm_phase(LAS unsigned char* lds, const Gemm g, const StaticOrder& S, const Epi& E) {
    const int tid = threadIdx.x, wid = __builtin_amdgcn_readfirstlane(tid >> 6), lane = tid & 63, wr = wid >> 2, wc = wid & 3, fr = lane & 15, fq = lane >> 4;
    const int K = g.K, nt = K / BK, lda = g.lda;
    unsigned voffA[2], voffB[2];
#pragma unroll
    for (int i = 0; i < 2; ++i) { int R, C; stage_rc(tid * 16 + i * 8192, R, C); const int Rb = Epi::PERM ? ((R & ~31) + perm32(R & 31)) : R;
        voffA[i] = (unsigned)(R * lda + C) * 2u; voffB[i] = (unsigned)(Rb * K + C) * 2u; }
    const size_t kstep = (size_t)(BK * 2);
    const size_t hstepA = (size_t)HALF * lda * 2, hstepB = (size_t)HALF * K * 2;
    const size_t tstepA = 2 * hstepA, tstepB = 2 * hstepB;
    const unsigned ldsw = (unsigned)wid * 1024u;
    const int aoff = lds_byte(wr * 64 + fr, fq * 8), boff = lds_byte(wc * 32 + fr, fq * 8);
#define PG8_SA(b, h) (((b) * 2 + (h)) * HTB)
#define PG8_SB(b, h) ((4 + (b) * 2 + (h)) * HTB)
#define PG8_STAGE(bufoff, gbase, voff) do { _Pragma("unroll") for (int _i = 0; _i < 2; ++_i) \
        __builtin_amdgcn_global_load_lds((const unsigned*)((const char*)(gbase) + (voff)[_i]), (LAS unsigned*)(lds + (bufoff) + ldsw + _i * 8192), 16, 0, 0); } while (0)
#define PG8_LDA(dst, b, h) do { _Pragma("unroll") for (int m = 0; m < 4; ++m) _Pragma("unroll") for (int k = 0; k < 2; ++k) dst[m][k] = *(const LAS bf16x8*)(lds + PG8_SA(b, h) + aoff + m * 2048 + k * 1024); } while (0)
#define PG8_LDB(dst, b, h) do { _Pragma("unroll") for (int n = 0; n < 2; ++n) _Pragma("unroll") for (int k = 0; k < 2; ++k) dst[n][k] = *(const LAS bf16x8*)(lds + PG8_SB(b, h) + boff + n * 2048 + k * 1024); } while (0)
#define PG8_MMA(ai, bj, At, Bt) do { __builtin_amdgcn_s_setprio(1); _Pragma("unroll") for (int m = 0; m < 4; ++m) _Pragma("unroll") for (int n = 0; n < 2; ++n) _Pragma("unroll") for (int k = 0; k < 2; ++k) \
        acc[ai][bj][m][n] = __builtin_amdgcn_mfma_f32_16x16x32_bf16(Bt[n][k], At[m][k], acc[ai][bj][m][n], 0, 0, 0); __builtin_amdgcn_s_setprio(0); } while (0)
#define PG8_WAIT_V(n) asm volatile("s_waitcnt vmcnt(" #n ")" ::: "memory")
#define PG8_WAIT_L(n) asm volatile("s_waitcnt lgkmcnt(" #n ")" ::: "memory")
#define PG8_BAR __builtin_amdgcn_s_barrier()
#define PG8_SCHED __builtin_amdgcn_sched_barrier(0)
#define PG8_AK(base, kt) ((base) + (size_t)(kt) * kstep - ((SHIFT && (kt) >= (nt >> 1)) ? (size_t)lda * 4 : (size_t)0))
    Unit cur, nxt; int ui = 0;
    if (!S.next(0, cur)) return;
    f32x4 acc[2][2][4][2];
#pragma unroll
    for (int a = 0; a < 2; ++a)
#pragma unroll
        for (int b = 0; b < 2; ++b)
#pragma unroll
            for (int m = 0; m < 4; ++m)
#pragma unroll
                for (int n = 0; n < 2; ++n) acc[a][b][m][n] = (f32x4){0.f, 0.f, 0.f, 0.f};
    bf16x8 At[4][2], B0[2][2], B1[2][2];
    const char* cA = (const char*)g.A + (size_t)cur.pm * tstepA; const char* cB = (const char*)g.Bt + (size_t)cur.pn * tstepB;
    PG8_STAGE(PG8_SB(0, 0), cB, voffB); PG8_STAGE(PG8_SB(0, 1), cB + hstepB, voffB); PG8_STAGE(PG8_SA(0, 0), cA, voffA); PG8_STAGE(PG8_SA(0, 1), cA + hstepA, voffA);
    if (wr == 1) PG8_BAR;
    PG8_WAIT_V(2); PG8_BAR;
    PG8_STAGE(PG8_SB(1, 0), cB + kstep, voffB); PG8_STAGE(PG8_SA(1, 0), cA + kstep, voffA); PG8_STAGE(PG8_SB(1, 1), cB + hstepB + kstep, voffB);
    PG8_WAIT_V(6); PG8_BAR;
    for (;;) {
        const bool has_next = S.next(ui + 1, nxt);
        const char* nA = has_next ? (const char*)g.A + (size_t)nxt.pm * tstepA : cA; const char* nB = has_next ? (const char*)g.Bt + (size_t)nxt.pn * tstepB : cB;
        for (int t = 0; t < nt; t += 2) {
            const bool last = (t == nt - 2);
            const char* a1 = PG8_AK(cA, t + 1);
            const char* a2 = last ? nA : PG8_AK(cA, t + 2); const char* b2 = last ? nB : cB + (size_t)(t + 2) * kstep;
            const char* a3 = a2 + kstep; const char* b3 = b2 + kstep;
            PG8_LDB(B0, 0, 0); PG8_LDB(B1, 0, 1); PG8_SCHED; PG8_LDA(At, 0, 0); PG8_STAGE(PG8_SA(1, 1), a1 + hstepA, voffA);
            PG8_WAIT_V(8); PG8_WAIT_L(0); PG8_BAR; PG8_MMA(0, 0, At, B0); PG8_MMA(0, 1, At, B1); PG8_BAR; PG8_SCHED;
            PG8_LDA(At, 0, 1); PG8_STAGE(PG8_SB(0, 0), b2, voffB); PG8_STAGE(PG8_SB(0, 1), b2 + hstepB, voffB); PG8_STAGE(PG8_SA(0, 0), a2, voffA);
            PG8_WAIT_V(8); PG8_WAIT_L(0); PG8_BAR; PG8_MMA(1, 0, At, B0); PG8_MMA(1, 1, At, B1); PG8_BAR; PG8_SCHED;
            PG8_LDB(B0, 1, 0); PG8_LDB(B1, 1, 1); PG8_SCHED; PG8_LDA(At, 1, 0); PG8_STAGE(PG8_SA(0, 1), a2 + hstepA, voffA);
            PG8_WAIT_V(8); PG8_WAIT_L(0); PG8_BAR; PG8_MMA(0, 0, At, B0); PG8_MMA(0, 1, At, B1); PG8_BAR; PG8_SCHED;
            PG8_LDA(At, 1, 1); PG8_STAGE(PG8_SB(1, 0), b3, voffB); PG8_STAGE(PG8_SB(1, 1), b3 + hstepB, voffB); PG8_STAGE(PG8_SA(1, 0), a3, voffA);
            PG8_WAIT_V(8); PG8_WAIT_L(0); PG8_BAR; PG8_MMA(1, 0, At, B0); PG8_MMA(1, 1, At, B1); PG8_BAR; PG8_SCHED;
        }
        if (wr == 0) PG8_BAR;
        E(acc, cur, wr, wc, fr, fq);
        if (!has_next) break;
#pragma unroll
        for (int a = 0; a < 2; ++a)
#pragma unroll
            for (int b = 0; b < 2; ++b)
#pragma unroll
                for (int m = 0; m < 4; ++m)
#pragma unroll
                    for (int n = 0; n < 2; ++n) acc[a][b][m][n] = (f32x4){0.f, 0.f, 0.f, 0.f};
        cur = nxt; cA = nA; cB = nB; ++ui;
        if (wr == 1) PG8_BAR;
    }
    PG8_WAIT_V(0);
    PG8_BAR;
#undef PG8_SA
#undef PG8_SB
#undef PG8_STAGE
#undef PG8_LDA
#undef PG8_LDB
#undef PG8_MMA
#undef PG8_WAIT_V
#undef PG8_WAIT_L
#undef PG8_BAR
#undef PG8_SCHED
#undef PG8_AK
}

typedef f32x4 Acc[2][2][4][2];
struct EpiSwiGLU {
    static constexpr bool PERM = true;
    bf16* H;
    __device__ __forceinline__ void operator()(const Acc& acc, const Unit& u, int wr, int wc, int fr, int fq) const {
        const int row0 = u.pm * BM + wr * 64 + fr, col0 = u.pn * HALF + wc * 32 + 8 * fq;
#pragma unroll
        for (int ai = 0; ai < 2; ++ai)
#pragma unroll
            for (int m = 0; m < 4; ++m) {
                bf16* rowp = H + (size_t)(row0 + ai * HALF + m * 16) * FF + col0;
                float h[8];
#pragma unroll
                for (int n = 0; n < 2; ++n)
#pragma unroll
                    for (int e = 0; e < 4; ++e) { const float gt = acc[ai][0][m][n][e], up = acc[ai][1][m][n][e]; h[4 * n + e] = gt * sigmoidf_(gt) * up; }
                u32x4 w; w.x = cvt_pk_bf16(h[0], h[1]); w.y = cvt_pk_bf16(h[2], h[3]); w.z = cvt_pk_bf16(h[4], h[5]); w.w = cvt_pk_bf16(h[6], h[7]);
                *(u32x4*)rowp = w;
            }
    }
};
struct EpiResid {
    static constexpr bool PERM = false;
    const float* X; float* O; float alpha, s;
    __device__ __forceinline__ void operator()(const Acc& acc, const Unit& u, int wr, int wc, int fr, int fq) const {
        const int row0 = u.pm * BM + wr * 64 + fr, col0 = u.pn * BM + wc * 32 + 4 * fq;
#pragma unroll
        for (int ai = 0; ai < 2; ++ai)
#pragma unroll
            for (int m = 0; m < 4; ++m) {
                const size_t off = (size_t)(row0 + ai * HALF + m * 16) * DM + col0;
#pragma unroll
                for (int bj = 0; bj < 2; ++bj)
#pragma unroll
                    for (int n = 0; n < 2; ++n) { const f32x4 x = *(const f32x4*)(X + off + bj * HALF + n * 16); *(f32x4*)(O + off + bj * HALF + n * 16) = x * alpha + acc[ai][bj][m][n] * s; }
            }
    }
};
struct EpiRwkv {
    static constexpr bool PERM = true;
    bf16 *RK, *Vv, *L;
    __device__ __forceinline__ void operator()(const Acc& acc, const Unit& u, int wr, int wc, int fr, int fq) const {
        const int row0 = u.pm * BM + wr * 64 + fr;
        bf16* rk_ = RK; bf16* vv_ = Vv; bf16* l_ = L; asm volatile("" : "+s"(rk_), "+s"(vv_), "+s"(l_));
        if (u.pn < 24) {
            bf16* base = rk_ + (size_t)(u.pn >> 3) * ACT_ELEMS; if (u.pn >= 16) base = vv_; const int col0 = (u.pn & 7) * BM + wc * 32 + 8 * fq;
#pragma unroll
            for (int ai = 0; ai < 2; ++ai)
#pragma unroll
                for (int m = 0; m < 4; ++m)
#pragma unroll
                    for (int bj = 0; bj < 2; ++bj) { const f32x4 v0 = acc[ai][bj][m][0], v1 = acc[ai][bj][m][1];
                        u32x4 w; w.x = cvt_pk_bf16(v0[0], v0[1]); w.y = cvt_pk_bf16(v0[2], v0[3]); w.z = cvt_pk_bf16(v1[0], v1[1]); w.w = cvt_pk_bf16(v1[2], v1[3]);
                        *(u32x4*)(base + (size_t)(row0 + ai * HALF + m * 16) * DM + col0 + bj * HALF) = w; }
        } else {
#pragma unroll
            for (int bj = 0; bj < 2; ++bj) {
                const int lc = (u.pn - 24) * BM + bj * HALF + wc * 32 + 8 * fq; const int kind = lc < 96 ? 0 : (lc < 192 ? 1 : (lc < 448 ? 2 : 3));
#pragma unroll
                for (int ai = 0; ai < 2; ++ai)
#pragma unroll
                    for (int m = 0; m < 4; ++m) { float h[8];
#pragma unroll
                        for (int n = 0; n < 2; ++n)
#pragma unroll
                            for (int e = 0; e < 4; ++e) { const float x = acc[ai][bj][m][n][e]; float y;
                                if (kind == 0) y = 1.f - 2.f * frcp(fexp2(x * (2.f * LOG2E)) + 1.f);
                                else if (kind == 1) y = x; else if (kind == 2) y = sigmoidf_(x); else y = 0.f;
                                h[4 * n + e] = y; }
                        u32x4 w; w.x = cvt_pk_bf16(h[0], h[1]); w.y = cvt_pk_bf16(h[2], h[3]); w.z = cvt_pk_bf16(h[4], h[5]); w.w = cvt_pk_bf16(h[6], h[7]);
                        *(u32x4*)(l_ + (size_t)(row0 + ai * HALF + m * 16) * KL2 + lc) = w; }
            }
        }
    }
};
struct EpiLora2 {
    static constexpr bool PERM = true;
    bf16* WAG; const float *w0, *a0;
    __device__ __forceinline__ void operator()(const Acc& acc, const Unit& u, int wr, int wc, int fr, int fq) const {
        const int row0 = u.pm * BM + wr * 64 + fr; const int kind = u.pn >> 3;
        bf16* wag_ = WAG; const float* w0_ = w0; const float* a0_ = a0; asm volatile("" : "+s"(wag_), "+s"(w0_), "+s"(a0_));
        bf16* base = wag_ + (size_t)kind * ACT_ELEMS; const float* bias = w0_; if (kind != 0) bias = a0_;
#pragma unroll
        for (int bj = 0; bj < 2; ++bj) {
            const int col0 = (u.pn & 7) * BM + bj * HALF + wc * 32 + 8 * fq;
            f32x4 b0 = (f32x4){0.f, 0.f, 0.f, 0.f}, b1 = b0;
            if (kind < 2) { b0 = *(const f32x4*)(bias + col0); b1 = *(const f32x4*)(bias + col0 + 4); }
#pragma unroll
            for (int ai = 0; ai < 2; ++ai)
#pragma unroll
                for (int m = 0; m < 4; ++m) { float h[8];
#pragma unroll
                    for (int e = 0; e < 4; ++e) { h[e] = acc[ai][bj][m][0][e] + b0[e]; h[4 + e] = acc[ai][bj][m][1][e] + b1[e]; }
                    if (kind == 0) {
#pragma unroll
                        for (int e = 0; e < 8; ++e) h[e] = -0.60653066f * sigmoidf_(h[e]);
                    } else if (kind == 1) {
#pragma unroll
                        for (int e = 0; e < 8; ++e) h[e] = sigmoidf_(h[e]);
                    }
                    u32x4 w; w.x = cvt_pk_bf16(h[0], h[1]); w.y = cvt_pk_bf16(h[2], h[3]); w.z = cvt_pk_bf16(h[4], h[5]); w.w = cvt_pk_bf16(h[6], h[7]);
                    *(u32x4*)(base + (size_t)(row0 + ai * HALF + m * 16) * DM + col0) = w; }
        }
    }
};
struct EpiKV {
    static constexpr bool PERM = false;
    float* out; bf16* KB;
    __device__ __forceinline__ void operator()(const Acc& acc, const Unit& u, int wr, int wc, int fr, int fq) const {
        const int row0 = u.pm * BM + wr * 64 + fr; const int isv = u.pn >= 8 ? 1 : 0; const int col0 = (u.pn & 7) * BM + wc * 32 + 4 * fq;
        float* out_ = out; bf16* kb_ = KB; asm volatile("" : "+s"(out_), "+s"(kb_));
#pragma unroll
        for (int ai = 0; ai < 2; ++ai)
#pragma unroll
            for (int m = 0; m < 4; ++m) {
                const int r = row0 + ai * HALF + m * 16; int samp, b, t;
                if (!row_decode(r, samp, b, t)) continue;
                size_t fofs = O_KP + (size_t)isv * (O_VP - O_KP) + (size_t)(b * T + t) * DM;
                if (samp) fofs = O_KS + (size_t)isv * (O_VS - O_KS) + (size_t)(b * TS + t) * DM;
                float* fo = out_ + fofs + col0;
                bf16* bo = kb_ + (size_t)isv * ((WS_VB - WS_KB) / 2) + (size_t)(samp ? NB * T + b * KVS + PAST + t : b * T + t) * DM + col0;
#pragma unroll
                for (int bj = 0; bj < 2; ++bj)
#pragma unroll
                    for (int n = 0; n < 2; ++n) { const f32x4 v = acc[ai][bj][m][n]; *(f32x4*)(fo + bj * HALF + n * 16) = v;
                        u32x2 w; w.x = cvt_pk_bf16(v[0], v[1]); w.y = cvt_pk_bf16(v[2], v[3]); *(u32x2*)(bo + bj * HALF + n * 16) = w; }
            }
    }
};
struct EpiQ {
    static constexpr bool PERM = true;
    bf16* Q;
    __device__ __forceinline__ void operator()(const Acc& acc, const Unit& u, int wr, int wc, int fr, int fq) const {
        const int row0 = u.pm * BM + wr * 64 + fr, col0 = u.pn * BM + wc * 32 + 8 * fq;
#pragma unroll
        for (int ai = 0; ai < 2; ++ai)
#pragma unroll
            for (int m = 0; m < 4; ++m)
#pragma unroll
                for (int bj = 0; bj < 2; ++bj) { const f32x4 v0 = acc[ai][bj][m][0] * QSCALE, v1 = acc[ai][bj][m][1] * QSCALE;
                    u32x4 w; w.x = cvt_pk_bf16(v0[0], v0[1]); w.y = cvt_pk_bf16(v0[2], v0[3]); w.z = cvt_pk_bf16(v1[0], v1[1]); w.w = cvt_pk_bf16(v1[2], v1[3]);
                    *(u32x4*)(Q + (size_t)(row0 + ai * HALF + m * 16) * DM + col0 + bj * HALF) = w; }
    }
};
}

struct Args { const float* in[31]; float* out; unsigned char* ws; int ph_lo, ph_hi; };
struct Frame {
    LAS unsigned char* lds; volatile LAS unsigned* MISC; gu32* ctl;
    int tid, lane, wave, vcu, G;
};

__device__ __forceinline__ void tr_item(const float* W, int N, int k0, int n0, LAS float* scr, int lane, bf16* dst, size_t ldd, const float* sc, int mode) {
#pragma unroll 8
    for (int i = 0; i < 32; ++i) { const int kk = 2 * i + (lane >> 5); float v = W[(size_t)(k0 + kk) * N + n0 + (lane & 31)];
        if (mode) { const float s = sc[k0 + kk]; v *= (mode == 1) ? s : (1.f - s); }
        scr[kk * 33 + (lane & 31)] = v; }
    LDS_WAIT(); asm volatile("" ::: "memory");
    const int c = lane & 7;
#pragma unroll
    for (int j = 0; j < 4; ++j) { const int n = (lane >> 3) + 8 * j; const LAS float* s = scr + (8 * c) * 33 + n;
        u32x4 o; o.x = pk2(s[0 * 33], s[1 * 33]); o.y = pk2(s[2 * 33], s[3 * 33]); o.z = pk2(s[4 * 33], s[5 * 33]); o.w = pk2(s[6 * 33], s[7 * 33]);
        *(u32x4*)(dst + (size_t)n * ldd + 8 * c) = o; }
    LDS_WAIT(); asm volatile("" ::: "memory");
}

__device__ __forceinline__ void p0_prologue(Frame& F, const Args& a) {
    LAS float* scr = (LAS float*)(F.lds + F.wave * 16384);
    const int gw = F.vcu * NWAVES + F.wave, NGW = F.G * NWAVES, lane = F.lane;
    unsigned char* ws = a.ws;
    constexpr int I_IN = 32 * 352, I_OUT = 88 * 64, I_SQ = 32 * 64, I_KV = 32 * 128, I_L96 = 32 * 3, I_L256 = 32 * 8;
    constexpr int N0 = 4 * I_IN, N1 = N0 + 4 * I_OUT, N2 = N1 + 3 * 2 * I_SQ, N3 = N2 + 2 * (2 * I_L96 + I_L256), N4 = N3 + 3 * I_SQ, N5 = N4 + I_KV;
    for (int it = gw; it < N5; it += NGW) {
        if (it < N0) {
            const int mi = it / I_IN, r = it % I_IN, kb = r / 352, nb = r % 352, n0 = nb * 32;
            const int isup = n0 >= FF, c = isup ? n0 - FF : n0, drow = (c >> 7) * 256 + isup * 128 + (c & 127);
            tr_item(a.in[8] + (size_t)mi * DM * 2 * FF, 2 * FF, kb * 64, n0, scr, lane, (bf16*)(ws + WS_WIN + mi * WIN_STRIDE) + (size_t)drow * DM + kb * 64, DM, nullptr, 0);
        } else if (it < N1) {
            const int q = it - N0, mi = q / I_OUT, r = q % I_OUT, kb = r / 64, nb = r % 64;
            tr_item(a.in[9] + (size_t)mi * FF * DM, DM, kb * 64, nb * 32, scr, lane, (bf16*)(ws + WS_WOUT + mi * WOUT_STRIDE) + (size_t)(nb * 32) * FF + kb * 64, FF, nullptr, 0);
        } else if (it < N2) {
            const int q = it - N1, j = q / (2 * I_SQ), r = q % (2 * I_SQ), half = r / I_SQ, rr = r % I_SQ, kb = rr / 64, nb = rr % 64;
            const int mix = j == 0 ? 0 : (j == 1 ? 2 : 3);
            tr_item(a.in[11] + (size_t)j * DM * DM, DM, kb * 64, nb * 32, scr, lane, (bf16*)(ws + WS_WCAT) + (size_t)(j * DM + nb * 32) * KCAT + half * DM + kb * 64, KCAT, a.in[10] + mix * DM, half ? 1 : 2);
        } else if (it < N3) {
            int q = it - N2; const int half = q / (2 * I_L96 + I_L256); q %= (2 * I_L96 + I_L256);
            const float* W; int N, mix, rowoff;
            if (q < I_L96) { W = a.in[13]; N = 96; mix = 1; rowoff = 6144; } else if (q < 2 * I_L96) { q -= I_L96; W = a.in[16]; N = 96; mix = 4; rowoff = 6240; } else { q -= 2 * I_L96; W = a.in[18]; N = 256; mix = 5; rowoff = 6336; }
            const int nbn = N / 32, kb = q / nbn, nb = q % nbn;
            tr_item(W, N, kb * 64, nb * 32, scr, lane, (bf16*)(ws + WS_WCAT) + (size_t)(rowoff + nb * 32) * KCAT + half * DM + kb * 64, KCAT, a.in[10] + mix * DM, half ? 1 : 2);
        } else if (it < N4) {
            const int q = it - N3, j = q / I_SQ, r = q % I_SQ, kb = r / 64, nb = r % 64;
            const float* W = j == 0 ? a.in[25] : (j == 1 ? a.in[27] : a.in[30]); const size_t wo = j == 0 ? WS_WOR : (j == 1 ? WS_WQ : WS_WOD);
            tr_item(W, DM, kb * 64, nb * 32, scr, lane, (bf16*)(ws + wo) + (size_t)(nb * 32) * DM + kb * 64, DM, nullptr, 0);
        } else {
            const int q = it - N4, kb = q / 128, nb = q % 128;
            tr_item(a.in[26], 4096, kb * 64, nb * 32, scr, lane, (bf16*)(ws + WS_WKV) + (size_t)(nb * 32) * DM + kb * 64, DM, nullptr, 0);
        }
    }
    const int gt = F.vcu * 512 + F.tid, NGT = F.G * 512;
    for (int i = gt; i < 64 * KCAT / 8; i += NGT) *(u32x4*)((bf16*)(ws + WS_WCAT) + (size_t)6592 * KCAT + (size_t)i * 8) = (u32x4){0u, 0u, 0u, 0u};
    for (int i = gt; i < NL2 * (KL2 / 8); i += NGT) {
        const int n = i / (KL2 / 8), k8 = (i % (KL2 / 8)) * 8, kind = n >> 11, nn = n & 2047;
        const int klo = kind == 0 ? 0 : (kind == 1 ? 96 : 192), khi = kind == 0 ? 96 : (kind == 1 ? 192 : 448);
        const float* W = kind == 0 ? a.in[14] : (kind == 1 ? a.in[17] : a.in[19]);
        float v[8];
#pragma unroll
        for (int e = 0; e < 8; ++e) { const int k = k8 + e; v[e] = (k >= klo && k < khi) ? W[(size_t)(k - klo) * DM + nn] : 0.f; }
        u32x4 o; o.x = pk2(v[0], v[1]); o.y = pk2(v[2], v[3]); o.z = pk2(v[4], v[5]); o.w = pk2(v[6], v[7]);
        *(u32x4*)((bf16*)(ws + WS_WL2) + (size_t)n * KL2 + k8) = o;
    }
    float* XF = (float*)(ws + WS_XF); bf16* XB = (bf16*)(ws + WS_XBA);
    for (int r = gw; r < MP; r += NGW) {
        int samp, b, t; const bool ok = row_decode(r, samp, b, t);
        const float* src = samp ? a.in[1] + (size_t)(b * TS + t) * DM : a.in[0] + (size_t)(b * T + t) * DM;
#pragma unroll
        for (int j = 0; j < 8; ++j) { const int c = 4 * lane + 256 * j; f32x4 v = (f32x4){0.f, 0.f, 0.f, 0.f}; if (ok) v = *(const f32x4*)(src + c);
            *(f32x4*)(XF + (size_t)r * DM + c) = v; u32x2 w; w.x = pk2(v[0], v[1]); w.y = pk2(v[2], v[3]); *(u32x2*)(XB + (size_t)r * DM + c) = w; }
    }
}

__device__ __forceinline__ void ln_pass(Frame& F, const Args& a, const float* g, const float* bta, bf16* XB, int mode) {
    const int gw = F.vcu * NWAVES + F.wave, NGW = F.G * NWAVES, lane = F.lane;
    float* XF = (float*)(a.ws + WS_XF);
    for (int r = gw; r < MP; r += NGW) {
        int samp, b, t; const bool ok = row_decode(r, samp, b, t);
        f32x4 v[8]; float s = 0.f;
#pragma unroll
        for (int j = 0; j < 8; ++j) { v[j] = *(const f32x4*)(XF + (size_t)r * DM + 4 * lane + 256 * j); s += (v[j][0] + v[j][1]) + (v[j][2] + v[j][3]); }
        const float mean = wave_sum(s) * (1.f / DM); float s2 = 0.f;
#pragma unroll
        for (int j = 0; j < 8; ++j) { v[j] = v[j] - mean; s2 += (v[j][0] * v[j][0] + v[j][1] * v[j][1]) + (v[j][2] * v[j][2] + v[j][3] * v[j][3]); }
        const float rstd = 1.f / sqrtf(wave_sum(s2) * (1.f / DM) + LN_EPS);
#pragma unroll
        for (int j = 0; j < 8; ++j) { const int c = 4 * lane + 256 * j; const f32x4 gg = *(const f32x4*)(g + c), bb = *(const f32x4*)(bta + c); v[j] = v[j] * rstd * gg + bb; }
        if (mode == 2) {
            if (ok) { float* o = a.out + (samp ? O_YS + (size_t)(b * TS + t) * DM : O_YP + (size_t)(b * T + t) * DM);
#pragma unroll
                for (int j = 0; j < 8; ++j) *(f32x4*)(o + 4 * lane + 256 * j) = v[j]; }
            continue;
        }
        if (mode == 1) {
            if (!ok && r < NROWS) {
                const bool sm = r >= SROW0; const int bb = sm ? (r - SROW0) / SRS : 0;
#pragma unroll
                for (int j = 0; j < 8; ++j) { const int c = 4 * lane + 256 * j; f32x4 h = (f32x4){0.f, 0.f, 0.f, 0.f}; if (sm) h = *(const f32x4*)(a.in[5] + (size_t)bb * DM + c);
                    u32x2 w; w.x = pk2(h[0], h[1]); w.y = pk2(h[2], h[3]); *(u32x2*)(XB + (size_t)r * DM + c) = w; }
                continue;
            }
            if (ok && t == (samp ? TS - 1 : T - 1)) { float* o = a.out + (samp ? O_SHS : O_SHP) + (size_t)b * DM;
#pragma unroll
                for (int j = 0; j < 8; ++j) *(f32x4*)(o + 4 * lane + 256 * j) = v[j]; }
        }
#pragma unroll
        for (int j = 0; j < 8; ++j) { const int c = 4 * lane + 256 * j; *(f32x4*)(XF + (size_t)r * DM + c) = v[j];
            u32x2 w; w.x = pk2(v[j][0], v[j][1]); w.y = pk2(v[j][2], v[j][3]); *(u32x2*)(XB + (size_t)r * DM + c) = w; }
    }
}

__device__ __forceinline__ void cache_convert(Frame& F, const Args& a) {
    const int gt = F.vcu * 512 + F.tid, NGT = F.G * 512;
    bf16* KB = (bf16*)(a.ws + WS_KB); bf16* VB = (bf16*)(a.ws + WS_VB);
    constexpr int PER = NB * PAST * DM / 8;
    for (int i = gt; i < 2 * PER; i += NGT) {
        const int which = i >= PER, q = which ? i - PER : i; const size_t e = (size_t)q * 8; const int b = (int)(e / ((size_t)PAST * DM)); const size_t rem = e - (size_t)b * PAST * DM;
        const float* src = a.in[2 + which] + e; const f32x4 v0 = *(const f32x4*)src, v1 = *(const f32x4*)(src + 4);
        u32x4 o; o.x = pk2(v0[0], v0[1]); o.y = pk2(v0[2], v0[3]); o.z = pk2(v1[0], v1[1]); o.w = pk2(v1[2], v1[3]);
        *(u32x4*)((which ? VB : KB) + (size_t)(NB * T + b * KVS) * DM + rem) = o;
    }
}

constexpr int SC_TB = 32, SC_RAW = 0, SC_RAWB = 6 * SC_TB * 64 * 2, SC_DER = 2 * SC_RAWB, SC_YB = SC_DER + 5 * SC_TB * 64 * 4, SC_RK = SC_YB + SC_TB * 64 * 4;
__device__ __forceinline__ void scan_unit(Frame& F, const Args& a, int samp, int b, int h) {
    const int lane = F.lane, w = F.wave, tid = F.tid;
    const int nsteps = samp ? TS : T, row0 = samp ? SROW0 + b * SRS + 1 : b * RS + 1;
    const bool hsel = (tid >> 8) != 0;
    const bf16* arr0 = hsel ? (const bf16*)(a.ws + WS_KR) : (const bf16*)(a.ws + WS_R);
    const bf16* arr1 = hsel ? (const bf16*)((unsigned char*)a.out + DO_WLD) : (const bf16*)((unsigned char*)a.out + DO_VV);
    const bf16* arr2 = hsel ? (const bf16*)((unsigned char*)a.out + DO_GG) : (const bf16*)((unsigned char*)a.out + DO_AG);
    bf16* Y = (bf16*)(a.ws + WS_XBA);
    LAS unsigned char* lds = F.lds;
    const float kk_w = a.in[20][h * 64 + lane], ka_w = a.in[21][h * 64 + lane], rk_w = a.in[22][h * 64 + lane], lg = a.in[23][h * 64 + lane], lb = a.in[24][h * 64 + lane];
    float S[8];
#pragma unroll
    for (int i = 0; i < 8; ++i) S[i] = samp ? a.in[4][((size_t)(b * 32 + h) * 64 + 8 * w + i) * 64 + lane] : 0.f;
    const int nchunk = (nsteps + SC_TB - 1) / SC_TB;
    u32x4 pre[3];
#define SC_LOAD(c) do { _Pragma("unroll") for (int j = 0; j < 3; ++j) { const int p = tid + 512 * j, ar = p >> 8, st = (p >> 3) & 31, ch = p & 7; \
        const int step = (c) * SC_TB + st; pre[j] = (u32x4){0u, 0u, 0u, 0u}; \
        const bf16* ap_ = j == 0 ? arr0 : (j == 1 ? arr1 : arr2); (void)ar; \
        if (step < nsteps) pre[j] = *(const u32x4*)(ap_ + (size_t)(row0 + step) * DM + h * 64 + ch * 8); } } while (0)
#define SC_STORE(c) do { _Pragma("unroll") for (int j = 0; j < 3; ++j) { const int p = tid + 512 * j, ar = p >> 8, st = (p >> 3) & 31, ch = p & 7; \
        *(LAS u32x4*)(lds + SC_RAW + ((c) & 1) * SC_RAWB + ((ar * SC_TB + st) * 64 + ch * 8) * 2) = pre[j]; } } while (0)
    SC_LOAD(0); SC_STORE(0);
    __syncthreads();
    for (int c = 0; c < nchunk; ++c) {
        const LAS bf16* raw = (const LAS bf16*)(lds + SC_RAW + (c & 1) * SC_RAWB);
        LAS float* der = (LAS float*)(lds + SC_DER); LAS float* yb = (LAS float*)(lds + SC_YB); LAS float* rkb = (LAS float*)(lds + SC_RK);
        if (c + 1 < nchunk) SC_LOAD(c + 1);
#pragma unroll
        for (int j = 0; j < 4; ++j) { const int st = w + 8 * j;
            const float r = bf2f(raw[(0 * SC_TB + st) * 64 + lane]), kr = bf2f(raw[(1 * SC_TB + st) * 64 + lane]), ld = bf2f(raw[(3 * SC_TB + st) * 64 + lane]), aa = bf2f(raw[(4 * SC_TB + st) * 64 + lane]);
            const float kkr = kr * kk_w; const float ss = wave_sum(kkr * kkr); const float kk = kkr * __builtin_amdgcn_rsqf(fmaxf(ss, 1e-24f));
            const float kmod = kr * (1.f + (aa - 1.f) * ka_w); const float rk = wave_sum(r * kmod * rk_w);
            der[(0 * SC_TB + st) * 64 + lane] = kk; der[(1 * SC_TB + st) * 64 + lane] = kk * aa; der[(2 * SC_TB + st) * 64 + lane] = kmod;
            der[(3 * SC_TB + st) * 64 + lane] = fexp2(ld * LOG2E); der[(4 * SC_TB + st) * 64 + lane] = r;
            if (lane == 0) rkb[st] = rk; }
        __syncthreads();
        const int ns = (nsteps - c * SC_TB) < SC_TB ? (nsteps - c * SC_TB) : SC_TB;
        for (int st = 0; st < ns; ++st) {
            const float kk = der[(0 * SC_TB + st) * 64 + lane], kka = der[(1 * SC_TB + st) * 64 + lane], kmod = der[(2 * SC_TB + st) * 64 + lane], dd = der[(3 * SC_TB + st) * 64 + lane], r = der[(4 * SC_TB + st) * 64 + lane];
            const float vv = bf2f(raw[(2 * SC_TB + st) * 64 + 8 * w + (lane & 7)]);
            float yv = 0.f;
#pragma unroll
            for (int i = 0; i < 8; ++i) {
                const float sa = wave_sum_dpp(S[i] * kk);
                const float vi = __builtin_bit_cast(float, __builtin_amdgcn_readlane(__builtin_bit_cast(int, vv), i));
                S[i] = S[i] * dd - sa * kka + vi * kmod;
                const float y = wave_sum_dpp(S[i] * r);
                yv = (lane == i) ? y : yv;
            }
            if (lane < 8) yb[st * 64 + 8 * w + lane] = yv;
        }
        __syncthreads();
#pragma unroll
        for (int j = 0; j < 4; ++j) { const int st = w + 8 * j;
            if (st < ns) {
                const float y = yb[st * 64 + lane]; const float mu = wave_sum(y) * (1.f / 64.f); const float dy = y - mu; const float var = wave_sum(dy * dy) * (1.f / 64.f);
                const float yn = dy * __builtin_amdgcn_rsqf(var + GN_EPS) * lg + lb;
                const float vvv = bf2f(raw[(2 * SC_TB + st) * 64 + lane]), gg = bf2f(raw[(5 * SC_TB + st) * 64 + lane]);
                Y[(size_t)(row0 + c * SC_TB + st) * DM + h * 64 + lane] = (bf16)f2bf((yn + rkb[st] * vvv) * gg);
            } }
        if (c + 1 < nchunk) SC_STORE(c + 1);
        __syncthreads();
    }
    float* so = a.out + (samp ? O_WKVS : O_WKVP) + (size_t)(b * 32 + h) * 4096;
#pragma unroll
    for (int i = 0; i < 8; ++i) so[(8 * w + i) * 64 + lane] = S[i];
#undef SC_LOAD
#undef SC_STORE
}

__device__ __forceinline__ int crow(int r, int hi) { return (r & 3) + 8 * (r >> 2) + 4 * hi; }
__device__ __forceinline__ s16x4 vtr(const LAS unsigned char* p) { typedef short v4i16_t __attribute__((ext_vector_type(4))); return __builtin_bit_cast(s16x4, __builtin_amdgcn_ds_read_tr16_b64_v4i16((LAS v4i16_t*)p)); }
__device__ __forceinline__ void attn_unit(Frame& F, const Args& a, int qbase, int kvbase, int hp, int nt0, int ntstep, int NT, int nkeys, int nrg_valid, int nq_valid, float lam) {
    const int lane = F.lane, wid = F.wave, tid = F.tid, r32 = lane & 31, hi = lane >> 5, rg = wid >> 1, sub = wid & 1;
    const bf16* Q = (const bf16*)((unsigned char*)a.out + DO_Q); bf16* O = (bf16*)((unsigned char*)a.out + DO_Q);
    const bf16* KB = (const bf16*)(a.ws + WS_KB); const bf16* VB = (const bf16*)(a.ws + WS_VB);
    LAS unsigned char* lds = F.lds; LAS float* wsf = (LAS float*)(lds + ATT_WSF_OFF) + wid * 64;
    const int myNT = rg < nrg_valid ? nt0 + ntstep * (rg >> 1) : 0;
    bf16x8 qr[4];
#pragma unroll
    for (int d0 = 0; d0 < 4; ++d0) qr[d0] = *(const bf16x8*)(Q + (size_t)(qbase + rg * 32 + r32) * DM + (2 * hp + sub) * 64 + d0 * 16 + hi * 8);
    f32x16 o[4];
#pragma unroll
    for (int d = 0; d < 4; ++d)
#pragma unroll
        for (int i = 0; i < 16; ++i) o[d][i] = 0.f;
    float mrun = -1e30f, lsum = 0.f;
    u32x4 pk[4];
#define AT_LOAD(j) do { const size_t krow = (size_t)(kvbase + (j) * 64 + (tid & 63)) * DM; \
        pk[0] = *(const u32x4*)(KB + krow + (2 * hp) * 64 + (tid >> 6) * 8); pk[1] = *(const u32x4*)(KB + krow + (2 * hp + 1) * 64 + (tid >> 6) * 8); \
        pk[2] = *(const u32x4*)(VB + krow + hp * 128 + (tid >> 6) * 8); pk[3] = *(const u32x4*)(VB + krow + hp * 128 + ((tid >> 6) + 8) * 8); } while (0)
#define AT_STORE(j) do { LAS unsigned char* sb = lds + ((j) & 1) * 32768; const int key = tid & 63, c0 = tid >> 6, c1 = c0 + 8; \
        *(LAS u32x4*)(sb + c0 * 1024 + key * 16) = pk[0]; *(LAS u32x4*)(sb + 8192 + c0 * 1024 + key * 16) = pk[1]; \
        *(LAS u32x4*)(sb + 16384 + (c0 >> 2) * 4096 + (key >> 4) * 1024 + (key & 15) * 64 + (c0 & 3) * 16) = pk[2]; \
        *(LAS u32x4*)(sb + 16384 + (c1 >> 2) * 4096 + (key >> 4) * 1024 + (key & 15) * 64 + (c1 & 3) * 16) = pk[3]; } while (0)
    AT_LOAD(0); AT_STORE(0);
    __syncthreads();
    const int vtoff = ((lane >> 4) & 1) * 32 + (lane & 3) * 8 + (4 * hi + ((lane & 15) >> 2)) * 64;
    for (int j = 0; j < NT; ++j) {
        if (j + 1 < NT) AT_LOAD(j + 1);
        if (j < myNT) {
            const LAS unsigned char* sb = lds + (j & 1) * 32768; const LAS unsigned char* Ks = sb + sub * 8192; const LAS unsigned char* Vs = sb + 16384;
            f32x16 p0, p1;
#pragma unroll
            for (int i = 0; i < 16; ++i) { p0[i] = 0.f; p1[i] = 0.f; }
#pragma unroll
            for (int d0 = 0; d0 < 4; ++d0) {
                const bf16x8 k0 = *(const LAS bf16x8*)(Ks + (2 * d0 + hi) * 1024 + r32 * 16), k1 = *(const LAS bf16x8*)(Ks + (2 * d0 + hi) * 1024 + 512 + r32 * 16);
                p0 = __builtin_amdgcn_mfma_f32_32x32x16_bf16(k0, qr[d0], p0, 0, 0, 0); p1 = __builtin_amdgcn_mfma_f32_32x32x16_bf16(k1, qr[d0], p1, 0, 0, 0);
            }
            if ((j + 1) * 64 > nkeys) {
#pragma unroll
                for (int i = 0; i < 16; ++i) { const int kx = j * 64 + crow(i, hi); if (kx >= nkeys) p0[i] = -1e30f; if (kx + 32 >= nkeys) p1[i] = -1e30f; }
            }
            float rm = p0[0];
#pragma unroll
            for (int i = 1; i < 16; ++i) rm = fmaxf(rm, p0[i]);
#pragma unroll
            for (int i = 0; i < 16; ++i) rm = fmaxf(rm, p1[i]);
            rm = fmaxf(rm, __shfl_xor(rm, 32));
            const float mnew = fmaxf(mrun, rm), alpha = fexp2(mrun - mnew); mrun = mnew;
            float ps = 0.f;
#pragma unroll
            for (int i = 0; i < 16; ++i) { p0[i] = fexp2(p0[i] - mnew); p1[i] = fexp2(p1[i] - mnew); ps += p0[i] + p1[i]; }
            lsum = lsum * alpha + ps;
            if (hi == 0) wsf[r32] = alpha;
            LDS_WAIT();
#pragma unroll
            for (int i = 0; i < 16; ++i) { const float f = wsf[crow(i, hi)];
#pragma unroll
                for (int d = 0; d < 4; ++d) o[d][i] *= f; }
            bf16x8 pa[4];
            { u32x4 t0, t1, t2, t3;
              t0.x = cvt_pk_bf16(p0[0], p0[1]); t0.y = cvt_pk_bf16(p0[2], p0[3]); t0.z = cvt_pk_bf16(p0[4], p0[5]); t0.w = cvt_pk_bf16(p0[6], p0[7]);
              t1.x = cvt_pk_bf16(p0[8], p0[9]); t1.y = cvt_pk_bf16(p0[10], p0[11]); t1.z = cvt_pk_bf16(p0[12], p0[13]); t1.w = cvt_pk_bf16(p0[14], p0[15]);
              t2.x = cvt_pk_bf16(p1[0], p1[1]); t2.y = cvt_pk_bf16(p1[2], p1[3]); t2.z = cvt_pk_bf16(p1[4], p1[5]); t2.w = cvt_pk_bf16(p1[6], p1[7]);
              t3.x = cvt_pk_bf16(p1[8], p1[9]); t3.y = cvt_pk_bf16(p1[10], p1[11]); t3.z = cvt_pk_bf16(p1[12], p1[13]); t3.w = cvt_pk_bf16(p1[14], p1[15]);
              pa[0] = __builtin_bit_cast(bf16x8, t0); pa[1] = __builtin_bit_cast(bf16x8, t1); pa[2] = __builtin_bit_cast(bf16x8, t2); pa[3] = __builtin_bit_cast(bf16x8, t3); }
#pragma unroll
            for (int d = 0; d < 4; ++d)
#pragma unroll
                for (int ks = 0; ks < 4; ++ks) {
                    const s16x4 lo = vtr(Vs + d * 4096 + ks * 1024 + vtoff), hh = vtr(Vs + d * 4096 + ks * 1024 + 512 + vtoff);
                    const bf16x8 vf = (bf16x8){lo[0], lo[1], lo[2], lo[3], hh[0], hh[1], hh[2], hh[3]};
                    o[d] = __builtin_amdgcn_mfma_f32_32x32x16_bf16(pa[ks], vf, o[d], 0, 0, 0);
                }
        }
        if (j + 1 < NT) AT_STORE(j + 1);
        __syncthreads();
    }
    lsum += __shfl_xor(lsum, 32);
    if (hi == 0) wsf[32 + r32] = lsum;
    LDS_WAIT();
    LAS float* E = (LAS float*)lds;
    if (myNT > 0) {
#pragma unroll
        for (int i = 0; i < 16; ++i) { const float rl = frcp(wsf[32 + crow(i, hi)]);
#pragma unroll
            for (int d = 0; d < 4; ++d) E[((rg * 2 + sub) * 32 + crow(i, hi)) * 128 + d * 32 + r32] = o[d][i] * rl; }
    }
    __syncthreads();
    if (myNT > 0) {
        const f32x2 sg = *(const f32x2*)(a.in[29] + 2 * lane);
        for (int qq = 0; qq < 16; ++qq) { const int q = 16 * sub + qq;
            if (q >= nq_valid) break;
            const f32x2 e0 = *(const LAS f32x2*)(E + ((rg * 2 + 0) * 32 + q) * 128 + 2 * lane), e1 = *(const LAS f32x2*)(E + ((rg * 2 + 1) * 32 + q) * 128 + 2 * lane);
            const f32x2 ov = e0 - e1 * lam; const float ss = wave_sum(ov[0] * ov[0] + ov[1] * ov[1]);
            const float sc = __builtin_amdgcn_rsqf(ss * (1.f / 128.f) + LN_EPS) * (1.f - LAMBDA_INIT);
            *(unsigned*)(O + (size_t)(qbase + rg * 32 + q) * DM + hp * 128 + 2 * lane) = pk2(ov[0] * sc * sg[0], ov[1] * sc * sg[1]);
        }
    }
    __syncthreads();
#undef AT_LOAD
#undef AT_STORE
}

constexpr int NPHASE = 22;
__global__ void __launch_bounds__(NWAVES * 64, 2) mk_fwd(Args args) {
    extern __shared__ __attribute__((aligned(16))) unsigned char lds_raw[];
    Frame F;
    F.lds = (LAS unsigned char*)lds_raw;
    F.MISC = (volatile LAS unsigned*)(F.lds + MISC_OFF);
    F.tid = threadIdx.x; F.lane = F.tid & 63; F.wave = __builtin_amdgcn_readfirstlane(F.tid >> 6);
    F.G = gridDim.x; { const int bx = blockIdx.x; F.vcu = (F.G % 8 == 0) ? (bx % 8) * (F.G / 8) + bx / 8 : bx; }
    unsigned char* ws = args.ws;
    F.ctl = (gu32*)(ws + WS_CTL);
    for (int u = F.tid; u < (LDS_BYTES - LDSCTL_OFF) / 4; u += NWAVES * 64) ((LAS unsigned*)(F.lds + LDSCTL_OFF))[u] = 0u;
    __syncthreads();
    XcdBarrier bar; bar.bar = (unsigned*)(F.ctl + CW_BAR); bar.x = 0; bar.st = nullptr;
    if (MK_SINGLE) bar = xcd_barrier_post((unsigned*)(F.ctl + CW_BAR), F.MISC + 8);
    const int lo = args.ph_lo, hi = args.ph_hi;
#define IN(k) (lo <= (k) && (k) < hi)
#define SEAM(k) do { if (IN(k) && IN((k) + 1)) xcd_barrier(bar); } while (0)
    const float* ln_g = args.in[6]; const float* ln_b = args.in[7];
    float* XF = (float*)(ws + WS_XF); bf16* XBA = (bf16*)(ws + WS_XBA); bf16* XBB = (bf16*)(ws + WS_XBB); bf16* HB = (bf16*)(ws + WS_H);
    unsigned char* dob = (unsigned char*)args.out;

#define FFN_G1(A_, mi) do { pg8::Gemm g{A_, (const bf16*)(ws + WS_WIN + (mi) * WIN_STRIDE), MP, 2 * FF, DM, DM}; pg8::StaticOrder S; S.init(MP, 2 * FF, F.G, (int)blockIdx.x); \
        pg8::EpiSwiGLU E{HB}; pg8::gemm_phase<pg8::EpiSwiGLU, false>(F.lds, g, S, E); } while (0)
#define FFN_G2(mi) do { pg8::Gemm g{HB, (const bf16*)(ws + WS_WOUT + (mi) * WOUT_STRIDE), MP, DM, FF, FF}; pg8::StaticOrder S; S.init(MP, DM, F.G, (int)blockIdx.x); \
        pg8::EpiResid E{XF, XF, ALPHA, 0.5f}; pg8::gemm_phase<pg8::EpiResid, false>(F.lds, g, S, E); } while (0)

    if (IN(0)) { p0_prologue(F, args); } SEAM(0);
    if (IN(1)) { FFN_G1(XBA, 0); } SEAM(1);
    if (IN(2)) { FFN_G2(0); } SEAM(2);
    if (IN(3)) { ln_pass(F, args, ln_g + 0 * DM, ln_b + 0 * DM, XBA, 1); } SEAM(3);
    if (IN(4)) { pg8::Gemm g{XBA, (const bf16*)(ws + WS_WCAT), MP, NCAT, KCAT, DM}; pg8::StaticOrder S; S.init(MP, NCAT, F.G, (int)blockIdx.x);
        pg8::EpiRwkv E{(bf16*)(ws + WS_R), (bf16*)(dob + DO_VV), (bf16*)(ws + WS_L)}; pg8::gemm_phase<pg8::EpiRwkv, true>(F.lds, g, S, E); } SEAM(4);
    if (IN(5)) { pg8::Gemm g{(const bf16*)(ws + WS_L), (const bf16*)(ws + WS_WL2), MP, NL2, KL2, KL2}; pg8::StaticOrder S; S.init(MP, NL2, F.G, (int)blockIdx.x);
        pg8::EpiLora2 E{(bf16*)(dob + DO_WLD), args.in[12], args.in[15]}; pg8::gemm_phase<pg8::EpiLora2, false>(F.lds, g, S, E); } SEAM(5);
    if (IN(6)) {
        for (int u = F.vcu; u < 512; u += F.G) { const int samp = u >= 256, bh = u & 255; scan_unit(F, args, samp, bh >> 5, bh & 31); }
    } SEAM(6);
    if (IN(7)) { pg8::Gemm g{XBA, (const bf16*)(ws + WS_WOR), MP, DM, DM, DM}; pg8::StaticOrder S; S.init(MP, DM, F.G, (int)blockIdx.x);
        pg8::EpiResid E{XF, XF, ALPHA, 1.0f}; pg8::gemm_phase<pg8::EpiResid, false>(F.lds, g, S, E); } SEAM(7);
    if (IN(8)) { ln_pass(F, args, ln_g + 1 * DM, ln_b + 1 * DM, XBA, 0); } SEAM(8);
    if (IN(9)) { FFN_G1(XBA, 1); } SEAM(9);
    if (IN(10)) { FFN_G2(1); } SEAM(10);
    if (IN(11)) { ln_pass(F, args, ln_g + 2 * DM, ln_b + 2 * DM, XBA, 0); } SEAM(11);
    if (IN(12)) { FFN_G1(XBA, 2); } SEAM(12);
    if (IN(13)) { FFN_G2(2); } SEAM(13);
    if (IN(14)) { ln_pass(F, args, ln_g + 3 * DM, ln_b + 3 * DM, XBB, 0); cache_convert(F, args); } SEAM(14);
    if (IN(15)) {
        { pg8::Gemm g{XBA, (const bf16*)(ws + WS_WKV), MP, 2 * DM, DM, DM}; pg8::StaticOrder S; S.init(MP, 2 * DM, F.G, (int)blockIdx.x);
          pg8::EpiKV E{args.out, (bf16*)(ws + WS_KB)}; pg8::gemm_phase<pg8::EpiKV, false>(F.lds, g, S, E); }
        { pg8::Gemm g{XBB, (const bf16*)(ws + WS_WQ), MP, DM, DM, DM}; pg8::StaticOrder S; S.init(MP, DM, F.G, (int)blockIdx.x);
          pg8::EpiQ E{(bf16*)(dob + DO_Q)}; pg8::gemm_phase<pg8::EpiQ, false>(F.lds, g, S, E); }
    } SEAM(15);
    if (IN(16)) {
        const float l0 = args.in[28][F.lane] * args.in[28][64 + F.lane], l1 = args.in[28][128 + F.lane] * args.in[28][192 + F.lane];
        const float lam = __expf(wave_sum(l0)) - __expf(wave_sum(l1)) + LAMBDA_INIT;
        for (int i = 0; i < 8; ++i) { const int pidx = F.vcu + F.G * i; if (pidx >= 2048) break; const int bhp = pidx >> 4, us = pidx & 15, b = bhp >> 4, hp = bhp & 15;
#pragma unroll 1
            for (int k = 0; k < 2; ++k) { const int uq = k ? 31 - us : us;
                attn_unit(F, args, b * RS + 1 + uq * 128, b * T, hp, 2 * uq + 1, 1, 2 * uq + 2, 1 << 30, 4, 32, lam); } }
        for (int u = F.vcu; u < 128; u += F.G) { const int b = u >> 4, hp = u & 15;
            attn_unit(F, args, SROW0 + b * SRS + 1, NB * T + b * KVS, hp, 17, 0, 17, KVS, 1, 16, lam); }
    } SEAM(16);
    if (IN(17)) { pg8::Gemm g{(const bf16*)(dob + DO_Q), (const bf16*)(ws + WS_WOD), MP, DM, DM, DM}; pg8::StaticOrder S; S.init(MP, DM, F.G, (int)blockIdx.x);
        pg8::EpiResid E{XF, XF, ALPHA, 1.0f}; pg8::gemm_phase<pg8::EpiResid, false>(F.lds, g, S, E); } SEAM(17);
    if (IN(18)) { ln_pass(F, args, ln_g + 4 * DM, ln_b + 4 * DM, XBA, 0); } SEAM(18);
    if (IN(19)) { FFN_G1(XBA, 3); } SEAM(19);
    if (IN(20)) { FFN_G2(3); } SEAM(20);
    if (IN(21)) { ln_pass(F, args, ln_g + 5 * DM, ln_b + 5 * DM, XBA, 2); }
#undef IN
#undef SEAM
}

extern "C" void kernel_launch(void* const* d_in, const int* in_sizes, int n_in, void* d_out, int out_size, void* d_ws, size_t ws_size, hipStream_t stream) {
    static int grid = 0;
    if (grid == 0) {
        if (n_in != 31 || (size_t)out_size != O_TOTAL || ws_size < WS_END) { fprintf(stderr, "kernel_launch: unexpected sizes n_in %d out %d ws %zu\n", n_in, out_size, ws_size); grid = -1; return; }
        int dev = 0, cus = 0, per_cu = 0;
        if (hipGetDevice(&dev) != hipSuccess || hipDeviceGetAttribute(&cus, hipDeviceAttributeMultiprocessorCount, dev) != hipSuccess) { grid = -1; return; }
        if (hipFuncSetAttribute((const void*)mk_fwd, hipFuncAttributeMaxDynamicSharedMemorySize, LDS_BYTES) != hipSuccess) { fprintf(stderr, "kernel_launch: hipFuncSetAttribute failed\n"); grid = -1; return; }
        if (hipOccupancyMaxActiveBlocksPerMultiprocessor(&per_cu, (const void*)mk_fwd, NWAVES * 64, LDS_BYTES) != hipSuccess || per_cu < 1) { fprintf(stderr, "kernel_launch: occupancy query says %d\n", per_cu); }
        (void)hipGetLastError();
        grid = cus;
    }
    if (grid < 0) return;
    (void)hipMemsetAsync((char*)d_ws + WS_CTL, 0, CTL_ZERO_BYTES, stream);
    Args a{};
    for (int i = 0; i < 31; ++i) a.in[i] = (const float*)d_in[i];
    a.out = (float*)d_out; a.ws = (unsigned char*)d_ws;
#if MK_SINGLE
    a.ph_lo = 0; a.ph_hi = NPHASE;
    hipLaunchKernelGGL(mk_fwd, dim3(grid), dim3(NWAVES * 64), LDS_BYTES, stream, a);
#else
    for (int p = 0; p < NPHASE; ++p) { a.ph_lo = p; a.ph_hi = p + 1; hipLaunchKernelGGL(mk_fwd, dim3(grid), dim3(NWAVES * 64), LDS_BYTES, stream, a); }
#endif
}
```

```cpp
#include <hip/hip_runtime.h>
#include <cstdio>
#include <cstdint>

#ifndef MK_DUP
#define MK_DUP -1
#endif
#ifndef MK_ABL
#define MK_ABL 0
#endif
#ifndef MK_SINGLE
#define MK_SINGLE 1
#endif

#define GAS __attribute__((address_space(1)))
#define LAS __attribute__((address_space(3)))
typedef unsigned short bf16;
typedef short bf16x8 __attribute__((ext_vector_type(8)));
typedef short s16x4 __attribute__((ext_vector_type(4)));
typedef float f32x2 __attribute__((ext_vector_type(2)));
typedef float f32x4 __attribute__((ext_vector_type(4)));
typedef float f32x16 __attribute__((ext_vector_type(16)));
typedef unsigned u32x2 __attribute__((ext_vector_type(2)));
typedef unsigned u32x4 __attribute__((ext_vector_type(4)));
typedef int i32x4 __attribute__((ext_vector_type(4)));
typedef GAS unsigned gu32;

constexpr int DM = 2048, FF = 5632, T = 4096, NB = 8, TS = 16, PAST = 1024;
constexpr int RS = T + 1;
constexpr int SROW0 = NB * RS;
constexpr int SRS = TS + 1;
constexpr int NROWS = SROW0 + NB * SRS;
constexpr int MP = 33024;
constexpr int KVS = PAST + TS;
constexpr int KVROWS = NB * T + NB * KVS;
constexpr int NCAT = 7168, KCAT = 2048;
constexpr int NL2 = 6144, KL2 = 512;
constexpr float LN_EPS = 1e-5f, GN_EPS = 64e-5f;
constexpr float ALPHA = 1.41421356237f;
constexpr float LOG2E = 1.4426950408889634f;
constexpr float QSCALE = 0.125f * LOG2E;
constexpr float LAMBDA_INIT = 0.35550906f;

constexpr size_t MiB = 1u << 20;
constexpr size_t WS_CTL = 0, CTL_ZERO_BYTES = 1 * MiB;
constexpr size_t WS_WIN = 2 * MiB;
constexpr size_t WIN_STRIDE = (size_t)2 * FF * DM;
constexpr size_t WS_WOUT = 178 * MiB;
constexpr size_t WOUT_STRIDE = (size_t)DM * FF;
constexpr float H8_CLIP = 8.f;
constexpr size_t WS_WCAT = 266 * MiB;
constexpr size_t WS_WL2 = 318 * MiB;
constexpr size_t WS_WOR = 324 * MiB, WS_WOD = 332 * MiB, WS_WKV = 340 * MiB, WS_WQ = 356 * MiB;
constexpr size_t WS_XF = 364 * MiB;
constexpr size_t WS_XBA = 623 * MiB;
constexpr size_t WS_XBB = 753 * MiB;
constexpr size_t WS_H = 883 * MiB;
constexpr size_t WS_PART = 1240 * MiB;
constexpr size_t WS_STATS = 1248 * MiB;
constexpr size_t WS_XQ = 1250 * MiB;
constexpr size_t WS_SX = 1316 * MiB;
constexpr size_t WS_END = 1318 * MiB;
constexpr size_t ACT_BYTES = (size_t)MP * DM * 2;
constexpr size_t WS_MIX2 = WS_H, WS_MIX3 = WS_H + ACT_BYTES, WS_L = WS_H + 2 * ACT_BYTES;
constexpr size_t WS_KB = WS_H, WS_VB = WS_H + 161 * MiB;
constexpr size_t O_YP = 0, O_YS = 67108864, O_KP = 67371008, O_VP = 134479872, O_WKVP = 201588736, O_SHP = 202637312,
                 O_KS = 202653696, O_VS = 202915840, O_WKVS = 203177984, O_SHS = 204226560, O_TOTAL = 204242944;
constexpr size_t DO_Q = 0, DO_R = 0, DO_KR = ACT_BYTES, DO_VV = 2 * ACT_BYTES, DO_Z = 3 * ACT_BYTES, DO_WLD = 3 * ACT_BYTES, DO_AG = 4 * ACT_BYTES;
static_assert(DO_AG + ACT_BYTES <= O_WKVP * 4, "d_out scratch overlays end before the wkv/shift outputs");
constexpr size_t ACT_ELEMS = (size_t)MP * DM;

constexpr int CW_TMO = 0, CW_BAR = 4096;
constexpr int CW_CMAX2 = 131072;
constexpr int CW_CMAX = 65536;

constexpr int RING_BYTES = 131072;
constexpr int LDSCTL_OFF = RING_BYTES, MISC_OFF = LDSCTL_OFF + 320;
constexpr int SCL_OFF = RING_BYTES + 4096;
constexpr int ATT_WSF_OFF = RING_BYTES + 1024;
constexpr int LDS_BYTES = 147456;
constexpr int NWAVES = 8;

#define LDS_WAIT() asm volatile("s_waitcnt lgkmcnt(0)" ::: "memory")
#define VM_WAIT() asm volatile("s_waitcnt vmcnt(0)" ::: "memory")
__device__ __forceinline__ unsigned f2bf(float f) { unsigned u = __builtin_bit_cast(unsigned, f); return (u + 0x7fffu + ((u >> 16) & 1u)) >> 16; }
__device__ __forceinline__ unsigned pk2(float lo, float hi) { return f2bf(lo) | (f2bf(hi) << 16); }
__device__ __forceinline__ float bf2f(unsigned short h) { return __builtin_bit_cast(float, (unsigned)h << 16); }
__device__ __forceinline__ float bflo(unsigned w) { return __builtin_bit_cast(float, w << 16); }
__device__ __forceinline__ float bfhi(unsigned w) { return __builtin_bit_cast(float, w & 0xffff0000u); }
__device__ __forceinline__ unsigned cvt_pk_bf16(float lo, float hi) { unsigned r; asm volatile("v_cvt_pk_bf16_f32 %0, %1, %2" : "=v"(r) : "v"(lo), "v"(hi)); return r; }
__device__ __forceinline__ float fexp2(float x) { return __builtin_amdgcn_exp2f(x); }
__device__ __forceinline__ float frcp(float x) { return __builtin_amdgcn_rcpf(x); }
__device__ __forceinline__ float sigmoidf_(float z) { return frcp(1.f + fexp2(-z * LOG2E)); }
__device__ __forceinline__ float wave_sum(float v) {
#pragma unroll
    for (int o = 1; o < 64; o <<= 1) v += __shfl_xor(v, o);
    return v;
}
template <int CTRL, int RMASK> __device__ __forceinline__ float dpp_f(float old, float v) {
    return __builtin_bit_cast(float, __builtin_amdgcn_update_dpp(__builtin_bit_cast(int, old), __builtin_bit_cast(int, v), CTRL, RMASK, 0xf, false));
}
__device__ __forceinline__ float wave_sum_dpp(float v) {
    v += dpp_f<0x121, 0xf>(0.f, v);
    v += dpp_f<0x122, 0xf>(0.f, v);
    v += dpp_f<0x124, 0xf>(0.f, v);
    v += dpp_f<0x128, 0xf>(0.f, v);
    v += dpp_f<0x142, 0xa>(0.f, v);
    v += dpp_f<0x143, 0xc>(0.f, v);
    return __builtin_bit_cast(float, __builtin_amdgcn_readlane(__builtin_bit_cast(int, v), 63));
}
__device__ __forceinline__ void wave_sum_dpp4(float (&v)[4]) {
#define WS4_STEP(CTRL, RM) _Pragma("unroll") for (int i = 0; i < 4; ++i) v[i] += dpp_f<CTRL, RM>(0.f, v[i]);
    WS4_STEP(0x121, 0xf) WS4_STEP(0x122, 0xf) WS4_STEP(0x124, 0xf) WS4_STEP(0x128, 0xf) WS4_STEP(0x142, 0xa) WS4_STEP(0x143, 0xc)
#undef WS4_STEP
#pragma unroll
    for (int i = 0; i < 4; ++i) v[i] = __builtin_bit_cast(float, __builtin_amdgcn_readlane(__builtin_bit_cast(int, v[i]), 63));
}
__device__ __forceinline__ float wave_max_dpp(float v) {
    v = fmaxf(v, dpp_f<0x121, 0xf>(0.f, v));
    v = fmaxf(v, dpp_f<0x122, 0xf>(0.f, v));
    v = fmaxf(v, dpp_f<0x124, 0xf>(0.f, v));
    v = fmaxf(v, dpp_f<0x128, 0xf>(0.f, v));
    v = fmaxf(v, dpp_f<0x142, 0xa>(0.f, v));
    v = fmaxf(v, dpp_f<0x143, 0xc>(0.f, v));
    return __builtin_bit_cast(float, __builtin_amdgcn_readlane(__builtin_bit_cast(int, v), 63));
}
__device__ __forceinline__ float grp8_sum(float v) {
    v += dpp_f<0xB1, 0xf>(0.f, v);
    v += dpp_f<0x4E, 0xf>(0.f, v);
    v += dpp_f<0x141, 0xf>(0.f, v);
    return v;
}
__device__ __forceinline__ unsigned q8x4(f32x4 v, float inv) {
    const int a = (int)__builtin_rintf(v[0] * inv), b = (int)__builtin_rintf(v[1] * inv), c = (int)__builtin_rintf(v[2] * inv), d = (int)__builtin_rintf(v[3] * inv);
    return ((unsigned)a & 0xffu) | (((unsigned)b & 0xffu) << 8) | (((unsigned)c & 0xffu) << 16) | ((unsigned)d << 24);
}
__device__ __forceinline__ bool row_decode(int r, int& samp, int& b, int& t) {
    if (r < SROW0) { b = r / RS; t = r - b * RS - 1; samp = 0; return t >= 0; }
    if (r < NROWS) { const int q = r - SROW0; b = q / SRS; t = q - b * SRS - 1; samp = 1; return t >= 0; }
    samp = 0; b = 0; t = -1; return false;
}

#define XB_TMO      128
#define XB_XCNT(j)  (256  + 64 * (j))
#define XB_XSUB(j)  (1280 + 64 * (j))
#define XB_XGEN(j)  (2304 + 64 * (j))
#define XB_TOP      3328
#define XB_TOPGEN   3392
#define XCD_BAR_WORDS 3456
#define XB_SPIN_CAP (1u << 24)
__device__ __forceinline__ unsigned xb_ld(unsigned* p)              { return __hip_atomic_load(p, __ATOMIC_RELAXED, __HIP_MEMORY_SCOPE_AGENT); }
__device__ __forceinline__ unsigned xb_add(unsigned* p, unsigned v) { return __hip_atomic_fetch_add(p, v, __ATOMIC_RELAXED, __HIP_MEMORY_SCOPE_AGENT); }
__device__ __forceinline__ unsigned xb_xcc_id() { return (unsigned)__builtin_amdgcn_s_getreg((3 << 11) | 20) & 0xFu; }
#define XB_SPIN(cond, bar) do { unsigned _sp = 0; while (cond) { __builtin_amdgcn_s_sleep(1); \
    if ((++_sp & 255u) == 0u) { if (xb_ld(&(bar)[XB_TMO])) break; if (_sp > XB_SPIN_CAP) { atomicAdd(&(bar)[XB_TMO], 1u); break; } } } } while (0)
struct XcdBarrier { unsigned* bar; unsigned x; volatile LAS unsigned* st; };
__device__ __forceinline__ XcdBarrier xcd_barrier_post(unsigned* bar, volatile LAS unsigned* st) {
    XcdBarrier b; b.bar = bar; b.x = xb_xcc_id(); b.st = st;
    if (threadIdx.x == 0) (void)xb_add(&bar[XB_XCNT(b.x)], 1u);
    return b;
}
__device__ __forceinline__ void xcd_barrier_complete(unsigned* bar, unsigned x, unsigned& nloc, unsigned& nx) {
    const unsigned G = gridDim.x * gridDim.y * gridDim.z;
    unsigned sum, cnt, mine, sp = 0u;
    for (;;) {
        sum = 0u; cnt = 0u; mine = 0u;
#pragma unroll
        for (unsigned j = 0; j < 16; ++j) { const unsigned c = xb_ld(&bar[XB_XCNT(j)]); sum += c; cnt += (c > 0u) ? 1u : 0u; mine = (j == x) ? c : mine; }
        if (sum == G) break;
        __builtin_amdgcn_s_sleep(1);
        if ((++sp & 255u) == 0u) { if (xb_ld(&bar[XB_TMO])) break; if (sp > XB_SPIN_CAP) { atomicAdd(&bar[XB_TMO], 1u); break; } }
    }
    nloc = mine > 0u ? mine : 1u; nx = cnt > 0u ? cnt : 1u;
}
__device__ __forceinline__ void xcd_barrier(const XcdBarrier& b) {
    asm volatile("s_waitcnt vmcnt(0)" ::: "memory");
    __syncthreads();
    if (threadIdx.x == 0) {
        unsigned* bar = b.bar;
        __builtin_amdgcn_s_waitcnt(0);
        unsigned nloc = b.st[0], nx = b.st[1];
        if (nloc == 0u) { xcd_barrier_complete(bar, b.x, nloc, nx); b.st[0] = nloc; b.st[1] = nx; }
        const unsigned old = xb_add(&bar[XB_XSUB(b.x)], 1u);
        const unsigned gen = old / nloc;
        if (old + 1u == (gen + 1u) * nloc) {
            __builtin_amdgcn_fence(__ATOMIC_RELEASE, "agent");
            asm volatile("s_waitcnt vmcnt(0)" ::: "memory");
            const unsigned og = xb_add(&bar[XB_TOP], 1u);
            const unsigned tg = og / nx;
            if (og + 1u == (tg + 1u) * nx) xb_add(&bar[XB_TOPGEN], 1u);
            else XB_SPIN(xb_ld(&bar[XB_TOPGEN]) == tg, bar);
            __builtin_amdgcn_fence(__ATOMIC_ACQUIRE, "agent");
            xb_add(&bar[XB_XGEN(b.x)], 1u);
            asm volatile("s_waitcnt vmcnt(0)" ::: "memory");
        } else {
            XB_SPIN(xb_ld(&bar[XB_XGEN(b.x)]) == gen, bar);
            __builtin_amdgcn_fence(__ATOMIC_ACQUIRE, "agent");
            asm volatile("s_waitcnt vmcnt(0)" ::: "memory");
        }
    }
    __syncthreads();
}

namespace pg8 {
constexpr int BM = 256, BK = 64, HALF = 128, HTB = HALF * BK * 2, STAGE_BYTES = 8 * HTB, NXCD = 8, WGM = 8;
__host__ __device__ __forceinline__ int lds_byte(int r, int c) { const int st = (r >> 4) * 2 + (c >> 5), rr = r & 15, cc = c & 31, ob = rr * 64 + cc * 2; return st * 1024 + (ob ^ (((ob >> 9) & 1) << 5)); }
__host__ __device__ __forceinline__ void stage_rc(int b, int& R, int& C) { const int st = b / 1024, sb = b % 1024, swz = sb ^ (((sb >> 9) & 1) << 5); R = (st >> 1) * 16 + swz / 64; C = (st & 1) * 32 + (swz % 64) / 2; }
__host__ __device__ __forceinline__ int perm32(int rho) { const int n = rho >> 4, i = rho & 15; return 8 * (i >> 2) + 4 * n + (i & 3); }
struct Unit { int pm, pn, ks, k0, nt; };
struct Gemm { const bf16* A; const bf16* Bt; int M, N, K, lda; const bf16 *A1, *A2, *A3; };
struct StaticOrder {
    int nM, nN, nwg, G, c, nt, split, lora;
    __device__ __forceinline__ void init(int M, int N, int K, int G_, int c_, int split_, int lora_ = 0) { split = split_; lora = lora_; nM = M / BM - (split_ ? 1 : 0); nN = N / BM; nwg = nM * nN; G = G_; c = c_; nt = K / BK; }
    __device__ __forceinline__ bool next(int i, Unit& u) const {
        const long L = (long)i * G + c;
        if (L >= (long)nwg + nN * split) return false;
        const bool sp = L >= nwg;
        int wgid = sp ? 0 : (int)L; { const int q = nwg / NXCD, r = nwg % NXCD, xcd = wgid % NXCD, off = wgid / NXCD; wgid = (xcd < r ? xcd * (q + 1) : r * (q + 1) + (xcd - r) * q) + off; }
        const int nig = WGM * nN, gid = wgid / nig, fm = gid * WGM, gsz = (nM - fm) < WGM ? (nM - fm) : WGM;
        const int sidx = sp ? (int)(L - nwg) : 0, sks = sidx / nN, snt = split ? nt / split : nt;
        const int pm_ = sp ? nM : fm + ((wgid % nig) % gsz), pn_ = sp ? sidx % nN : (wgid % nig) / gsz, ks_ = sp ? sks : -1, nt_ = sp ? snt : nt, k0_ = sp ? sks * snt : 0;
        u.pm = pm_; u.pn = pn_; u.ks = ks_; u.k0 = k0_; u.nt = nt_;
        if (lora) { const int kind = pn_ >> 3; u.k0 = kind == 0 ? 0 : (kind == 1 ? 1 : 3); u.nt = kind == 2 ? 4 : 2; }
        return true;
    }
};
__device__ __forceinline__ f32x4 mma16(bf16x8 b, bf16x8 a, f32x4 c) { return __builtin_amdgcn_mfma_f32_16x16x32_bf16(b, a, c, 0, 0, 0); }
__device__ __forceinline__ i32x4 mma16(bf16x8 b, bf16x8 a, i32x4 c) { return __builtin_amdgcn_mfma_i32_16x16x64_i8(__builtin_bit_cast(i32x4, b), __builtin_bit_cast(i32x4, a), c, 0, 0, 0); }
template <class Epi>
__device__ __forceinline__ void gemm_phase(LAS unsigned char* lds, const Gemm g, const StaticOrder& S, const Epi& E) {
    const int tid = threadIdx.x, wid = __builtin_amdgcn_readfirstlane(tid >> 6), lane = tid & 63, wr = wid >> 2, wc = wid & 3, fr = lane & 15, fq = lane >> 4;
    const int K = g.K, lda = g.lda;
    const bf16* a0_ = g.A; const bf16* a1_ = g.A1; const bf16* a2_ = g.A2; const bf16* a3_ = g.A3; asm volatile("" : "+s"(a0_), "+s"(a1_), "+s"(a2_), "+s"(a3_));
    unsigned voffA[2], voffB[2];
#pragma unroll
    for (int i = 0; i < 2; ++i) { int R, C; stage_rc(tid * 16 + i * 8192, R, C); const int Rb = Epi::PERM ? ((R & ~31) + perm32(R & 31)) : R;
        voffA[i] = (unsigned)(R * lda + C) * 2u; voffB[i] = (unsigned)(Rb * K + C) * 2u; }
    const size_t kstep = (size_t)(BK * 2);
    const size_t hstepA = (size_t)HALF * lda * 2, hstepB = (size_t)HALF * K * 2;
    const size_t tstepA = 2 * hstepA, tstepB = 2 * hstepB;
    const unsigned ldsw = (unsigned)wid * 1024u;
    const int aoff = lds_byte(wr * 64 + fr, fq * 8), boff = lds_byte(wc * 32 + fr, fq * 8);
#define PG8_SA(b, h) (((b) * 2 + (h)) * HTB)
#define PG8_SB(b, h) ((4 + (b) * 2 + (h)) * HTB)
#define PG8_STAGE(bufoff, gbase, voff) do { _Pragma("unroll") for (int _i = 0; _i < 2; ++_i) \
        __builtin_amdgcn_global_load_lds((const unsigned*)((const char*)(gbase) + (voff)[_i]), (LAS unsigned*)(lds + (bufoff) + ldsw + _i * 8192), 16, 0, 0); } while (0)
#define PG8_LDA(dst, b, h) do { _Pragma("unroll") for (int m = 0; m < 4; ++m) _Pragma("unroll") for (int k = 0; k < 2; ++k) dst[m][k] = *(const LAS bf16x8*)(lds + PG8_SA(b, h) + aoff + m * 2048 + k * 1024); } while (0)
#define PG8_LDB(dst, b, h) do { _Pragma("unroll") for (int n = 0; n < 2; ++n) _Pragma("unroll") for (int k = 0; k < 2; ++k) dst[n][k] = *(const LAS bf16x8*)(lds + PG8_SB(b, h) + boff + n * 2048 + k * 1024); } while (0)
#define PG8_MMA(ai, bj, At, Bt) do { __builtin_amdgcn_s_setprio(1); _Pragma("unroll") for (int m = 0; m < 4; ++m) _Pragma("unroll") for (int n = 0; n < 2; ++n) _Pragma("unroll") for (int k = 0; k < 2; ++k) \
        acc[ai][bj][m][n] = mma16(Bt[n][k], At[m][k], acc[ai][bj][m][n]); __builtin_amdgcn_s_setprio(0); } while (0)
#define PG8_WAIT_V(n) asm volatile("s_waitcnt vmcnt(" #n ")" ::: "memory")
#define PG8_WAIT_L(n) asm volatile("s_waitcnt lgkmcnt(" #n ")" ::: "memory")
#define PG8_BAR __builtin_amdgcn_s_barrier()
#define PG8_SCHED __builtin_amdgcn_sched_barrier(0)
#define PG8_ABASE(u) ((const char*)(a1_ ? ((u).pn < 8 ? a0_ : ((u).pn < 16 ? a1_ : ((u).pn < 24 ? a2_ : a3_))) : a0_) + (size_t)(u).pm * tstepA + (size_t)(u).k0 * kstep)
#define PG8_BBASE(u) ((const char*)g.Bt + (size_t)(u).pn * tstepB + (size_t)(u).k0 * kstep)
    Unit cur, nxt; int ui = 0;
    if (!S.next(0, cur)) return;
    typedef typename Epi::AccT AccT;
    AccT acc[2][2][4][2];
#pragma unroll
    for (int a = 0; a < 2; ++a)
#pragma unroll
        for (int b = 0; b < 2; ++b)
#pragma unroll
            for (int m = 0; m < 4; ++m)
#pragma unroll
                for (int n = 0; n < 2; ++n) acc[a][b][m][n] = AccT{};
    bf16x8 At[4][2], B0[2][2], B1[2][2];
    const char* cA = PG8_ABASE(cur); const char* cB = PG8_BBASE(cur);
    if constexpr (Epi::PRE) E.stage(lds, cur, wid, lane, 0);
    PG8_STAGE(PG8_SB(0, 0), cB, voffB); PG8_STAGE(PG8_SB(0, 1), cB + hstepB, voffB); PG8_STAGE(PG8_SA(0, 0), cA, voffA); PG8_STAGE(PG8_SA(0, 1), cA + hstepA, voffA);
    if (wr == 1) PG8_BAR;
    PG8_WAIT_V(2); PG8_BAR;
    PG8_STAGE(PG8_SB(1, 0), cB + kstep, voffB); PG8_STAGE(PG8_SA(1, 0), cA + kstep, voffA); PG8_STAGE(PG8_SB(1, 1), cB + hstepB + kstep, voffB);
    PG8_WAIT_V(6); PG8_BAR;
    for (;;) {
        const bool has_next = S.next(ui + 1, nxt);
        const char* nA = has_next ? PG8_ABASE(nxt) : cA; const char* nB = has_next ? PG8_BBASE(nxt) : cB;
        const int nt = cur.nt;
        for (int t = 0; t < nt; t += 2) {
            const bool last = (t == nt - 2);
            const char* a1 = cA + (size_t)(t + 1) * kstep;
            const char* a2 = last ? nA : cA + (size_t)(t + 2) * kstep; const char* b2 = last ? nB : cB + (size_t)(t + 2) * kstep;
            const char* a3 = a2 + kstep; const char* b3 = b2 + kstep;
            PG8_LDB(B0, 0, 0); PG8_LDB(B1, 0, 1); PG8_SCHED; PG8_LDA(At, 0, 0); PG8_STAGE(PG8_SA(1, 1), a1 + hstepA, voffA);
            PG8_WAIT_V(8); PG8_WAIT_L(0); PG8_BAR; PG8_MMA(0, 0, At, B0); PG8_MMA(0, 1, At, B1); PG8_BAR; PG8_SCHED;
            PG8_LDA(At, 0, 1); PG8_STAGE(PG8_SB(0, 0), b2, voffB); PG8_STAGE(PG8_SB(0, 1), b2 + hstepB, voffB); PG8_STAGE(PG8_SA(0, 0), a2, voffA);
            PG8_WAIT_V(8); PG8_WAIT_L(0); PG8_BAR; PG8_MMA(1, 0, At, B0); PG8_MMA(1, 1, At, B1); PG8_BAR; PG8_SCHED;
            PG8_LDB(B0, 1, 0); PG8_LDB(B1, 1, 1); PG8_SCHED; PG8_LDA(At, 1, 0); PG8_STAGE(PG8_SA(0, 1), a2 + hstepA, voffA);
            PG8_WAIT_V(8); PG8_WAIT_L(0); PG8_BAR; PG8_MMA(0, 0, At, B0); PG8_MMA(0, 1, At, B1); PG8_BAR; PG8_SCHED;
            PG8_LDA(At, 1, 1); PG8_STAGE(PG8_SB(1, 0), b3, voffB); PG8_STAGE(PG8_SB(1, 1), b3 + hstepB, voffB); PG8_STAGE(PG8_SA(1, 0), a3, voffA);
            PG8_WAIT_V(8); PG8_WAIT_L(0); PG8_BAR; PG8_MMA(1, 0, At, B0); PG8_MMA(1, 1, At, B1); PG8_BAR; PG8_SCHED;
        }
        if (wr == 0) PG8_BAR;
        if constexpr (Epi::PRE) E(acc, cur, wr, wc, fr, fq, lds, ui & 1); else E(acc, cur, wr, wc, fr, fq);
        if (!has_next) break;
#pragma unroll
        for (int a = 0; a < 2; ++a)
#pragma unroll
            for (int b = 0; b < 2; ++b)
#pragma unroll
                for (int m = 0; m < 4; ++m)
#pragma unroll
                    for (int n = 0; n < 2; ++n) acc[a][b][m][n] = AccT{};
        cur = nxt; cA = nA; cB = nB; ++ui;
        if constexpr (Epi::PRE) E.stage(lds, cur, wid, lane, ui & 1);
        if (wr == 1) PG8_BAR;
    }
    PG8_WAIT_V(0);
    PG8_BAR;
#undef PG8_SA
#undef PG8_SB
#undef PG8_STAGE
#undef PG8_LDA
#undef PG8_LDB
#undef PG8_MMA
#undef PG8_WAIT_V
#undef PG8_WAIT_L
#undef PG8_BAR
#undef PG8_SCHED
#undef PG8_ABASE
#undef PG8_BBASE
}

typedef f32x4 Acc[2][2][4][2];
struct EpiSwiGLU {
    typedef f32x4 AccT;
    static constexpr bool PERM = true;
    static constexpr bool PRE = false;
    bf16* H;
    __device__ __forceinline__ void operator()(const Acc& acc, const Unit& u, int wr, int wc, int fr, int fq) const {
        const int row0 = u.pm * BM + wr * 64 + fr, col0 = u.pn * HALF + wc * 32 + 8 * fq;
#pragma unroll
        for (int ai = 0; ai < 2; ++ai)
#pragma unroll
            for (int m = 0; m < 4; ++m) {
                bf16* rowp = H + (size_t)(row0 + ai * HALF + m * 16) * FF + col0;
                float h[8];
#pragma unroll
                for (int n = 0; n < 2; ++n)
#pragma unroll
                    for (int e = 0; e < 4; ++e) { const float gt = acc[ai][0][m][n][e], up = acc[ai][1][m][n][e]; h[4 * n + e] = gt * sigmoidf_(gt) * up; }
                u32x4 w; w.x = cvt_pk_bf16(h[0], h[1]); w.y = cvt_pk_bf16(h[2], h[3]); w.z = cvt_pk_bf16(h[4], h[5]); w.w = cvt_pk_bf16(h[6], h[7]);
                *(u32x4*)rowp = w;
            }
    }
};
typedef i32x4 AccI[2][2][4][2];
struct EpiSwiGLUI8 {
    typedef i32x4 AccT;
    static constexpr bool PERM = true;
    static constexpr bool PRE = true;
    bf16* H; const float* sx; const float* cmax;
    __device__ __forceinline__ void stage(LAS unsigned char* lds, const Unit& u, int wid, int lane, int par) const {
        const float* src = wid < 4 ? sx + (size_t)u.pm * BM + wid * 64 + lane : cmax + (size_t)u.pn * BM + (wid - 4) * 64 + lane;
        __builtin_amdgcn_global_load_lds((const unsigned*)src, (LAS unsigned*)(lds + SCL_OFF + par * 2048 + wid * 256), 4, 0, 0);
    }
    __device__ __forceinline__ void operator()(const AccI& acc, const Unit& u, int wr, int wc, int fr, int fq, const LAS unsigned char* lds, int par) const {
        const int row0 = u.pm * BM + wr * 64 + fr, col0 = u.pn * HALF + wc * 32 + 8 * fq, cb = wc * 32 + 8 * fq;
        const LAS float* sl = (const LAS float*)(lds + SCL_OFF + par * 2048); const LAS float* cl = sl + 256;
        constexpr float Q2 = -LOG2E / (127.f * 127.f), QU = -(127.f / H8_CLIP) / (LOG2E * 127.f * 127.f);
        f32x2 gs[4], us[4];
        { const f32x4 g0 = *(const LAS f32x4*)(cl + cb) * Q2, g1 = *(const LAS f32x4*)(cl + cb + 4) * Q2, u0 = *(const LAS f32x4*)(cl + cb + HALF) * QU, u1 = *(const LAS f32x4*)(cl + cb + HALF + 4) * QU;
          gs[0] = (f32x2){g0[0], g0[1]}; gs[1] = (f32x2){g0[2], g0[3]}; gs[2] = (f32x2){g1[0], g1[1]}; gs[3] = (f32x2){g1[2], g1[3]};
          us[0] = (f32x2){u0[0], u0[1]}; us[1] = (f32x2){u0[2], u0[3]}; us[2] = (f32x2){u1[0], u1[1]}; us[3] = (f32x2){u1[2], u1[3]}; }
#pragma unroll
        for (int ai = 0; ai < 2; ++ai)
#pragma unroll
            for (int m = 0; m < 4; ++m) {
                const int r = row0 + ai * HALF + m * 16; const float sr = sl[wr * 64 + fr + ai * HALF + m * 16]; const f32x2 sr2 = (f32x2){sr, sr};
                unsigned char* rowp = (unsigned char*)H + (size_t)r * FF + col0;
                u32x2 w = (u32x2){0u, 0u};
#pragma unroll
                for (int p = 0; p < 4; ++p) {
                    const int n = p >> 1, e = (p & 1) * 2;
                    const f32x2 cg = (f32x2){(float)acc[ai][0][m][n][e], (float)acc[ai][0][m][n][e + 1]}, cu = (f32x2){(float)acc[ai][1][m][n][e], (float)acc[ai][1][m][n][e + 1]};
                    const f32x2 z = cg * (sr2 * gs[p]), up = cu * (sr2 * us[p]);
                    const f32x2 dn = (f32x2){fexp2(z[0]), fexp2(z[1])} + (f32x2){1.f, 1.f};
                    const f32x2 t = z * (f32x2){frcp(dn[0]), frcp(dn[1])};
                    const f32x2 q = __builtin_elementwise_fma(t, up, (f32x2){128.f, 128.f});
                    unsigned wd = n ? w.y : w.x;
                    wd = __builtin_amdgcn_cvt_pk_u8_f32(q[0], e, wd); wd = __builtin_amdgcn_cvt_pk_u8_f32(q[1], e + 1, wd);
                    if (n) w.y = wd; else w.x = wd;
                }
                w.x ^= 0x80808080u; w.y ^= 0x80808080u;
                *(u32x2*)rowp = w;
            }
    }
};
template <int HALFSC> struct ResidAcc { typedef f32x4 T; };
template <> struct ResidAcc<1> { typedef i32x4 T; };
template <int HALFSC, int RAWIN = 0> struct EpiResid {
    typedef typename ResidAcc<HALFSC>::T AccT;
    static constexpr bool PERM = true;
    static constexpr bool PRE = false;
    static constexpr float alpha = ALPHA, s = HALFSC ? 0.5f : 1.0f;
    bf16* VF; const float* st; const float* g; const float* b; float* PART; const float* cmax; const float* xin;
    __device__ __forceinline__ void operator()(const AccT (&acci)[2][2][4][2], const Unit& u, int wr, int wc, int fr, int fq) const {
        const int rl0 = wr * 64 + fr, col0 = u.pn * BM + wc * 32 + 8 * fq;
        f32x4 acc[2][2][4][2];
        if constexpr (HALFSC) {
#pragma unroll
            for (int bj = 0; bj < 2; ++bj)
#pragma unroll
                for (int n = 0; n < 2; ++n) { const f32x4 cs = *(const f32x4*)(cmax + col0 + bj * HALF + n * 4) * (H8_CLIP / (127.f * 127.f));
#pragma unroll
                    for (int ai = 0; ai < 2; ++ai)
#pragma unroll
                        for (int m = 0; m < 4; ++m) { const i32x4 q = acci[ai][bj][m][n]; acc[ai][bj][m][n] = (f32x4){(float)q[0], (float)q[1], (float)q[2], (float)q[3]} * cs; } }
        } else {
#pragma unroll
            for (int ai = 0; ai < 2; ++ai)
#pragma unroll
                for (int bj = 0; bj < 2; ++bj)
#pragma unroll
                    for (int m = 0; m < 4; ++m)
#pragma unroll
                        for (int n = 0; n < 2; ++n) acc[ai][bj][m][n] = acci[ai][bj][m][n];
        }
        bf16* vf_ = VF; float* part_ = PART; const float* st_ = st; const float* g_ = g; const float* b_ = b;
        if (u.ks >= 0) {
#pragma unroll
            for (int ai = 0; ai < 2; ++ai)
#pragma unroll
                for (int m = 0; m < 4; ++m) { float* p = part_ + ((size_t)(u.ks * BM + rl0 + ai * HALF + m * 16)) * DM + col0;
                    if (rl0 + ai * HALF + m * 16 < NROWS - (MP - BM)) {
#pragma unroll
                        for (int bj = 0; bj < 2; ++bj)
#pragma unroll
                            for (int n = 0; n < 2; ++n) *(f32x4*)(p + bj * HALF + n * 4) = acc[ai][bj][m][n]; } }
            return;
        }
        f32x4 gv[2][2], bv[2][2];
#pragma unroll
        for (int bj = 0; bj < 2; ++bj)
#pragma unroll
            for (int n = 0; n < 2; ++n) { gv[bj][n] = (f32x4){1.f, 1.f, 1.f, 1.f}; bv[bj][n] = (f32x4){0.f, 0.f, 0.f, 0.f};
                if (st_) { gv[bj][n] = *(const f32x4*)(g_ + col0 + bj * HALF + n * 4); bv[bj][n] = *(const f32x4*)(b_ + col0 + bj * HALF + n * 4); } }
#pragma unroll
        for (int ai = 0; ai < 2; ++ai)
#pragma unroll
            for (int m = 0; m < 4; ++m) {
                const int r = u.pm * BM + rl0 + ai * HALF + m * 16; const size_t off = (size_t)r * DM + col0;
                float mu = 0.f, rs = 1.f; if (st_) { const f32x2 t = *(const f32x2*)(st_ + 2 * (size_t)r); mu = t[0]; rs = t[1]; }
                const int bb_ = r / RS, tt_ = r - bb_ * RS - 1; const float* xr_ = xin + (size_t)(bb_ * T + (tt_ < 0 ? 0 : tt_)) * DM + col0;
#pragma unroll
                for (int bj = 0; bj < 2; ++bj) { u32x4 w8 = (u32x4){0u, 0u, 0u, 0u}; if (!RAWIN) w8 = *(const u32x4*)(vf_ + off + bj * HALF); f32x4 o[2];
#pragma unroll
                    for (int n = 0; n < 2; ++n) { f32x4 x;
                        if (RAWIN) { x = *(const f32x4*)(xr_ + bj * HALF + n * 4); if (tt_ < 0) x = (f32x4){0.f, 0.f, 0.f, 0.f}; }
                        else { const unsigned wa = n ? w8.z : w8.x, wb = n ? w8.w : w8.y; const f32x4 v = (f32x4){bflo(wa), bfhi(wa), bflo(wb), bfhi(wb)}; x = (v - mu) * rs * gv[bj][n] + bv[bj][n]; }
                        o[n] = x * alpha + acc[ai][bj][m][n] * s; }
                    u32x4 wo; wo.x = cvt_pk_bf16(o[0][0], o[0][1]); wo.y = cvt_pk_bf16(o[0][2], o[0][3]); wo.z = cvt_pk_bf16(o[1][0], o[1][1]); wo.w = cvt_pk_bf16(o[1][2], o[1][3]);
                    *(u32x4*)(vf_ + off + bj * HALF) = wo; }
            }
    }
};
struct EpiRwkv {
    typedef f32x4 AccT;
    static constexpr bool PERM = true;
    static constexpr bool PRE = false;
    bf16* RKV; float* Z;
    __device__ __forceinline__ void operator()(const Acc& acc, const Unit& u, int wr, int wc, int fr, int fq) const {
        const int row0 = u.pm * BM + wr * 64 + fr;
        bf16* rkv_ = RKV; float* z_ = Z; asm volatile("" : "+s"(rkv_), "+s"(z_));
        if (u.pn < 24) {
            bf16* base = rkv_ + (size_t)(u.pn >> 3) * ACT_ELEMS; const int col0 = (u.pn & 7) * BM + wc * 32 + 8 * fq;
#pragma unroll
            for (int ai = 0; ai < 2; ++ai)
#pragma unroll
                for (int m = 0; m < 4; ++m)
#pragma unroll
                    for (int bj = 0; bj < 2; ++bj) { const f32x4 v0 = acc[ai][bj][m][0], v1 = acc[ai][bj][m][1];
                        u32x4 w; w.x = cvt_pk_bf16(v0[0], v0[1]); w.y = cvt_pk_bf16(v0[2], v0[3]); w.z = cvt_pk_bf16(v1[0], v1[1]); w.w = cvt_pk_bf16(v1[2], v1[3]);
                        *(u32x4*)(base + (size_t)(row0 + ai * HALF + m * 16) * DM + col0 + bj * HALF) = w; }
        } else {
            const int col0 = (u.pn - 24) * BM + wc * 32 + 8 * fq;
#pragma unroll
            for (int ai = 0; ai < 2; ++ai)
#pragma unroll
                for (int m = 0; m < 4; ++m)
#pragma unroll
                    for (int bj = 0; bj < 2; ++bj) { float* p = z_ + (size_t)(row0 + ai * HALF + m * 16) * 1024 + col0 + bj * HALF;
                        *(f32x4*)p = acc[ai][bj][m][0]; *(f32x4*)(p + 4) = acc[ai][bj][m][1]; }
        }
    }
};
struct EpiLora2 {
    typedef f32x4 AccT;
    static constexpr bool PERM = true;
    static constexpr bool PRE = false;
    bf16 *WAG, *GGp; const float *w0, *a0;
    __device__ __forceinline__ void operator()(const Acc& acc, const Unit& u, int wr, int wc, int fr, int fq) const {
        const int row0 = u.pm * BM + wr * 64 + fr; const int kind = u.pn >> 3;
        bf16* wag_ = WAG; bf16* gg_ = GGp; const float* w0_ = w0; const float* a0_ = a0; asm volatile("" : "+s"(wag_), "+s"(gg_), "+s"(w0_), "+s"(a0_));
        bf16* base = wag_ + (size_t)kind * ACT_ELEMS; if (kind == 2) base = gg_; const float* bias = w0_; if (kind != 0) bias = a0_;
#pragma unroll
        for (int bj = 0; bj < 2; ++bj) {
            const int col0 = (u.pn & 7) * BM + bj * HALF + wc * 32 + 8 * fq;
            f32x4 b0 = (f32x4){0.f, 0.f, 0.f, 0.f}, b1 = b0;
            if (kind < 2) { b0 = *(const f32x4*)(bias + col0); b1 = *(const f32x4*)(bias + col0 + 4); }
#pragma unroll
            for (int ai = 0; ai < 2; ++ai)
#pragma unroll
                for (int m = 0; m < 4; ++m) { float h[8];
#pragma unroll
                    for (int e = 0; e < 4; ++e) { h[e] = acc[ai][bj][m][0][e] + b0[e]; h[4 + e] = acc[ai][bj][m][1][e] + b1[e]; }
                    if (kind == 0) {
#pragma unroll
                        for (int e = 0; e < 8; ++e) h[e] = -0.60653066f * sigmoidf_(h[e]);
                    } else if (kind == 1) {
#pragma unroll
                        for (int e = 0; e < 8; ++e) h[e] = sigmoidf_(h[e]);
                    }
                    u32x4 w; w.x = cvt_pk_bf16(h[0], h[1]); w.y = cvt_pk_bf16(h[2], h[3]); w.z = cvt_pk_bf16(h[4], h[5]); w.w = cvt_pk_bf16(h[6], h[7]);
                    *(u32x4*)(base + (size_t)(row0 + ai * HALF + m * 16) * DM + col0) = w; }
        }
    }
};
struct EpiKV {
    typedef f32x4 AccT;
    static constexpr bool PERM = true;
    static constexpr bool PRE = false;
    float* out; bf16* KB;
    __device__ __forceinline__ void operator()(const Acc& acc, const Unit& u, int wr, int wc, int fr, int fq) const {
        const int row0 = u.pm * BM + wr * 64 + fr; const int isv = u.pn >= 8 ? 1 : 0; const int col0 = (u.pn & 7) * BM + wc * 32 + 8 * fq;
        float* out_ = out; bf16* kb_ = KB; asm volatile("" : "+s"(out_), "+s"(kb_));
#pragma unroll
        for (int ai = 0; ai < 2; ++ai)
#pragma unroll
            for (int m = 0; m < 4; ++m) {
                const int r = row0 + ai * HALF + m * 16; int samp, b, t;
                if (!row_decode(r, samp, b, t)) continue;
                size_t fofs = O_KP + (size_t)isv * (O_VP - O_KP) + (size_t)(b * T + t) * DM;
                if (samp) fofs = O_KS + (size_t)isv * (O_VS - O_KS) + (size_t)(b * TS + t) * DM;
                float* fo = out_ + fofs + col0;
                bf16* bo = kb_ + (size_t)isv * ((WS_VB - WS_KB) / 2) + (size_t)(samp ? NB * T + b * KVS + PAST + t : b * T + t) * DM + col0;
#pragma unroll
                for (int bj = 0; bj < 2; ++bj) { const f32x4 v0 = acc[ai][bj][m][0], v1 = acc[ai][bj][m][1]; *(f32x4*)(fo + bj * HALF) = v0; *(f32x4*)(fo + bj * HALF + 4) = v1;
                    u32x4 w; w.x = cvt_pk_bf16(v0[0], v0[1]); w.y = cvt_pk_bf16(v0[2], v0[3]); w.z = cvt_pk_bf16(v1[0], v1[1]); w.w = cvt_pk_bf16(v1[2], v1[3]); *(u32x4*)(bo + bj * HALF) = w; }
            }
    }
};
struct EpiKVQ {
    typedef f32x4 AccT;
    static constexpr bool PERM = true;
    static constexpr bool PRE = false;
    float* out; bf16* KB; bf16* Q;
    __device__ __forceinline__ void operator()(const Acc& acc, const Unit& u, int wr, int wc, int fr, int fq) const {
        if (u.pn < 16) { EpiKV e{out, KB}; e(acc, u, wr, wc, fr, fq); return; }
        const int row0 = u.pm * BM + wr * 64 + fr, col0 = (u.pn - 16) * BM + wc * 32 + 8 * fq;
#pragma unroll
        for (int ai = 0; ai < 2; ++ai)
#pragma unroll
            for (int m = 0; m < 4; ++m)
#pragma unroll
                for (int bj = 0; bj < 2; ++bj) { const f32x4 v0 = acc[ai][bj][m][0] * QSCALE, v1 = acc[ai][bj][m][1] * QSCALE;
                    u32x4 w; w.x = cvt_pk_bf16(v0[0], v0[1]); w.y = cvt_pk_bf16(v0[2], v0[3]); w.z = cvt_pk_bf16(v1[0], v1[1]); w.w = cvt_pk_bf16(v1[2], v1[3]);
                    *(u32x4*)(Q + (size_t)(row0 + ai * HALF + m * 16) * DM + col0 + bj * HALF) = w; }
    }
};
struct EpiQ {
    typedef f32x4 AccT;
    static constexpr bool PERM = true;
    static constexpr bool PRE = false;
    bf16* Q;
    __device__ __forceinline__ void operator()(const Acc& acc, const Unit& u, int wr, int wc, int fr, int fq) const {
        const int row0 = u.pm * BM + wr * 64 + fr, col0 = u.pn * BM + wc * 32 + 8 * fq;
#pragma unroll
        for (int ai = 0; ai < 2; ++ai)
#pragma unroll
            for (int m = 0; m < 4; ++m)
#pragma unroll
                for (int bj = 0; bj < 2; ++bj) { const f32x4 v0 = acc[ai][bj][m][0] * QSCALE, v1 = acc[ai][bj][m][1] * QSCALE;
                    u32x4 w; w.x = cvt_pk_bf16(v0[0], v0[1]); w.y = cvt_pk_bf16(v0[2], v0[3]); w.z = cvt_pk_bf16(v1[0], v1[1]); w.w = cvt_pk_bf16(v1[2], v1[3]);
                    *(u32x4*)(Q + (size_t)(row0 + ai * HALF + m * 16) * DM + col0 + bj * HALF) = w; }
    }
};
}

struct Args { const float* in[31]; float* out; unsigned char* ws; int ph_lo, ph_hi; };
struct Frame {
    LAS unsigned char* lds; volatile LAS unsigned* MISC; gu32* ctl;
    int tid, lane, wave, vcu, G;
};

__device__ __forceinline__ void tr_item(const float* W, int N, int k0, int n0, LAS float* scr, int lane, bf16* dst, size_t ldd, const float* sc, int mode) {
    float tv[32];
#pragma unroll
    for (int i = 0; i < 32; ++i) tv[i] = W[(size_t)(k0 + 2 * i + (lane >> 5)) * N + n0 + (lane & 31)];
    if (mode) {
#pragma unroll
        for (int i = 0; i < 32; ++i) { const float s = sc[k0 + 2 * i + (lane >> 5)]; tv[i] *= (mode == 1) ? s : (1.f - s); }
    }
#pragma unroll
    for (int i = 0; i < 32; ++i) scr[(2 * i + (lane >> 5)) * 33 + (lane & 31)] = tv[i];
    LDS_WAIT(); asm volatile("" ::: "memory");
    const int c = lane & 7;
#pragma unroll
    for (int j = 0; j < 4; ++j) { const int n = (lane >> 3) + 8 * j; const LAS float* s = scr + (8 * c) * 33 + n;
        u32x4 o; o.x = pk2(s[0 * 33], s[1 * 33]); o.y = pk2(s[2 * 33], s[3 * 33]); o.z = pk2(s[4 * 33], s[5 * 33]); o.w = pk2(s[6 * 33], s[7 * 33]);
        *(u32x4*)(dst + (size_t)n * ldd + 8 * c) = o; }
    LDS_WAIT(); asm volatile("" ::: "memory");
}

__device__ __forceinline__ void p0_prologue(Frame& F, const Args& a) {
    LAS float* scr = (LAS float*)(F.lds + F.wave * 16384);
    const int gw = F.vcu * NWAVES + F.wave, NGW = F.G * NWAVES, lane = F.lane;
    unsigned char* ws = a.ws;
    constexpr int I_IN = 32 * 352, I_OUT = 88 * 64, I_SQ = 32 * 64, I_KV = 32 * 128, I_L96 = 32 * 3, I_L256 = 32 * 8;
    constexpr int N0 = 4 * I_IN, N1 = N0 + 4 * I_OUT, N2 = N1 + 3 * I_SQ, N3 = N2 + 2 * (2 * I_L96 + I_L256), N4 = N3 + 3 * I_SQ, N5 = N4 + I_KV;
    for (int it = gw; it < N5; it += NGW) {
        if (it < N0) {
            const int mi = it / I_IN, r = it % I_IN, kb = r / 352, nb = r % 352, n0 = nb * 32;
            const int isup = n0 >= FF, c = isup ? n0 - FF : n0, drow = (c >> 7) * 256 + isup * 128 + (c & 127);
            const float* W = a.in[8] + (size_t)mi * DM * 2 * FF; float m = 0.f;
#pragma unroll
            for (int i = 0; i < 32; ++i) m = fmaxf(m, fabsf(W[(size_t)(kb * 64 + 2 * i + (lane >> 5)) * (2 * FF) + n0 + (lane & 31)]));
            m = fmaxf(m, __shfl_xor(m, 32));
            if (lane < 32) atomicMax((unsigned*)(F.ctl + CW_CMAX) + mi * 2 * FF + drow + lane, __float_as_uint(m));
        } else if (it < N1) {
            const int q = it - N0, mi = q / I_OUT, r = q % I_OUT, kb = r / 64, nb = r % 64;
            const float* W = a.in[9] + (size_t)mi * FF * DM; float m = 0.f;
#pragma unroll
            for (int i = 0; i < 32; ++i) m = fmaxf(m, fabsf(W[(size_t)(kb * 64 + 2 * i + (lane >> 5)) * DM + nb * 32 + (lane & 31)]));
            m = fmaxf(m, __shfl_xor(m, 32));
            if (lane < 32) atomicMax((unsigned*)(F.ctl + CW_CMAX2) + mi * DM + nb * 32 + lane, __float_as_uint(m));
        } else if (it < N2) {
            const int q = it - N1, j = q / I_SQ, rr = q % I_SQ, kb = rr / 64, nb = rr % 64;
            tr_item(a.in[11] + (size_t)j * DM * DM, DM, kb * 64, nb * 32, scr, lane, (bf16*)(ws + WS_WCAT) + (size_t)(j * DM + nb * 32) * KCAT + kb * 64, KCAT, nullptr, 0);
        } else if (it < N3) {
            int q = it - N2; const int half = q / (2 * I_L96 + I_L256); q %= (2 * I_L96 + I_L256);
            const float* W; int N, mix, rowoff;
            if (q < I_L96) { W = a.in[13]; N = 96; mix = 1; rowoff = 0; } else if (q < 2 * I_L96) { q -= I_L96; W = a.in[16]; N = 96; mix = 4; rowoff = 96; } else { q -= 2 * I_L96; W = a.in[18]; N = 256; mix = 5; rowoff = 192; }
            const int nbn = N / 32, kb = q / nbn, nb = q % nbn;
            tr_item(W, N, kb * 64, nb * 32, scr, lane, (bf16*)(ws + WS_WCAT) + (size_t)(6144 + half * 512 + rowoff + nb * 32) * KCAT + kb * 64, KCAT, a.in[10] + mix * DM, half ? 1 : 2);
        } else if (it < N4) {
            const int q = it - N3, j = q / I_SQ, r = q % I_SQ, kb = r / 64, nb = r % 64;
            const float* W = j == 0 ? a.in[25] : (j == 1 ? a.in[27] : a.in[30]); const size_t wo = j == 0 ? WS_WOR : (j == 1 ? WS_WQ : WS_WOD);
            tr_item(W, DM, kb * 64, nb * 32, scr, lane, (bf16*)(ws + wo) + (size_t)(nb * 32) * DM + kb * 64, DM, nullptr, 0);
        } else {
            const int q = it - N4, kb = q / 128, nb = q % 128;
            tr_item(a.in[26], 4096, kb * 64, nb * 32, scr, lane, (bf16*)(ws + WS_WKV) + (size_t)(nb * 32) * DM + kb * 64, DM, nullptr, 0);
        }
    }
    const int gt = F.vcu * 512 + F.tid, NGT = F.G * 512;
    for (int i = gt; i < 2 * 64 * KCAT / 8; i += NGT) { const int hf = i / (64 * KCAT / 8), j = i % (64 * KCAT / 8);
        *(u32x4*)((bf16*)(ws + WS_WCAT) + (size_t)(6592 + hf * 512) * KCAT + (size_t)j * 8) = (u32x4){0u, 0u, 0u, 0u}; }
    for (int i = gt; i < NL2 * (KL2 / 8); i += NGT) {
        const int n = i / (KL2 / 8), k8 = (i % (KL2 / 8)) * 8, kind = n >> 11, nn = n & 2047;
        const int klo = kind == 0 ? 0 : (kind == 1 ? 96 : 192), khi = kind == 0 ? 96 : (kind == 1 ? 192 : 448);
        const float* W = kind == 0 ? a.in[14] : (kind == 1 ? a.in[17] : a.in[19]);
        float v[8];
#pragma unroll
        for (int e = 0; e < 8; ++e) { const int k = k8 + e; v[e] = (k >= klo && k < khi) ? W[(size_t)(k - klo) * DM + nn] : 0.f; }
        u32x4 o; o.x = pk2(v[0], v[1]); o.y = pk2(v[2], v[3]); o.z = pk2(v[4], v[5]); o.w = pk2(v[6], v[7]);
        *(u32x4*)((bf16*)(ws + WS_WL2) + (size_t)n * KL2 + k8) = o;
    }
    bf16* XF = (bf16*)(ws + WS_XF); unsigned char* XQ = ws + WS_XQ; float* SX = (float*)(ws + WS_SX);
    for (int r0 = gw; r0 < MP; r0 += 3 * NGW) {
        f32x4 v[3][8];
#pragma unroll
        for (int k = 0; k < 3; ++k) { const int r = r0 + k * NGW; int samp = 0, b = 0, t = 0; const bool ok = r < MP && row_decode(r, samp, b, t);
            const float* src = samp ? a.in[1] + (size_t)(b * TS + t) * DM : a.in[0] + (size_t)(b * T + t) * DM;
#pragma unroll
            for (int j = 0; j < 8; ++j) { v[k][j] = (f32x4){0.f, 0.f, 0.f, 0.f}; if (ok) v[k][j] = *(const f32x4*)(src + 4 * lane + 256 * j); } }
#pragma unroll
        for (int k = 0; k < 3; ++k) { const int r = r0 + k * NGW;
            if (r < MP) { float m = 0.f;
#pragma unroll
                for (int j = 0; j < 8; ++j) { const int c = 4 * lane + 256 * j;
                    if (r >= 128 * 256) { u32x2 w; w.x = pk2(v[k][j][0], v[k][j][1]); w.y = pk2(v[k][j][2], v[k][j][3]); *(u32x2*)(XF + (size_t)r * DM + c) = w; }
                    m = fmaxf(fmaxf(m, fmaxf(fabsf(v[k][j][0]), fabsf(v[k][j][1]))), fmaxf(fabsf(v[k][j][2]), fabsf(v[k][j][3]))); }
                m = wave_max_dpp(m); const float inv = m > 0.f ? 127.f / m : 0.f;
                if (lane == 0) SX[r] = m;
#pragma unroll
                for (int j = 0; j < 8; ++j) *(unsigned*)(XQ + (size_t)r * DM + 4 * lane + 256 * j) = q8x4(v[k][j], inv); } }
    }
}
__device__ __forceinline__ void tr_item_i8(const float* W, int N, int k0, int n0, LAS float* scr, int lane, unsigned char* dst, size_t ldd, const float* cm) {
    float tv[32];
#pragma unroll
    for (int i = 0; i < 32; ++i) tv[i] = W[(size_t)(k0 + 2 * i + (lane >> 5)) * N + n0 + (lane & 31)];
#pragma unroll
    for (int i = 0; i < 32; ++i) scr[(2 * i + (lane >> 5)) * 33 + (lane & 31)] = tv[i];
    LDS_WAIT(); asm volatile("" ::: "memory");
    const int ch = lane & 3;
#pragma unroll
    for (int j = 0; j < 2; ++j) { const int n = (lane >> 2) + 16 * j; const float cmx = cm[n]; const float inv = cmx > 0.f ? 127.f / cmx : 0.f; const LAS float* sp = scr + (16 * ch) * 33 + n;
        u32x4 o;
        o.x = q8x4((f32x4){sp[0 * 33], sp[1 * 33], sp[2 * 33], sp[3 * 33]}, inv); o.y = q8x4((f32x4){sp[4 * 33], sp[5 * 33], sp[6 * 33], sp[7 * 33]}, inv);
        o.z = q8x4((f32x4){sp[8 * 33], sp[9 * 33], sp[10 * 33], sp[11 * 33]}, inv); o.w = q8x4((f32x4){sp[12 * 33], sp[13 * 33], sp[14 * 33], sp[15 * 33]}, inv);
        *(u32x4*)(dst + (size_t)n * ldd + 16 * ch) = o; }
    LDS_WAIT(); asm volatile("" ::: "memory");
}
__device__ __forceinline__ void p0_quant_win(Frame& F, const Args& a) {
    LAS float* scr = (LAS float*)(F.lds + F.wave * 16384);
    const int gw = F.vcu * NWAVES + F.wave, NGW = F.G * NWAVES, lane = F.lane;
    constexpr int I_IN = 32 * 352, I_OUT = 88 * 64;
    for (int it = gw; it < 4 * (I_IN + I_OUT); it += NGW) {
        if (it < 4 * I_IN) {
            const int mi = it / I_IN, r = it % I_IN, kb = r / 352, nb = r % 352, n0 = nb * 32, k0 = kb * 64;
            const int isup = n0 >= FF, c = isup ? n0 - FF : n0, drow = (c >> 7) * 256 + isup * 128 + (c & 127);
            tr_item_i8(a.in[8] + (size_t)mi * DM * 2 * FF, 2 * FF, k0, n0, scr, lane, a.ws + WS_WIN + mi * WIN_STRIDE + (size_t)drow * DM + k0, DM, (const float*)(F.ctl + CW_CMAX) + mi * 2 * FF + drow);
        } else {
            const int q = it - 4 * I_IN, mi = q / I_OUT, r = q % I_OUT, kb = r / 64, nb = r % 64;
            tr_item_i8(a.in[9] + (size_t)mi * FF * DM, DM, kb * 64, nb * 32, scr, lane, a.ws + WS_WOUT + mi * WOUT_STRIDE + (size_t)(nb * 32) * FF + kb * 64, FF, (const float*)(F.ctl + CW_CMAX2) + mi * DM + nb * 32);
        }
    }
}
constexpr int SPECIAL_ROW0 = 128 * 256;
__device__ __forceinline__ void ln_load(const Args& a, int r, int lane, f32x4 (&v)[8]) {
    const bf16* VF = (const bf16*)(a.ws + WS_XF);
#pragma unroll
    for (int j = 0; j < 8; ++j) { const u32x2 w = *(const u32x2*)(VF + (size_t)r * DM + 4 * lane + 256 * j); v[j] = (f32x4){bflo(w.x), bfhi(w.x), bflo(w.y), bfhi(w.y)}; }
}
__device__ __forceinline__ f32x4 ld4(const float* p) { return *(const f32x4*)p; }
__device__ __forceinline__ f32x4 ld4(const LAS float* p) { return *(const LAS f32x4*)p; }
template <typename GP> __device__ __forceinline__ void ln_row(const Args& a, int r, int lane, GP g, GP bta, const float* gprev, const float* bprev, float alpha, float spart, bool own, f32x4 (&v)[8], int nsplit) {
    bf16* VF = (bf16*)(a.ws + WS_XF); float* ST = (float*)(a.ws + WS_STATS); const float* PART = (const float*)(a.ws + WS_PART);
    if (own && r >= SPECIAL_ROW0) {
        float mu = 0.f, rs = 1.f; if (gprev) { const f32x2 t = *(const f32x2*)(ST + 2 * (size_t)r); mu = t[0]; rs = t[1]; }
#pragma unroll
        for (int j = 0; j < 8; ++j) { const int c = 4 * lane + 256 * j; f32x4 x = v[j];
            if (gprev) x = (v[j] - mu) * rs * *(const f32x4*)(gprev + c) + *(const f32x4*)(bprev + c);
            const float* pp = PART + (size_t)(r - SPECIAL_ROW0) * DM + c;
            f32x4 p = (f32x4){0.f, 0.f, 0.f, 0.f};
            if (r < NROWS) { p = *(const f32x4*)pp + *(const f32x4*)(pp + (size_t)256 * DM);
                if (nsplit == 4) p = p + (*(const f32x4*)(pp + (size_t)512 * DM) + *(const f32x4*)(pp + (size_t)768 * DM)); }
            const f32x4 o = x * alpha + p * spart; u32x2 w; w.x = pk2(o[0], o[1]); w.y = pk2(o[2], o[3]); *(u32x2*)(VF + (size_t)r * DM + c) = w;
            v[j] = (f32x4){bflo(w.x), bfhi(w.x), bflo(w.y), bfhi(w.y)}; }
    }
    float s = 0.f;
#pragma unroll
    for (int j = 0; j < 8; ++j) s += (v[j][0] + v[j][1]) + (v[j][2] + v[j][3]);
    const float mean = wave_sum_dpp(s) * (1.f / DM); float s2 = 0.f;
#pragma unroll
    for (int j = 0; j < 8; ++j) { v[j] = v[j] - mean; s2 += (v[j][0] * v[j][0] + v[j][1] * v[j][1]) + (v[j][2] * v[j][2] + v[j][3] * v[j][3]); }
    const float rstd = 1.f / sqrtf(wave_sum_dpp(s2) * (1.f / DM) + LN_EPS);
    if (own && lane == 0) *(f32x2*)(ST + 2 * (size_t)r) = (f32x2){mean, rstd};
#pragma unroll
    for (int j = 0; j < 8; ++j) { const int c = 4 * lane + 256 * j; v[j] = v[j] * rstd * ld4(g + c) + ld4(bta + c); }
}
__device__ __forceinline__ void ln_loadraw(const Args& a, int r, int lane, u32x2 (&w)[8]) {
    const bf16* VF = (const bf16*)(a.ws + WS_XF);
#pragma unroll
    for (int j = 0; j < 8; ++j) w[j] = *(const u32x2*)(VF + (size_t)r * DM + 4 * lane + 256 * j);
}
__device__ __forceinline__ void ln_pass_row(const Args& a, int r, int lane, const u32x2 (&w)[8], const LAS float* g, const LAS float* bta, const float* gprev, const float* bprev, float spart, bf16* XB, int final, int q8, int nsplit) {
    f32x4 v[8];
#pragma unroll
    for (int j = 0; j < 8; ++j) v[j] = (f32x4){bflo(w[j].x), bfhi(w[j].x), bflo(w[j].y), bfhi(w[j].y)};
    asm volatile("" : "+v"(g), "+v"(bta));
    ln_row(a, r, lane, g, bta, gprev, bprev, ALPHA, spart, true, v, nsplit);
    if (final) {
        int samp, b, t; if (row_decode(r, samp, b, t)) { float* o = a.out + (samp ? O_YS + (size_t)(b * TS + t) * DM : O_YP + (size_t)(b * T + t) * DM);
#pragma unroll
            for (int j = 0; j < 8; ++j) *(f32x4*)(o + 4 * lane + 256 * j) = v[j]; }
    } else {
        if (XB) {
#pragma unroll
            for (int j = 0; j < 8; ++j) { u32x2 o; o.x = pk2(v[j][0], v[j][1]); o.y = pk2(v[j][2], v[j][3]); *(u32x2*)(XB + (size_t)r * DM + 4 * lane + 256 * j) = o; }
        }
        if (q8) {
            float m = 0.f;
#pragma unroll
            for (int j = 0; j < 8; ++j) m = fmaxf(fmaxf(m, fmaxf(fabsf(v[j][0]), fabsf(v[j][1]))), fmaxf(fabsf(v[j][2]), fabsf(v[j][3])));
            m = wave_max_dpp(m); const float inv = m > 0.f ? 127.f / m : 0.f;
            if (lane == 0) ((float*)(a.ws + WS_SX))[r] = m;
#pragma unroll
            for (int j = 0; j < 8; ++j) *(unsigned*)(a.ws + WS_XQ + (size_t)r * DM + 4 * lane + 256 * j) = q8x4(v[j], inv);
        }
    }
}
__device__ __forceinline__ void ln_pass(Frame& F, const Args& a, const float* g_, const float* bta_, const float* gprev, const float* bprev, float spart, bf16* XB, int final, int q8, int nsplit) {
    const int gw = F.vcu * NWAVES + F.wave, NGW = F.G * NWAVES, lane = F.lane;
    LAS float* gl = (LAS float*)F.lds; LAS float* bl = gl + DM;
    for (int i = F.tid; i < DM; i += NWAVES * 64) { gl[i] = g_[i]; bl[i] = bta_[i]; }
    __syncthreads();
    const LAS float* g = gl; const LAS float* bta = bl;
    u32x2 cur[3][8], nxt[3][8];
#pragma unroll
    for (int k = 0; k < 3; ++k)
#pragma unroll
        for (int j = 0; j < 8; ++j) { cur[k][j] = (u32x2){0u, 0u}; nxt[k][j] = (u32x2){0u, 0u}; }
#pragma unroll
    for (int k = 0; k < 3; ++k) if (gw + k * NGW < MP) ln_loadraw(a, gw + k * NGW, lane, cur[k]);
    for (int r = gw; r < MP; r += 3 * NGW) {
#pragma unroll
        for (int k = 0; k < 3; ++k) if (r + (3 + k) * NGW < MP) ln_loadraw(a, r + (3 + k) * NGW, lane, nxt[k]);
#pragma unroll
        for (int k = 0; k < 3; ++k) if (r + k * NGW < MP) ln_pass_row(a, r + k * NGW, lane, cur[k], g, bta, gprev, bprev, spart, XB, final, q8, nsplit);
#pragma unroll
        for (int k = 0; k < 3; ++k)
#pragma unroll
            for (int j = 0; j < 8; ++j) cur[k][j] = nxt[k][j];
    }
}
__device__ __forceinline__ void ln_mix_pass(Frame& F, const Args& a, const float* g_, const float* bta_, float spart, int nsplit) {
    const int gw = F.vcu * NWAVES + F.wave, NGW = F.G * NWAVES, lane = F.lane;
    LAS float* gl = (LAS float*)F.lds; LAS float* bl = gl + DM; LAS float* ml = gl + 2 * DM;
    for (int i = F.tid; i < DM; i += NWAVES * 64) { gl[i] = g_[i]; bl[i] = bta_[i]; ml[i] = a.in[10][i]; ml[DM + i] = a.in[10][2 * DM + i]; ml[2 * DM + i] = a.in[10][3 * DM + i]; }
    __syncthreads();
    const LAS float* g = gl; const LAS float* bta = bl;
    bf16* XB = (bf16*)(a.ws + WS_XBA); bf16* M0 = (bf16*)(a.ws + WS_XBB); bf16* M2 = (bf16*)(a.ws + WS_MIX2); bf16* M3 = (bf16*)(a.ws + WS_MIX3);
    for (int blk = gw; blk * 17 < MP; blk += NGW) {
        const int r0 = blk * 17, r1 = (r0 + 17 < MP) ? r0 + 17 : MP;
        f32x4 yp[8], nx[8];
#pragma unroll
        for (int j = 0; j < 8; ++j) yp[j] = (f32x4){0.f, 0.f, 0.f, 0.f};
        ln_load(a, r0, lane, nx);
        { int samp, b, t; const bool ok = row_decode(r0, samp, b, t);
          if (ok && r0 <= SPECIAL_ROW0) { ln_load(a, r0 - 1, lane, yp); ln_row(a, r0 - 1, lane, g, bta, nullptr, nullptr, ALPHA, spart, false, yp, nsplit); } }
        for (int r = r0; r < r1; ++r) {
            int samp, b, t; const bool ok = row_decode(r, samp, b, t);
            f32x4 v[8];
#pragma unroll
            for (int j = 0; j < 8; ++j) v[j] = nx[j];
            if (r + 1 < r1) ln_load(a, r + 1, lane, nx);
            asm volatile("" : "+v"(g), "+v"(bta));
            ln_row(a, r, lane, g, bta, nullptr, nullptr, ALPHA, spart, true, v, nsplit);
            if (!ok && r < NROWS) {
                const bool sm = r >= SROW0; const int bb = sm ? (r - SROW0) / SRS : 0;
#pragma unroll
                for (int j = 0; j < 8; ++j) { v[j] = (f32x4){0.f, 0.f, 0.f, 0.f}; if (sm) v[j] = *(const f32x4*)(a.in[5] + (size_t)bb * DM + 4 * lane + 256 * j); }
            }
            if (ok && t == (samp ? TS - 1 : T - 1)) { float* o = a.out + (samp ? O_SHS : O_SHP) + (size_t)b * DM;
#pragma unroll
                for (int j = 0; j < 8; ++j) *(f32x4*)(o + 4 * lane + 256 * j) = v[j]; }
            const LAS float* mu_ = ml + 4 * lane; asm volatile("" : "+v"(mu_));
#pragma unroll
            for (int j = 0; j < 8; ++j) { const int c = 4 * lane + 256 * j; const size_t off = (size_t)r * DM + c;
                u32x2 w; w.x = pk2(v[j][0], v[j][1]); w.y = pk2(v[j][2], v[j][3]); *(u32x2*)(XB + off) = w;
                if (ok) { const f32x4 d = yp[j] - v[j];
                    const f32x4 m0 = v[j] + d * ld4(mu_ + 0 * DM + 256 * j), m2 = v[j] + d * ld4(mu_ + 1 * DM + 256 * j), m3 = v[j] + d * ld4(mu_ + 2 * DM + 256 * j);
                    w.x = pk2(m0[0], m0[1]); w.y = pk2(m0[2], m0[3]); *(u32x2*)(M0 + off) = w;
                    w.x = pk2(m2[0], m2[1]); w.y = pk2(m2[2], m2[3]); *(u32x2*)(M2 + off) = w;
                    w.x = pk2(m3[0], m3[1]); w.y = pk2(m3[2], m3[3]); *(u32x2*)(M3 + off) = w; }
                yp[j] = v[j]; }
        }
    }
}
__device__ __forceinline__ void lora_hidden_pass(Frame& F, const Args& a) {
    const int gt = F.vcu * 512 + F.tid, NGT = F.G * 512;
    const float* Z = (const float*)((unsigned char*)a.out + DO_Z); bf16* L = (bf16*)(a.ws + WS_L);
    for (int i0 = gt; i0 < MP * 64; i0 += 4 * NGT) {
        const int c = (i0 & 63) * 8;
        f32x4 x0[4], x1[4];
#pragma unroll
        for (int u = 0; u < 4; ++u) { const int i = i0 + u * NGT, r = i >> 6; x0[u] = (f32x4){0.f, 0.f, 0.f, 0.f}; x1[u] = x0[u];
            if (i < MP * 64 && c < 448) { const float* z1 = Z + (size_t)r * 1024 + c; x0[u] = *(const f32x4*)z1; x1[u] = *(const f32x4*)(z1 + 4);
                if (r > 0) { const float* z2 = Z + (size_t)(r - 1) * 1024 + 512 + c; x0[u] = x0[u] + *(const f32x4*)z2; x1[u] = x1[u] + *(const f32x4*)(z2 + 4); } } }
#pragma unroll
        for (int u = 0; u < 4; ++u) { const int i = i0 + u * NGT, r = i >> 6; float h[8];
#pragma unroll
            for (int e = 0; e < 8; ++e) h[e] = 0.f;
            if (c < 448) {
#pragma unroll
                for (int e = 0; e < 8; ++e) { const float x = e < 4 ? x0[u][e & 3] : x1[u][e & 3]; float y;
                    if (c < 96) y = 1.f - 2.f * frcp(fexp2(x * (2.f * LOG2E)) + 1.f); else if (c < 192) y = x; else y = sigmoidf_(x);
                    h[e] = y; }
            }
            if (i < MP * 64) { u32x4 w; w.x = pk2(h[0], h[1]); w.y = pk2(h[2], h[3]); w.z = pk2(h[4], h[5]); w.w = pk2(h[6], h[7]);
                *(u32x4*)(L + (size_t)r * KL2 + c) = w; } }
    }
}

__device__ __forceinline__ void cache_convert(Frame& F, const Args& a) {
    const int gt = F.vcu * 512 + F.tid, NGT = F.G * 512;
    bf16* KB = (bf16*)(a.ws + WS_KB); bf16* VB = (bf16*)(a.ws + WS_VB);
    constexpr int PER = NB * PAST * DM / 8;
    static_assert((2 * PER) % 4 == 0, "cache_convert: four pieces per turn");
    for (int i0 = gt; i0 < 2 * PER; i0 += 4 * NGT) {
        f32x4 v0[4], v1[4];
#pragma unroll
        for (int u = 0; u < 4; ++u) { const int i = i0 + u * NGT; v0[u] = (f32x4){0.f, 0.f, 0.f, 0.f}; v1[u] = v0[u];
            if (i < 2 * PER) { const int which = i >= PER, q = which ? i - PER : i; const float* src = a.in[2 + which] + (size_t)q * 8; v0[u] = *(const f32x4*)src; v1[u] = *(const f32x4*)(src + 4); } }
#pragma unroll
        for (int u = 0; u < 4; ++u) { const int i = i0 + u * NGT;
            if (i < 2 * PER) { const int which = i >= PER, q = which ? i - PER : i; const size_t e = (size_t)q * 8; const int b = (int)(e / ((size_t)PAST * DM)); const size_t rem = e - (size_t)b * PAST * DM;
                u32x4 o; o.x = pk2(v0[u][0], v0[u][1]); o.y = pk2(v0[u][2], v0[u][3]); o.z = pk2(v1[u][0], v1[u][1]); o.w = pk2(v1[u][2], v1[u][3]);
                *(u32x4*)((which ? VB : KB) + (size_t)(NB * T + b * KVS) * DM + rem) = o; } }
    }
}

constexpr int S2_CB = 43264, S2_AL = 0, S2_RH = 4608, S2_BE = 9216, S2_KA = 13824, S2_BH = 18432, S2_KH = 24576, S2_VT = 30720, S2_NT = 36864, S2_MKA = 38400, S2_MBR = 39936, S2_MKR = 41472, S2_PC = 43008;
constexpr int S2_YST = 2 * S2_CB, S2_RKS = S2_YST + 16384, S2_RAW = S2_RKS + 256, S2_END = S2_RAW + 20480;
static_assert(S2_END <= RING_BYTES, "scan LDS map");
__device__ __forceinline__ f32x4 mfma4(float a, float b, f32x4 c) { return __builtin_amdgcn_mfma_f32_16x16x4f32(a, b, c, 0, 0, 0); }
__device__ __forceinline__ void scan_unit(Frame& F, const Args& a, int samp, int b, int h, int abl) {
    const int lane = F.lane, w = F.wave, tid = F.tid, c = lane & 15, q = lane >> 4;
    const int nsteps = samp ? TS : T, row0 = samp ? SROW0 + b * SRS + 1 : b * RS + 1;
    const int niter = (nsteps + 31) >> 5;
    LAS unsigned char* lds = F.lds;
    const bf16* gR = (const bf16*)((unsigned char*)a.out + DO_R); const bf16* gK = (const bf16*)((unsigned char*)a.out + DO_KR);
    const bf16* gV = (const bf16*)((unsigned char*)a.out + DO_VV); const bf16* gW = (const bf16*)((unsigned char*)a.out + DO_WLD);
    const bf16* gA = (const bf16*)((unsigned char*)a.out + DO_AG); const bf16* gG = (const bf16*)(a.ws + WS_XBB);
    bf16* Y = (bf16*)(a.ws + WS_XBA);
    const float kk_w = a.in[20][h * 64 + lane], ka_w = a.in[21][h * 64 + lane], rk_w = a.in[22][h * 64 + lane], lg = a.in[23][h * 64 + lane], lb = a.in[24][h * 64 + lane];
    f32x4 ST[4];
#pragma unroll
    for (int mt = 0; mt < 4; ++mt)
#pragma unroll
        for (int i = 0; i < 4; ++i) ST[mt][i] = (samp && w < 4) ? a.in[4][((size_t)(b * 32 + h) * 64 + 16 * w + c) * 64 + 16 * mt + 4 * q + i] : 0.f;
    u32x4 pre[5];
#define S2_LOAD(it) do { const int t_ = tid - 256, tok_ = t_ >> 3, pc_ = t_ & 7, step_ = (it) * 32 + tok_; const size_t go_ = (size_t)(row0 + step_) * DM + h * 64 + pc_ * 8; const bool ok_ = step_ < nsteps; \
        pre[0] = pre[1] = pre[2] = pre[3] = pre[4] = (u32x4){0u, 0u, 0u, 0u}; \
        if (ok_) { pre[0] = *(const u32x4*)(gR + go_); pre[1] = *(const u32x4*)(gK + go_); pre[2] = *(const u32x4*)(gV + go_); pre[3] = *(const u32x4*)(gW + go_); pre[4] = *(const u32x4*)(gA + go_); } } while (0)
#define S2_STORE() do { const int t_ = tid - 256, tok_ = t_ >> 3, pc_ = t_ & 7; _Pragma("unroll") for (int j = 0; j < 5; ++j) \
        *(LAS u32x4*)(lds + S2_RAW + ((j * 32 + tok_) * 64 + pc_ * 8) * 2) = pre[j]; } while (0)
    u32x4 vrN = (u32x4){0u, 0u, 0u, 0u}, grN = (u32x4){0u, 0u, 0u, 0u};
    const float* lgp = a.in[23] + h * 64 + 8 * (lane & 7); const float* lbp = a.in[24] + h * 64 + 8 * (lane & 7);
    const f32x4 lg0_ = *(const f32x4*)lgp, lg1_ = *(const f32x4*)(lgp + 4), lb0_ = *(const f32x4*)lbp, lb1_ = *(const f32x4*)(lbp + 4);
#define S2_VGLOAD(it) do { const int step_ = (it) * 32 + (w - 4) + 4 * (lane >> 3); vrN = (u32x4){0u, 0u, 0u, 0u}; grN = (u32x4){0u, 0u, 0u, 0u}; \
        if (step_ < nsteps) { const size_t go_ = (size_t)(row0 + step_) * DM + h * 64 + 8 * (lane & 7); vrN = *(const u32x4*)(gV + go_); grN = *(const u32x4*)(gG + go_); } } while (0)
#define S2_POST(it) do { const LAS float* yb_ = (const LAS float*)(lds + S2_YST + ((it) & 1) * 8192); const LAS float* rkb_ = (const LAS float*)(lds + S2_RKS + ((it) & 1) * 128); \
        const int tok_ = (w - 4) + 4 * (lane >> 3), step_ = (it) * 32 + tok_; \
        const f32x4 y0_ = *(const LAS f32x4*)(yb_ + tok_ * 64 + 8 * (lane & 7)), y1_ = *(const LAS f32x4*)(yb_ + tok_ * 64 + 8 * (lane & 7) + 4); const float rk_ = rkb_[tok_]; \
        const float mu_ = grp8_sum(((y0_[0] + y0_[1]) + (y0_[2] + y0_[3])) + ((y1_[0] + y1_[1]) + (y1_[2] + y1_[3]))) * (1.f / 64.f); \
        const f32x4 d0_ = y0_ - mu_, d1_ = y1_ - mu_; \
        const float var_ = grp8_sum(((d0_[0] * d0_[0] + d0_[1] * d0_[1]) + (d0_[2] * d0_[2] + d0_[3] * d0_[3])) + ((d1_[0] * d1_[0] + d1_[1] * d1_[1]) + (d1_[2] * d1_[2] + d1_[3] * d1_[3]))) * (1.f / 64.f); \
        const float rs_ = __builtin_amdgcn_rsqf(var_ + GN_EPS); \
        const f32x4 v0_ = (f32x4){bflo(vrN.x), bfhi(vrN.x), bflo(vrN.y), bfhi(vrN.y)}, v1_ = (f32x4){bflo(vrN.z), bfhi(vrN.z), bflo(vrN.w), bfhi(vrN.w)}; \
        const f32x4 g0_ = (f32x4){bflo(grN.x), bfhi(grN.x), bflo(grN.y), bfhi(grN.y)}, g1_ = (f32x4){bflo(grN.z), bfhi(grN.z), bflo(grN.w), bfhi(grN.w)}; \
        const f32x4 o0_ = (d0_ * rs_ * lg0_ + lb0_ + v0_ * rk_) * g0_, o1_ = (d1_ * rs_ * lg1_ + lb1_ + v1_ * rk_) * g1_; \
        if (step_ < nsteps) { u32x4 w_; w_.x = pk2(o0_[0], o0_[1]); w_.y = pk2(o0_[2], o0_[3]); w_.z = pk2(o1_[0], o1_[1]); w_.w = pk2(o1_[2], o1_[3]); \
            *(u32x4*)(Y + (size_t)(row0 + step_) * DM + h * 64 + 8 * (lane & 7)) = w_; } } while (0)
    if (w >= 4) { S2_LOAD(0); S2_STORE(); if (niter > 1) S2_LOAD(1); }
    __syncthreads();
    for (int it = 0; it < niter; ++it) {
        if (abl != 1) {
            const int ch = w >> 2, t0 = 4 * (w & 3);
            const LAS bf16* raw = (const LAS bf16*)(lds + S2_RAW);
            LAS unsigned char* cb = lds + ch * S2_CB;
            float ldv[16];
#pragma unroll
            for (int t = 0; t < 16; ++t) ldv[t] = bf2f(raw[(3 * 32 + ch * 16 + t) * 64 + lane]);
            float Gm = 0.f, gc = 0.f;
#pragma unroll
            for (int t = 0; t < 16; ++t) { Gm += (t < t0) ? ldv[t] : 0.f; gc += ldv[t]; }
            float G[4]; { float g = Gm;
#pragma unroll
                for (int i = 0; i < 4; ++i) { g += bf2f(raw[(3 * 32 + ch * 16 + t0 + i) * 64 + lane]); G[i] = g; } }
            f32x4 bh, kh, vt;
            float eGm = fexp2(Gm * LOG2E);
            const float eGC = fexp2(gc * LOG2E);
            float rr[4], kr[4], aa[4], kkr[4], ss[4], kmod[4], rks[4];
#pragma unroll
            for (int i = 0; i < 4; ++i) { const int tk = ch * 16 + t0 + i;
                rr[i] = bf2f(raw[(0 * 32 + tk) * 64 + lane]); kr[i] = bf2f(raw[(1 * 32 + tk) * 64 + lane]); vt[i] = bf2f(raw[(2 * 32 + tk) * 64 + lane]); aa[i] = bf2f(raw[(4 * 32 + tk) * 64 + lane]); }
#pragma unroll
            for (int i = 0; i < 4; ++i) { kkr[i] = kr[i] * kk_w; ss[i] = kkr[i] * kkr[i]; kmod[i] = kr[i] * (1.f + (aa[i] - 1.f) * ka_w); rks[i] = rr[i] * kmod[i] * rk_w; }
            wave_sum_dpp4(ss); wave_sum_dpp4(rks);
#pragma unroll
            for (int i = 0; i < 4; ++i) {
                const int tk = ch * 16 + t0 + i, t = t0 + i;
                const float kk = kkr[i] * __builtin_amdgcn_rsqf(fmaxf(ss[i], 1e-24f)), bb = kk * aa[i];
                const float eG = fexp2(G[i] * LOG2E), enG = fexp2(-G[i] * LOG2E), eCG = eGC * enG;
                *(LAS float*)(cb + S2_AL + (t * 72 + lane) * 4) = -kk * eGm;
                *(LAS float*)(cb + S2_BE + (t * 72 + lane) * 4) = bb * enG;
                *(LAS float*)(cb + S2_KA + (t * 72 + lane) * 4) = kmod[i] * enG;
                *(LAS float*)(cb + S2_RH + (t * 72 + lane) * 4) = rr[i] * eG;
                bh[i] = bb * eCG; kh[i] = kmod[i] * eCG; eGm = eG;
                if (lane == 0) *(LAS float*)(lds + S2_RKS + (it & 1) * 128 + tk * 4) = rks[i];
            }
            *(LAS f32x4*)(cb + S2_BH + (lane * 24 + t0) * 4) = bh; *(LAS f32x4*)(cb + S2_KH + (lane * 24 + t0) * 4) = kh; *(LAS f32x4*)(cb + S2_VT + (lane * 24 + t0) * 4) = vt;
            if ((w & 3) == 0) *(LAS float*)(cb + S2_PC + lane * 4) = eGC;
        }
        __syncthreads();
        if (abl != 2) {
            const int ch = w >> 2, tile = w & 3;
            LAS unsigned char* cb = lds + ch * S2_CB;
            const LAS float* Ym = (const LAS float*)(cb + S2_AL + (tile >> 1) * 4608);
            const LAS float* Xm = (const LAS float*)(cb + S2_BE + (tile & 1) * 4608);
            f32x4 acc = (f32x4){0.f, 0.f, 0.f, 0.f};
#pragma unroll
            for (int s2 = 0; s2 < 2; ++s2) {
                const f32x4 ya0 = *(const LAS f32x4*)(Ym + c * 72 + 32 * s2 + 4 * q), ya1 = *(const LAS f32x4*)(Ym + c * 72 + 32 * s2 + 16 + 4 * q);
                const f32x4 xb0 = *(const LAS f32x4*)(Xm + c * 72 + 32 * s2 + 4 * q), xb1 = *(const LAS f32x4*)(Xm + c * 72 + 32 * s2 + 16 + 4 * q);
                const u32x4 pa = (u32x4){cvt_pk_bf16(ya0[0], ya0[1]), cvt_pk_bf16(ya0[2], ya0[3]), cvt_pk_bf16(ya1[0], ya1[1]), cvt_pk_bf16(ya1[2], ya1[3])};
                const u32x4 pb = (u32x4){cvt_pk_bf16(xb0[0], xb0[1]), cvt_pk_bf16(xb0[2], xb0[3]), cvt_pk_bf16(xb1[0], xb1[1]), cvt_pk_bf16(xb1[2], xb1[3])};
                acc = __builtin_amdgcn_mfma_f32_16x16x32_bf16(__builtin_bit_cast(bf16x8, pa), __builtin_bit_cast(bf16x8, pb), acc, 0, 0, 0); }
            LAS float* outm = (LAS float*)(cb + S2_NT + tile * 1536);
#pragma unroll
            for (int i = 0; i < 4; ++i) { const int t = 4 * q + i; const bool keep = (tile < 2) ? (c < t) : (c <= t); outm[t * 24 + c] = keep ? acc[i] : 0.f; }
        }
        __syncthreads();
        if (w < 4) { if (abl != 3) {
#pragma unroll 1
            for (int ch = 0; ch < 2; ++ch) {
                const LAS unsigned char* cb = lds + ch * S2_CB;
                f32x4 al[4], rh[4], bhv[4], khv[4], pcv[4];
#pragma unroll
                for (int mt = 0; mt < 4; ++mt) {
                    al[mt] = *(const LAS f32x4*)(cb + S2_AL + (c * 72 + 16 * mt + 4 * q) * 4); rh[mt] = *(const LAS f32x4*)(cb + S2_RH + (c * 72 + 16 * mt + 4 * q) * 4);
                    bhv[mt] = *(const LAS f32x4*)(cb + S2_BH + ((16 * mt + c) * 24 + 4 * q) * 4); khv[mt] = *(const LAS f32x4*)(cb + S2_KH + ((16 * mt + c) * 24 + 4 * q) * 4);
                    pcv[mt] = *(const LAS f32x4*)(cb + S2_PC + (16 * mt + 4 * q) * 4);
                }
                f32x4 nt = *(const LAS f32x4*)(cb + S2_NT + (c * 24 + 4 * q) * 4); const f32x4 mka = *(const LAS f32x4*)(cb + S2_MKA + (c * 24 + 4 * q) * 4);
                const f32x4 mbr = *(const LAS f32x4*)(cb + S2_MBR + (c * 24 + 4 * q) * 4), mkr = *(const LAS f32x4*)(cb + S2_MKR + (c * 24 + 4 * q) * 4);
                const f32x4 vb = *(const LAS f32x4*)(cb + S2_VT + ((16 * w + c) * 24 + 4 * q) * 4);
                const f32x4 nd1 = *(const LAS f32x4*)(cb + S2_NT + ((4 * q + 1) * 24 + 4 * q) * 4), nd2 = *(const LAS f32x4*)(cb + S2_NT + ((4 * q + 2) * 24 + 4 * q) * 4), nd3 = *(const LAS f32x4*)(cb + S2_NT + ((4 * q + 3) * 24 + 4 * q) * 4);
                if (q == (c >> 2)) nt = (f32x4){0.f, 0.f, 0.f, 0.f};
#define S2_PK8(x0, x1) __builtin_bit_cast(bf16x8, (u32x4){cvt_pk_bf16((x0)[0], (x0)[1]), cvt_pk_bf16((x0)[2], (x0)[3]), cvt_pk_bf16((x1)[0], (x1)[1]), cvt_pk_bf16((x1)[2], (x1)[3])})
                const bf16x8 st01 = S2_PK8(ST[0], ST[1]), st23 = S2_PK8(ST[2], ST[3]);
                const f32x4 zero4 = (f32x4){0.f, 0.f, 0.f, 0.f};
                f32x4 rhs = (f32x4){0.f, 0.f, 0.f, 0.f};
                rhs = __builtin_amdgcn_mfma_f32_16x16x32_bf16(S2_PK8(al[0], al[1]), st01, rhs, 0, 0, 0);
                rhs = __builtin_amdgcn_mfma_f32_16x16x32_bf16(S2_PK8(al[2], al[3]), st23, rhs, 0, 0, 0);
                rhs = __builtin_amdgcn_mfma_f32_16x16x32_bf16(S2_PK8(mka, zero4), S2_PK8(vb, zero4), rhs, 0, 0, 0);
                f32x4 ut = rhs;
#define S2_INBLK() do { ut[1] += nd1[0] * ut[0]; ut[2] += nd2[0] * ut[0] + nd2[1] * ut[1]; ut[3] += nd3[0] * ut[0] + nd3[1] * ut[1] + nd3[2] * ut[2]; } while (0)
                if (q == 0) S2_INBLK();
                const bf16x8 ntb = S2_PK8(nt, zero4);
#pragma unroll
                for (int qq = 1; qq < 4; ++qq) {
                    const f32x4 x = __builtin_amdgcn_mfma_f32_16x16x32_bf16(ntb, S2_PK8(ut, zero4), zero4, 0, 0, 0);
                    if (q == qq) { ut = rhs + x; S2_INBLK(); }
                }
#undef S2_INBLK
                f32x4 yv = (f32x4){0.f, 0.f, 0.f, 0.f};
                yv = __builtin_amdgcn_mfma_f32_16x16x32_bf16(S2_PK8(rh[0], rh[1]), st01, yv, 0, 0, 0);
                yv = __builtin_amdgcn_mfma_f32_16x16x32_bf16(S2_PK8(rh[2], rh[3]), st23, yv, 0, 0, 0);
                const bf16x8 uvb = S2_PK8(ut, vb);
                yv = __builtin_amdgcn_mfma_f32_16x16x32_bf16(S2_PK8(mbr, mkr), uvb, yv, 0, 0, 0);
                LAS float* yst = (LAS float*)(lds + S2_YST + (it & 1) * 8192);
#pragma unroll
                for (int i = 0; i < 4; ++i) yst[(ch * 16 + 4 * q + i) * 64 + 16 * w + c] = yv[i];
#pragma unroll
                for (int mt = 0; mt < 4; ++mt) ST[mt] = __builtin_amdgcn_mfma_f32_16x16x32_bf16(S2_PK8(bhv[mt], khv[mt]), uvb, ST[mt] * pcv[mt], 0, 0, 0);
#undef S2_PK8
            } }
        } else if (abl != 4) {
            if (it + 1 < niter) S2_STORE();
            if (it + 2 < niter) S2_LOAD(it + 2);
            if (it > 0) S2_POST(it - 1);
            S2_VGLOAD(it);
        }
        __syncthreads();
    }
    if (w >= 4) S2_POST(niter - 1);
    else {
        float* so = a.out + (samp ? O_WKVS : O_WKVP) + (size_t)(b * 32 + h) * 4096;
#pragma unroll
        for (int mt = 0; mt < 4; ++mt)
#pragma unroll
            for (int i = 0; i < 4; ++i) so[(16 * w + c) * 64 + 16 * mt + 4 * q + i] = ST[mt][i];
    }
    __syncthreads();
#undef S2_LOAD
#undef S2_STORE
#undef S2_POST
#undef S2_VGLOAD
}

__device__ __forceinline__ int crow(int r, int hi) { return (r & 3) + 8 * (r >> 2) + 4 * hi; }
__device__ __forceinline__ s16x4 vtr(const LAS unsigned char* p) { typedef short v4i16_t __attribute__((ext_vector_type(4))); return __builtin_bit_cast(s16x4, __builtin_amdgcn_ds_read_tr16_b64_v4i16((LAS v4i16_t*)p)); }
__device__ __forceinline__ void attn_unit(Frame& F, const Args& a, int qbase, int kvbase, int hp, int nt0, int ntstep, int NT, int nkeys, int nrg_valid, int nq_valid, float lam, int abl) {
    const int lane = F.lane, wid = F.wave, tid = F.tid, r32 = lane & 31, hi = lane >> 5, rg = wid >> 1, sub = wid & 1;
    const bf16* Q = (const bf16*)((unsigned char*)a.out + DO_Q); bf16* O = (bf16*)(a.ws + WS_XBB);
    const bf16* KB = (const bf16*)(a.ws + WS_KB); const bf16* VB = (const bf16*)(a.ws + WS_VB);
    LAS unsigned char* lds = F.lds; LAS float* wsf = (LAS float*)(lds + ATT_WSF_OFF) + wid * 64;
    const int myNT = rg < nrg_valid ? nt0 + ntstep * (rg >> 1) : 0;
    bf16x8 qr[4];
#pragma unroll
    for (int d0 = 0; d0 < 4; ++d0) qr[d0] = *(const bf16x8*)(Q + (size_t)(qbase + rg * 32 + r32) * DM + (2 * hp + sub) * 64 + d0 * 16 + hi * 8);
    f32x16 o[4];
#pragma unroll
    for (int d = 0; d < 4; ++d)
#pragma unroll
        for (int i = 0; i < 16; ++i) o[d][i] = 0.f;
    float mref = 0.f, lsum = 0.f;
    f32x16 negm;
#pragma unroll
    for (int i = 0; i < 16; ++i) negm[i] = 0.f;
    const bf16* ksrc = KB + (size_t)(kvbase + 8 * wid + (lane >> 3)) * DM + (2 * hp) * 64 + ((lane & 7) ^ ((lane >> 3) & 7)) * 8;
    const bf16* vsrc0 = VB + (size_t)(kvbase + (wid & 3) * 16 + (lane >> 2)) * DM + hp * 128 + (wid >> 2) * 32 + (lane & 3) * 8;
    const bf16* vsrc1 = vsrc0 + 64;
#define AT_DMA(j, slot) do { LAS unsigned char* sb_ = lds + (slot); const size_t to_ = (size_t)(j) * 64 * DM; \
        __builtin_amdgcn_global_load_lds((const unsigned*)(ksrc + to_), (LAS unsigned*)(sb_ + wid * 1024), 16, 0, 0); \
        __builtin_amdgcn_global_load_lds((const unsigned*)(ksrc + to_ + 64), (LAS unsigned*)(sb_ + 8192 + wid * 1024), 16, 0, 0); \
        __builtin_amdgcn_global_load_lds((const unsigned*)(vsrc0 + to_), (LAS unsigned*)(sb_ + 16384 + (wid >> 2) * 4096 + (wid & 3) * 1024), 16, 0, 0); \
        __builtin_amdgcn_global_load_lds((const unsigned*)(vsrc1 + to_), (LAS unsigned*)(sb_ + 16384 + ((wid >> 2) + 2) * 4096 + (wid & 3) * 1024), 16, 0, 0); } while (0)
    AT_DMA(0, 0);
    if (NT > 1) AT_DMA(1, 32768);
    int slot_c = 0, slot_n = 65536;
    const int vtoff = ((lane >> 4) & 1) * 32 + (lane & 3) * 8 + (4 * hi + ((lane & 15) >> 2)) * 64;
    constexpr float ATT_THR = 8.f;
    for (int j = 0; j < NT; ++j) {
        if (j + 1 < NT) asm volatile("s_waitcnt vmcnt(4)" ::: "memory"); else asm volatile("s_waitcnt vmcnt(0)" ::: "memory");
        asm volatile("s_waitcnt lgkmcnt(0)" ::: "memory"); __builtin_amdgcn_s_barrier(); asm volatile("" ::: "memory");
        asm volatile("" : "+s"(slot_c), "+s"(slot_n));
        if (j + 2 < NT) AT_DMA(j + 2, slot_n);
        if (j < myNT && abl != 1) {
            const LAS unsigned char* sb = lds + slot_c; const LAS unsigned char* Ks = sb + sub * 8192; const LAS unsigned char* Vs = sb + 16384;
            f32x16 p0 = negm, p1 = negm;
            bf16x8 kf[4];
#pragma unroll
            for (int d0 = 0; d0 < 2; ++d0) { kf[2 * d0] = *(const LAS bf16x8*)(Ks + r32 * 128 + (((2 * d0 + hi) ^ (r32 & 7)) << 4)); kf[2 * d0 + 1] = *(const LAS bf16x8*)(Ks + 4096 + r32 * 128 + (((2 * d0 + hi) ^ (r32 & 7)) << 4)); }
            __builtin_amdgcn_sched_barrier(0);
#pragma unroll
            for (int d0 = 0; d0 < 2; ++d0) { p0 = __builtin_amdgcn_mfma_f32_32x32x16_bf16(kf[2 * d0], qr[d0], p0, 0, 0, 0); p1 = __builtin_amdgcn_mfma_f32_32x32x16_bf16(kf[2 * d0 + 1], qr[d0], p1, 0, 0, 0); }
#pragma unroll
            for (int d0 = 2; d0 < 4; ++d0) { kf[2 * d0 - 4] = *(const LAS bf16x8*)(Ks + r32 * 128 + (((2 * d0 + hi) ^ (r32 & 7)) << 4)); kf[2 * d0 - 3] = *(const LAS bf16x8*)(Ks + 4096 + r32 * 128 + (((2 * d0 + hi) ^ (r32 & 7)) << 4)); }
#pragma unroll
            for (int d0 = 2; d0 < 4; ++d0) { p0 = __builtin_amdgcn_mfma_f32_32x32x16_bf16(kf[2 * d0 - 4], qr[d0], p0, 0, 0, 0); p1 = __builtin_amdgcn_mfma_f32_32x32x16_bf16(kf[2 * d0 - 3], qr[d0], p1, 0, 0, 0); }
            if ((j + 1) * 64 > nkeys) {
#pragma unroll
                for (int i = 0; i < 16; ++i) { const int kx = j * 64 + crow(i, hi); if (kx >= nkeys) p0[i] = -1e30f; if (kx + 32 >= nkeys) p1[i] = -1e30f; }
            }
            float ra = __builtin_fmaxf(__builtin_fmaxf(p0[0], p0[1]), p1[0]), rb = __builtin_fmaxf(__builtin_fmaxf(p0[2], p0[3]), p1[1]); ra = __builtin_fmaxf(__builtin_fmaxf(ra, p1[2]), p1[3]);
#pragma unroll
            for (int i = 4; i < 16; i += 4) { ra = __builtin_fmaxf(__builtin_fmaxf(ra, p0[i]), p0[i + 1]); rb = __builtin_fmaxf(__builtin_fmaxf(rb, p0[i + 2]), p0[i + 3]);
                ra = __builtin_fmaxf(__builtin_fmaxf(ra, p1[i]), p1[i + 1]); rb = __builtin_fmaxf(__builtin_fmaxf(rb, p1[i + 2]), p1[i + 3]); }
            float rm = __builtin_fmaxf(ra, rb);
            rm = __builtin_fmaxf(rm, __shfl_xor(rm, 32));
            if (j == 0 || __any(rm > ATT_THR)) {
                const float dl = (j == 0) ? rm : __builtin_fmaxf(rm, 0.f);
                mref += dl;
#pragma unroll
                for (int i = 0; i < 16; ++i) { p0[i] -= dl; p1[i] -= dl; negm[i] = -mref; }
                const float f = fexp2(-dl); lsum *= f;
                if (hi == 0) wsf[r32] = f;
                LDS_WAIT();
#pragma unroll
                for (int i = 0; i < 16; ++i) { const float ff = wsf[crow(i, hi)];
#pragma unroll
                    for (int d = 0; d < 4; ++d) o[d][i] *= ff; }
            }
            float ps = 0.f, ps1 = 0.f;
#pragma unroll
            for (int i = 0; i < 16; ++i) { p0[i] = fexp2(p0[i]); p1[i] = fexp2(p1[i]); ps += p0[i]; ps1 += p1[i]; }
            lsum += ps + ps1;
            bf16x8 pa[4];
            { u32x4 t0, t1, t2, t3;
              t0.x = cvt_pk_bf16(p0[0], p0[1]); t0.y = cvt_pk_bf16(p0[2], p0[3]); t0.z = cvt_pk_bf16(p0[4], p0[5]); t0.w = cvt_pk_bf16(p0[6], p0[7]);
              t1.x = cvt_pk_bf16(p0[8], p0[9]); t1.y = cvt_pk_bf16(p0[10], p0[11]); t1.z = cvt_pk_bf16(p0[12], p0[13]); t1.w = cvt_pk_bf16(p0[14], p0[15]);
              t2.x = cvt_pk_bf16(p1[0], p1[1]); t2.y = cvt_pk_bf16(p1[2], p1[3]); t2.z = cvt_pk_bf16(p1[4], p1[5]); t2.w = cvt_pk_bf16(p1[6], p1[7]);
              t3.x = cvt_pk_bf16(p1[8], p1[9]); t3.y = cvt_pk_bf16(p1[10], p1[11]); t3.z = cvt_pk_bf16(p1[12], p1[13]); t3.w = cvt_pk_bf16(p1[14], p1[15]);
              pa[0] = __builtin_bit_cast(bf16x8, t0); pa[1] = __builtin_bit_cast(bf16x8, t1); pa[2] = __builtin_bit_cast(bf16x8, t2); pa[3] = __builtin_bit_cast(bf16x8, t3); }
#define AT_VLD(dst, d) do { _Pragma("unroll") for (int ks = 0; ks < 4; ++ks) { dst[2 * ks] = vtr(Vs + (d) * 4096 + ks * 1024 + vtoff); dst[2 * ks + 1] = vtr(Vs + (d) * 4096 + ks * 1024 + 512 + vtoff); } } while (0)
#define AT_PV(src, d) do { _Pragma("unroll") for (int ks = 0; ks < 4; ++ks) { const bf16x8 vf = (bf16x8){src[2 * ks][0], src[2 * ks][1], src[2 * ks][2], src[2 * ks][3], src[2 * ks + 1][0], src[2 * ks + 1][1], src[2 * ks + 1][2], src[2 * ks + 1][3]}; \
                o[d] = __builtin_amdgcn_mfma_f32_32x32x16_bf16(pa[ks], vf, o[d], 0, 0, 0); } } while (0)
            if (abl != 2) {
            s16x4 va[8], vb2[8];
            AT_VLD(va, 0); __builtin_amdgcn_sched_barrier(0);
            AT_VLD(vb2, 1); __builtin_amdgcn_sched_barrier(0); AT_PV(va, 0); __builtin_amdgcn_sched_barrier(0);
            AT_VLD(va, 2); __builtin_amdgcn_sched_barrier(0); AT_PV(vb2, 1); __builtin_amdgcn_sched_barrier(0);
            AT_VLD(vb2, 3); __builtin_amdgcn_sched_barrier(0); AT_PV(va, 2); __builtin_amdgcn_sched_barrier(0);
            AT_PV(vb2, 3);
            }
#undef AT_VLD
#undef AT_PV
        }
        slot_c = (slot_c == 65536) ? 0 : slot_c + 32768; slot_n = (slot_n == 65536) ? 0 : slot_n + 32768;
    }
    asm volatile("s_waitcnt vmcnt(0) lgkmcnt(0)" ::: "memory"); __builtin_amdgcn_s_barrier(); asm volatile("" ::: "memory");
    lsum += __shfl_xor(lsum, 32);
    if (hi == 0) wsf[32 + r32] = lsum;
    LDS_WAIT();
    LAS float* E = (LAS float*)lds;
    if (myNT > 0) {
#pragma unroll
        for (int i = 0; i < 16; ++i) { const float rl = frcp(wsf[32 + crow(i, hi)]);
#pragma unroll
            for (int d = 0; d < 4; ++d) E[((rg * 2 + sub) * 32 + crow(i, hi)) * 128 + d * 32 + r32] = o[d][i] * rl; }
    }
    __syncthreads();
    if (myNT > 0) {
        const f32x2 sg = *(const f32x2*)(a.in[29] + 2 * lane);
        for (int qq = 0; qq < 16; ++qq) { const int q = 16 * sub + qq;
            if (q >= nq_valid) break;
            const f32x2 e0 = *(const LAS f32x2*)(E + ((rg * 2 + 0) * 32 + q) * 128 + 2 * lane), e1 = *(const LAS f32x2*)(E + ((rg * 2 + 1) * 32 + q) * 128 + 2 * lane);
            const f32x2 ov = e0 - e1 * lam; const float ss = wave_sum_dpp(ov[0] * ov[0] + ov[1] * ov[1]);
            const float sc = __builtin_amdgcn_rsqf(ss * (1.f / 128.f) + LN_EPS) * (1.f - LAMBDA_INIT);
            *(unsigned*)(O + (size_t)(qbase + rg * 32 + q) * DM + hp * 128 + 2 * lane) = pk2(ov[0] * sc * sg[0], ov[1] * sc * sg[1]);
        }
    }
    __syncthreads();
#undef AT_DMA
}

constexpr int NPHASE = 23;
__global__ void __launch_bounds__(NWAVES * 64, 2) mk_fwd(Args args) {
    extern __shared__ __attribute__((aligned(16))) unsigned char lds_raw[];
    Frame F;
    F.lds = (LAS unsigned char*)lds_raw;
    F.MISC = (volatile LAS unsigned*)(F.lds + MISC_OFF);
    F.tid = threadIdx.x; F.lane = F.tid & 63; F.wave = __builtin_amdgcn_readfirstlane(F.tid >> 6);
    F.G = gridDim.x; { const int bx = blockIdx.x; F.vcu = (F.G % 8 == 0) ? (bx % 8) * (F.G / 8) + bx / 8 : bx; }
    unsigned char* ws = args.ws;
    F.ctl = (gu32*)(ws + WS_CTL);
    for (int u = F.tid; u < (LDS_BYTES - LDSCTL_OFF) / 4; u += NWAVES * 64) ((LAS unsigned*)(F.lds + LDSCTL_OFF))[u] = 0u;
    __syncthreads();
    XcdBarrier bar; bar.bar = (unsigned*)(F.ctl + CW_BAR); bar.x = 0; bar.st = nullptr;
    if (MK_SINGLE) bar = xcd_barrier_post((unsigned*)(F.ctl + CW_BAR), F.MISC + 8);
    const int lo = args.ph_lo, hi = args.ph_hi;
#define IN(k) (lo <= (k) && (k) < hi)
#define REP(k) for (int rep_ = 0; rep_ < ((k) == MK_DUP ? 2 : 1); ++rep_)
#define SEAM(k) do { if (IN(k) && IN((k) + 1)) xcd_barrier(bar); } while (0)
    const float* ln_g = args.in[6]; const float* ln_b = args.in[7];
    bf16* VF = (bf16*)(ws + WS_XF); const float* STATS = (const float*)(ws + WS_STATS); float* PART = (float*)(ws + WS_PART);
    bf16* XBA = (bf16*)(ws + WS_XBA); bf16* XBB = (bf16*)(ws + WS_XBB); bf16* HB = (bf16*)(ws + WS_H);
    unsigned char* dob = (unsigned char*)args.out;

#define FFN_G1(mi) do { pg8::Gemm g{(const bf16*)(ws + WS_XQ), (const bf16*)(ws + WS_WIN + (mi) * WIN_STRIDE), MP, 2 * FF, DM / 2, DM / 2, nullptr, nullptr, nullptr}; pg8::StaticOrder S; S.init(MP, 2 * FF, DM / 2, F.G, (int)blockIdx.x, 0); \
        pg8::EpiSwiGLUI8 E{HB, (const float*)(ws + WS_SX), (const float*)(F.ctl + CW_CMAX) + (mi) * 2 * FF}; pg8::gemm_phase<pg8::EpiSwiGLUI8>(F.lds, g, S, E); } while (0)
#define RESID_GEMM(A_, W_, Kk, lnprev, sc, CM_) do { pg8::Gemm g{A_, (const bf16*)(ws + (W_)), MP, DM, (sc) ? (Kk) / 2 : (Kk), (sc) ? (Kk) / 2 : (Kk), nullptr, nullptr, nullptr}; pg8::StaticOrder S; S.init(MP, DM, (sc) ? (Kk) / 2 : (Kk), F.G, (int)blockIdx.x, (sc) ? 2 : 4); \
        pg8::EpiResid<sc> E{VF, (lnprev) >= 0 ? STATS : nullptr, ln_g + ((lnprev) >= 0 ? (lnprev) : 0) * DM, ln_b + ((lnprev) >= 0 ? (lnprev) : 0) * DM, PART, CM_, nullptr}; \
        pg8::gemm_phase<pg8::EpiResid<sc>>(F.lds, g, S, E); } while (0)
#define LN_PASS(lncur, lnprev, sc, XB_, fin, q8_, nsp) ln_pass(F, args, ln_g + (lncur) * DM, ln_b + (lncur) * DM, (lnprev) >= 0 ? ln_g + ((lnprev) >= 0 ? (lnprev) : 0) * DM : nullptr, ln_b + ((lnprev) >= 0 ? (lnprev) : 0) * DM, sc, XB_, fin, q8_, nsp)

    if (IN(0)) { p0_prologue(F, args); xcd_barrier(bar); p0_quant_win(F, args); } SEAM(0);
    if (IN(1)) { REP(1) { FFN_G1(0); } } SEAM(1);
    if (IN(2)) { pg8::Gemm g{HB, (const bf16*)(ws + WS_WOUT), MP, DM, FF / 2, FF / 2, nullptr, nullptr, nullptr}; pg8::StaticOrder S; S.init(MP, DM, FF / 2, F.G, (int)blockIdx.x, 2);
        pg8::EpiResid<1, 1> E{VF, nullptr, ln_g, ln_b, PART, (const float*)(F.ctl + CW_CMAX2), args.in[0]}; pg8::gemm_phase<pg8::EpiResid<1, 1>>(F.lds, g, S, E); } SEAM(2);
    if (IN(3)) { ln_mix_pass(F, args, ln_g + 0 * DM, ln_b + 0 * DM, 0.5f, 2); } SEAM(3);
    if (IN(4)) REP(4) { pg8::Gemm g{XBB, (const bf16*)(ws + WS_WCAT), MP, NCAT, KCAT, DM, (const bf16*)(ws + WS_MIX2), (const bf16*)(ws + WS_MIX3), XBA}; pg8::StaticOrder S; S.init(MP, NCAT, KCAT, F.G, (int)blockIdx.x, 0);
        pg8::EpiRwkv E{(bf16*)(dob + DO_R), (float*)(dob + DO_Z)}; pg8::gemm_phase<pg8::EpiRwkv>(F.lds, g, S, E); } SEAM(4);
    if (IN(5)) { lora_hidden_pass(F, args); } SEAM(5);
    if (IN(6)) { pg8::Gemm g{(const bf16*)(ws + WS_L), (const bf16*)(ws + WS_WL2), MP, NL2, KL2, KL2, nullptr, nullptr, nullptr}; pg8::StaticOrder S; S.init(MP, NL2, KL2, F.G, (int)blockIdx.x, 0, 1);
        pg8::EpiLora2 E{(bf16*)(dob + DO_WLD), XBB, args.in[12], args.in[15]}; pg8::gemm_phase<pg8::EpiLora2>(F.lds, g, S, E); } SEAM(6);
    if (IN(7)) REP(7) {
        const int abl = (MK_DUP == 7 && rep_ == 0) ? MK_ABL : 0;
        for (int u = F.vcu; u < 512; u += F.G) { const int samp = u >= 256, bh = u & 255; scan_unit(F, args, samp, bh >> 5, bh & 31, abl); }
    } SEAM(7);
    if (IN(8)) { RESID_GEMM(XBA, WS_WOR, DM, 0, 0, (const float*)nullptr); } SEAM(8);
    if (IN(9)) { LN_PASS(1, 0, 1.0f, (bf16*)nullptr, 0, 1, 4); } SEAM(9);
    if (IN(10)) { FFN_G1(1); } SEAM(10);
    if (IN(11)) { RESID_GEMM(HB, WS_WOUT + 1 * WOUT_STRIDE, FF, 1, 1, (const float*)(F.ctl + CW_CMAX2) + 1 * DM); } SEAM(11);
    if (IN(12)) { LN_PASS(2, 1, 0.5f, XBA, 0, 1, 2); } SEAM(12);
    if (IN(13)) { FFN_G1(2); } SEAM(13);
    if (IN(14)) { RESID_GEMM(HB, WS_WOUT + 2 * WOUT_STRIDE, FF, 2, 1, (const float*)(F.ctl + CW_CMAX2) + 2 * DM); } SEAM(14);
    if (IN(15)) { LN_PASS(3, 2, 0.5f, XBB, 0, 0, 2); cache_convert(F, args); } SEAM(15);
    if (IN(16)) { pg8::Gemm g{XBA, (const bf16*)(ws + WS_WKV), MP, 3 * DM, DM, DM, XBA, XBB, XBB}; pg8::StaticOrder S; S.init(MP, 3 * DM, DM, F.G, (int)blockIdx.x, 0);
        pg8::EpiKVQ E{args.out, (bf16*)(ws + WS_KB), (bf16*)(dob + DO_Q)}; pg8::gemm_phase<pg8::EpiKVQ>(F.lds, g, S, E); } SEAM(16);
    if (IN(17)) REP(17) {
        const int abl = (MK_DUP == 17 && rep_ == 0) ? MK_ABL : 0;
        const float l0 = args.in[28][F.lane] * args.in[28][64 + F.lane], l1 = args.in[28][128 + F.lane] * args.in[28][192 + F.lane];
        const float lam = __expf(wave_sum(l0)) - __expf(wave_sum(l1)) + LAMBDA_INIT;
        for (int i = 0; i < 8; ++i) { const int pidx = F.vcu + F.G * i; if (pidx >= 2048) break; const int bhp = pidx >> 4, us = pidx & 15, b = bhp >> 4, hp = bhp & 15;
#pragma unroll 1
            for (int k = 0; k < 2; ++k) { const int uq = k ? 31 - us : us;
                attn_unit(F, args, b * RS + 1 + uq * 128, b * T, hp, 2 * uq + 1, 1, 2 * uq + 2, 1 << 30, 4, 32, lam, abl); } }
        for (int u = F.vcu; u < 128; u += F.G) { const int b = u >> 4, hp = u & 15;
            attn_unit(F, args, SROW0 + b * SRS + 1, NB * T + b * KVS, hp, 17, 0, 17, KVS, 1, 16, lam, abl); }
    } SEAM(17);
    if (IN(18)) { RESID_GEMM(XBB, WS_WOD, DM, 3, 0, (const float*)nullptr); } SEAM(18);
    if (IN(19)) { LN_PASS(4, 3, 1.0f, (bf16*)nullptr, 0, 1, 4); } SEAM(19);
    if (IN(20)) { FFN_G1(3); } SEAM(20);
    if (IN(21)) { RESID_GEMM(HB, WS_WOUT + 3 * WOUT_STRIDE, FF, 4, 1, (const float*)(F.ctl + CW_CMAX2) + 3 * DM); } SEAM(21);
    if (IN(22)) REP(22) { LN_PASS(5, 4, 0.5f, XBA, 1, 0, 2); }
#undef IN
#undef SEAM
#undef REP
}

extern "C" void kernel_launch(void* const* d_in, const int* in_sizes, int n_in, void* d_out, int out_size, void* d_ws, size_t ws_size, hipStream_t stream) {
    static int grid = 0;
    if (grid == 0) {
        if (n_in != 31 || (size_t)out_size != O_TOTAL || ws_size < WS_END) { fprintf(stderr, "kernel_launch: unexpected sizes n_in %d out %d ws %zu\n", n_in, out_size, ws_size); grid = -1; return; }
        int dev = 0, cus = 0, per_cu = 0;
        if (hipGetDevice(&dev) != hipSuccess || hipDeviceGetAttribute(&cus, hipDeviceAttributeMultiprocessorCount, dev) != hipSuccess) { grid = -1; return; }
        if (hipFuncSetAttribute((const void*)mk_fwd, hipFuncAttributeMaxDynamicSharedMemorySize, LDS_BYTES) != hipSuccess) { fprintf(stderr, "kernel_launch: hipFuncSetAttribute failed\n"); grid = -1; return; }
        if (hipOccupancyMaxActiveBlocksPerMultiprocessor(&per_cu, (const void*)mk_fwd, NWAVES * 64, LDS_BYTES) != hipSuccess || per_cu < 1) { fprintf(stderr, "kernel_launch: occupancy query says %d\n", per_cu); }
        (void)hipGetLastError();
        grid = cus;
    }
    if (grid < 0) return;
    (void)hipMemsetAsync((char*)d_ws + WS_CTL, 0, CTL_ZERO_BYTES, stream);
    Args a{};
    for (int i = 0; i < 31; ++i) a.in[i] = (const float*)d_in[i];
    a.out = (float*)d_out; a.ws = (unsigned char*)d_ws;
#if MK_SINGLE
    a.ph_lo = 0; a.ph_hi = NPHASE;
    hipLaunchKernelGGL(mk_fwd, dim3(grid), dim3(NWAVES * 64), LDS_BYTES, stream, a);
#else
    for (int p = 0; p < NPHASE; ++p) { a.ph_lo = p; a.ph_hi = p + 1; hipLaunchKernelGGL(mk_fwd, dim3(grid), dim3(NWAVES * 64), LDS_BYTES, stream, a); }
#endif
}
```

```cpp
#include <hip/hip_runtime.h>
#include <cstdio>
#include <cstdint>

#ifndef MK_DUP
#define MK_DUP -1
#endif
#ifndef MK_ABL
#define MK_ABL 0
#endif
#ifndef MK_SINGLE
#define MK_SINGLE 1
#endif

#define GAS __attribute__((address_space(1)))
#define LAS __attribute__((address_space(3)))
typedef unsigned short bf16;
typedef short bf16x8 __attribute__((ext_vector_type(8)));
typedef short s16x4 __attribute__((ext_vector_type(4)));
typedef float f32x2 __attribute__((ext_vector_type(2)));
typedef float f32x4 __attribute__((ext_vector_type(4)));
typedef float f32x16 __attribute__((ext_vector_type(16)));
typedef unsigned u32x2 __attribute__((ext_vector_type(2)));
typedef unsigned u32x4 __attribute__((ext_vector_type(4)));
typedef int i32x4 __attribute__((ext_vector_type(4)));
typedef GAS unsigned gu32;

constexpr int DM = 2048, FF = 5632, T = 4096, NB = 8, TS = 16, PAST = 1024;
constexpr int RS = T + 1;
constexpr int SROW0 = NB * RS;
constexpr int SRS = TS + 1;
constexpr int NROWS = SROW0 + NB * SRS;
constexpr int MP = 33024;
constexpr int KVS = PAST + TS;
constexpr int KVROWS = NB * T + NB * KVS;
constexpr int NCAT = 7168, KCAT = 2048;
constexpr int NL2 = 6144, KL2 = 512;
constexpr float LN_EPS = 1e-5f, GN_EPS = 64e-5f;
constexpr float ALPHA = 1.41421356237f;
constexpr float LOG2E = 1.4426950408889634f;
constexpr float QSCALE = 0.125f * LOG2E;
constexpr float LAMBDA_INIT = 0.35550906f;

constexpr size_t MiB = 1u << 20;
constexpr size_t WS_CTL = 0, CTL_ZERO_BYTES = 1 * MiB;
constexpr size_t WS_WIN = 2 * MiB;
constexpr size_t WIN_STRIDE = (size_t)2 * FF * DM;
constexpr size_t WS_WOUT = 178 * MiB;
constexpr size_t WOUT_STRIDE = (size_t)DM * FF;
constexpr float H8_CLIP = 8.f;
constexpr size_t WS_WCAT = 266 * MiB;
constexpr size_t WS_WL2 = 318 * MiB;
constexpr size_t WS_WOR = 324 * MiB, WS_WOD = 332 * MiB, WS_WKV = 340 * MiB, WS_WQ = 356 * MiB;
constexpr size_t WS_XF = 364 * MiB;
constexpr size_t WS_XBA = 623 * MiB;
constexpr size_t WS_XBB = 753 * MiB;
constexpr size_t WS_H = 883 * MiB;
constexpr size_t WS_PART = 1240 * MiB;
constexpr size_t WS_STATS = 1248 * MiB;
constexpr size_t WS_XQ = 1250 * MiB;
constexpr size_t WS_SX = 1316 * MiB;
constexpr size_t WS_END = 1318 * MiB;
constexpr size_t ACT_BYTES = (size_t)MP * DM * 2;
constexpr size_t WS_MIX2 = WS_H, WS_MIX3 = WS_H + ACT_BYTES, WS_L = WS_H + 2 * ACT_BYTES;
constexpr size_t WS_KB = WS_H, WS_VB = WS_H + 161 * MiB;
constexpr size_t O_YP = 0, O_YS = 67108864, O_KP = 67371008, O_VP = 134479872, O_WKVP = 201588736, O_SHP = 202637312,
                 O_KS = 202653696, O_VS = 202915840, O_WKVS = 203177984, O_SHS = 204226560, O_TOTAL = 204242944;
constexpr size_t DO_Q = 0, DO_R = 0, DO_KR = ACT_BYTES, DO_VV = 2 * ACT_BYTES, DO_Z = 3 * ACT_BYTES, DO_WLD = 3 * ACT_BYTES, DO_AG = 4 * ACT_BYTES;
static_assert(DO_AG + ACT_BYTES <= O_WKVP * 4, "d_out scratch overlays end before the wkv/shift outputs");
constexpr size_t ACT_ELEMS = (size_t)MP * DM;

constexpr int CW_TMO = 0, CW_BAR = 4096;
constexpr int CW_CMAX2 = 131072;
constexpr int CW_CMAX = 65536;

constexpr int RING_BYTES = 131072;
constexpr int LDSCTL_OFF = RING_BYTES, MISC_OFF = LDSCTL_OFF + 320;
constexpr int SCL_OFF = RING_BYTES + 4096;
constexpr int ATT_WSF_OFF = RING_BYTES + 1024;
constexpr int LDS_BYTES = 147456;
constexpr int NWAVES = 8;

#define LDS_WAIT() asm volatile("s_waitcnt lgkmcnt(0)" ::: "memory")
#define VM_WAIT() asm volatile("s_waitcnt vmcnt(0)" ::: "memory")
__device__ __forceinline__ unsigned f2bf(float f) { unsigned u = __builtin_bit_cast(unsigned, f); return (u + 0x7fffu + ((u >> 16) & 1u)) >> 16; }
__device__ __forceinline__ unsigned pk2(float lo, float hi) { return f2bf(lo) | (f2bf(hi) << 16); }
__device__ __forceinline__ float bf2f(unsigned short h) { return __builtin_bit_cast(float, (unsigned)h << 16); }
__device__ __forceinline__ float bflo(unsigned w) { return __builtin_bit_cast(float, w << 16); }
__device__ __forceinline__ float bfhi(unsigned w) { return __builtin_bit_cast(float, w & 0xffff0000u); }
__device__ __forceinline__ unsigned cvt_pk_bf16(float lo, float hi) { unsigned r; asm volatile("v_cvt_pk_bf16_f32 %0, %1, %2" : "=v"(r) : "v"(lo), "v"(hi)); return r; }
__device__ __forceinline__ float fexp2(float x) { return __builtin_amdgcn_exp2f(x); }
__device__ __forceinline__ float frcp(float x) { return __builtin_amdgcn_rcpf(x); }
__device__ __forceinline__ float sigmoidf_(float z) { return frcp(1.f + fexp2(-z * LOG2E)); }
__device__ __forceinline__ float wave_sum(float v) {
#pragma unroll
    for (int o = 1; o < 64; o <<= 1) v += __shfl_xor(v, o);
    return v;
}
template <int CTRL, int RMASK> __device__ __forceinline__ float dpp_f(float old, float v) {
    return __builtin_bit_cast(float, __builtin_amdgcn_update_dpp(__builtin_bit_cast(int, old), __builtin_bit_cast(int, v), CTRL, RMASK, 0xf, false));
}
__device__ __forceinline__ float wave_sum_dpp(float v) {
    v += dpp_f<0x121, 0xf>(0.f, v);
    v += dpp_f<0x122, 0xf>(0.f, v);
    v += dpp_f<0x124, 0xf>(0.f, v);
    v += dpp_f<0x128, 0xf>(0.f, v);
    v += dpp_f<0x142, 0xa>(0.f, v);
    v += dpp_f<0x143, 0xc>(0.f, v);
    return __builtin_bit_cast(float, __builtin_amdgcn_readlane(__builtin_bit_cast(int, v), 63));
}
__device__ __forceinline__ void wave_sum_dpp4(float (&v)[4]) {
#define WS4_STEP(CTRL, RM) _Pragma("unroll") for (int i = 0; i < 4; ++i) v[i] += dpp_f<CTRL, RM>(0.f, v[i]);
    WS4_STEP(0x121, 0xf) WS4_STEP(0x122, 0xf) WS4_STEP(0x124, 0xf) WS4_STEP(0x128, 0xf) WS4_STEP(0x142, 0xa) WS4_STEP(0x143, 0xc)
#undef WS4_STEP
#pragma unroll
    for (int i = 0; i < 4; ++i) v[i] = __builtin_bit_cast(float, __builtin_amdgcn_readlane(__builtin_bit_cast(int, v[i]), 63));
}
__device__ __forceinline__ float wave_max_dpp(float v) {
    v = fmaxf(v, dpp_f<0x121, 0xf>(0.f, v));
    v = fmaxf(v, dpp_f<0x122, 0xf>(0.f, v));
    v = fmaxf(v, dpp_f<0x124, 0xf>(0.f, v));
    v = fmaxf(v, dpp_f<0x128, 0xf>(0.f, v));
    v = fmaxf(v, dpp_f<0x142, 0xa>(0.f, v));
    v = fmaxf(v, dpp_f<0x143, 0xc>(0.f, v));
    return __builtin_bit_cast(float, __builtin_amdgcn_readlane(__builtin_bit_cast(int, v), 63));
}
__device__ __forceinline__ float grp8_sum(float v) {
    v += dpp_f<0xB1, 0xf>(0.f, v);
    v += dpp_f<0x4E, 0xf>(0.f, v);
    v += dpp_f<0x141, 0xf>(0.f, v);
    return v;
}
__device__ __forceinline__ unsigned q8x4(f32x4 v, float inv) {
    const int a = (int)__builtin_rintf(v[0] * inv), b = (int)__builtin_rintf(v[1] * inv), c = (int)__builtin_rintf(v[2] * inv), d = (int)__builtin_rintf(v[3] * inv);
    return ((unsigned)a & 0xffu) | (((unsigned)b & 0xffu) << 8) | (((unsigned)c & 0xffu) << 16) | ((unsigned)d << 24);
}
__device__ __forceinline__ bool row_decode(int r, int& samp, int& b, int& t) {
    if (r < SROW0) { b = r / RS; t = r - b * RS - 1; samp = 0; return t >= 0; }
    if (r < NROWS) { const int q = r - SROW0; b = q / SRS; t = q - b * SRS - 1; samp = 1; return t >= 0; }
    samp = 0; b = 0; t = -1; return false;
}

#define XB_TMO      128
#define XB_XCNT(j)  (256  + 64 * (j))
#define XB_XSUB(j)  (1280 + 64 * (j))
#define XB_XGEN(j)  (2304 + 64 * (j))
#define XB_TOP      3328
#define XB_TOPGEN   3392
#define XCD_BAR_WORDS 3456
#define XB_SPIN_CAP (1u << 24)
__device__ __forceinline__ unsigned xb_ld(unsigned* p)              { return __hip_atomic_load(p, __ATOMIC_RELAXED, __HIP_MEMORY_SCOPE_AGENT); }
__device__ __forceinline__ unsigned xb_add(unsigned* p, unsigned v) { return __hip_atomic_fetch_add(p, v, __ATOMIC_RELAXED, __HIP_MEMORY_SCOPE_AGENT); }
__device__ __forceinline__ unsigned xb_xcc_id() { return (unsigned)__builtin_amdgcn_s_getreg((3 << 11) | 20) & 0xFu; }
#define XB_SPIN(cond, bar) do { unsigned _sp = 0; while (cond) { __builtin_amdgcn_s_sleep(1); \
    if ((++_sp & 255u) == 0u) { if (xb_ld(&(bar)[XB_TMO])) break; if (_sp > XB_SPIN_CAP) { atomicAdd(&(bar)[XB_TMO], 1u); break; } } } } while (0)
struct XcdBarrier { unsigned* bar; unsigned x; volatile LAS unsigned* st; };
__device__ __forceinline__ XcdBarrier xcd_barrier_post(unsigned* bar, volatile LAS unsigned* st) {
    XcdBarrier b; b.bar = bar; b.x = xb_xcc_id(); b.st = st;
    if (threadIdx.x == 0) (void)xb_add(&bar[XB_XCNT(b.x)], 1u);
    return b;
}
__device__ __forceinline__ void xcd_barrier_complete(unsigned* bar, unsigned x, unsigned& nloc, unsigned& nx) {
    const unsigned G = gridDim.x * gridDim.y * gridDim.z;
    unsigned sum, cnt, mine, sp = 0u;
    for (;;) {
        sum = 0u; cnt = 0u; mine = 0u;
#pragma unroll
        for (unsigned j = 0; j < 16; ++j) { const unsigned c = xb_ld(&bar[XB_XCNT(j)]); sum += c; cnt += (c > 0u) ? 1u : 0u; mine = (j == x) ? c : mine; }
        if (sum == G) break;
        __builtin_amdgcn_s_sleep(1);
        if ((++sp & 255u) == 0u) { if (xb_ld(&bar[XB_TMO])) break; if (sp > XB_SPIN_CAP) { atomicAdd(&bar[XB_TMO], 1u); break; } }
    }
    nloc = mine > 0u ? mine : 1u; nx = cnt > 0u ? cnt : 1u;
}
__device__ __forceinline__ void xcd_barrier(const XcdBarrier& b) {
    asm volatile("s_waitcnt vmcnt(0)" ::: "memory");
    __syncthreads();
    if (threadIdx.x == 0) {
        unsigned* bar = b.bar;
        __builtin_amdgcn_s_waitcnt(0);
        unsigned nloc = b.st[0], nx = b.st[1];
        if (nloc == 0u) { xcd_barrier_complete(bar, b.x, nloc, nx); b.st[0] = nloc; b.st[1] = nx; }
        const unsigned old = xb_add(&bar[XB_XSUB(b.x)], 1u);
        const unsigned gen = old / nloc;
        if (old + 1u == (gen + 1u) * nloc) {
            __builtin_amdgcn_fence(__ATOMIC_RELEASE, "agent");
            asm volatile("s_waitcnt vmcnt(0)" ::: "memory");
            const unsigned og = xb_add(&bar[XB_TOP], 1u);
            const unsigned tg = og / nx;
            if (og + 1u == (tg + 1u) * nx) xb_add(&bar[XB_TOPGEN], 1u);
            else XB_SPIN(xb_ld(&bar[XB_TOPGEN]) == tg, bar);
            __builtin_amdgcn_fence(__ATOMIC_ACQUIRE, "agent");
            xb_add(&bar[XB_XGEN(b.x)], 1u);
            asm volatile("s_waitcnt vmcnt(0)" ::: "memory");
        } else {
            XB_SPIN(xb_ld(&bar[XB_XGEN(b.x)]) == gen, bar);
            __builtin_amdgcn_fence(__ATOMIC_ACQUIRE, "agent");
            asm volatile("s_waitcnt vmcnt(0)" ::: "memory");
        }
    }
    __syncthreads();
}

namespace pg8 {
constexpr int BM = 256, BK = 64, HALF = 128, HTB = HALF * BK * 2, STAGE_BYTES = 8 * HTB, NXCD = 8, WGM = 8;
__host__ __device__ __forceinline__ int lds_byte(int r, int c) { const int st = (r >> 4) * 2 + (c >> 5), rr = r & 15, cc = c & 31, ob = rr * 64 + cc * 2; return st * 1024 + (ob ^ (((ob >> 9) & 1) << 5)); }
__host__ __device__ __forceinline__ void stage_rc(int b, int& R, int& C) { const int st = b / 1024, sb = b % 1024, swz = sb ^ (((sb >> 9) & 1) << 5); R = (st >> 1) * 16 + swz / 64; C = (st & 1) * 32 + (swz % 64) / 2; }
__host__ __device__ __forceinline__ int perm32(int rho) { const int n = rho >> 4, i = rho & 15; return 8 * (i >> 2) + 4 * n + (i & 3); }
struct Unit { int pm, pn, ks, k0, nt; };
struct Gemm { const bf16* A; const bf16* Bt; int M, N, K, lda; const bf16 *A1, *A2, *A3; };
struct StaticOrder {
    int nM, nN, nwg, G, c, nt, split, lora;
    __device__ __forceinline__ void init(int M, int N, int K, int G_, int c_, int split_, int lora_ = 0) { split = split_; lora = lora_; nM = M / BM - (split_ ? 1 : 0); nN = N / BM; nwg = nM * nN; G = G_; c = c_; nt = K / BK; }
    __device__ __forceinline__ bool next(int i, Unit& u) const {
        const long L = (long)i * G + c;
        if (L >= (long)nwg + nN * split) return false;
        const bool sp = L >= nwg;
        int wgid = sp ? 0 : (int)L; { const int q = nwg / NXCD, r = nwg % NXCD, xcd = wgid % NXCD, off = wgid / NXCD; wgid = (xcd < r ? xcd * (q + 1) : r * (q + 1) + (xcd - r) * q) + off; }
        const int nig = WGM * nN, gid = wgid / nig, fm = gid * WGM, gsz = (nM - fm) < WGM ? (nM - fm) : WGM;
        const int sidx = sp ? (int)(L - nwg) : 0, sks = sidx / nN, snt = split ? nt / split : nt;
        const int pm_ = sp ? nM : fm + ((wgid % nig) % gsz), pn_ = sp ? sidx % nN : (wgid % nig) / gsz, ks_ = sp ? sks : -1, nt_ = sp ? snt : nt, k0_ = sp ? sks * snt : 0;
        u.pm = pm_; u.pn = pn_; u.ks = ks_; u.k0 = k0_; u.nt = nt_;
        if (lora) { const int kind = pn_ >> 3; u.k0 = kind == 0 ? 0 : (kind == 1 ? 1 : 3); u.nt = kind == 2 ? 4 : 2; }
        return true;
    }
};
__device__ __forceinline__ f32x4 mma16(bf16x8 b, bf16x8 a, f32x4 c) { return __builtin_amdgcn_mfma_f32_16x16x32_bf16(b, a, c, 0, 0, 0); }
__device__ __forceinline__ i32x4 mma16(bf16x8 b, bf16x8 a, i32x4 c) { return __builtin_amdgcn_mfma_i32_16x16x64_i8(__builtin_bit_cast(i32x4, b), __builtin_bit_cast(i32x4, a), c, 0, 0, 0); }
template <class Epi>
__device__ __forceinline__ void gemm_phase(LAS unsigned char* lds, const Gemm g, const StaticOrder& S, const Epi& E) {
    const int tid = threadIdx.x, wid = __builtin_amdgcn_readfirstlane(tid >> 6), lane = tid & 63, wr = wid >> 2, wc = wid & 3, fr = lane & 15, fq = lane >> 4;
    const int K = g.K, lda = g.lda;
    const bf16* a0_ = g.A; const bf16* a1_ = g.A1; const bf16* a2_ = g.A2; const bf16* a3_ = g.A3; asm volatile("" : "+s"(a0_), "+s"(a1_), "+s"(a2_), "+s"(a3_));
    unsigned voffA[2], voffB[2];
#pragma unroll
    for (int i = 0; i < 2; ++i) { int R, C; stage_rc(tid * 16 + i * 8192, R, C); const int Rb = Epi::PERM ? ((R & ~31) + perm32(R & 31)) : R;
        voffA[i] = (unsigned)(R * lda + C) * 2u; voffB[i] = (unsigned)(Rb * K + C) * 2u; }
    const size_t kstep = (size_t)(BK * 2);
    const size_t hstepA = (size_t)HALF * lda * 2, hstepB = (size_t)HALF * K * 2;
    const size_t tstepA = 2 * hstepA, tstepB = 2 * hstepB;
    const unsigned ldsw = (unsigned)wid * 1024u;
    const int aoff = lds_byte(wr * 64 + fr, fq * 8), boff = lds_byte(wc * 32 + fr, fq * 8);
#define PG8_SA(b, h) (((b) * 2 + (h)) * HTB)
#define PG8_SB(b, h) ((4 + (b) * 2 + (h)) * HTB)
#define PG8_STAGE(bufoff, gbase, voff) do { _Pragma("unroll") for (int _i = 0; _i < 2; ++_i) \
        __builtin_amdgcn_global_load_lds((const unsigned*)((const char*)(gbase) + (voff)[_i]), (LAS unsigned*)(lds + (bufoff) + ldsw + _i * 8192), 16, 0, 0); } while (0)
#define PG8_LDA(dst, b, h) do { _Pragma("unroll") for (int m = 0; m < 4; ++m) _Pragma("unroll") for (int k = 0; k < 2; ++k) dst[m][k] = *(const LAS bf16x8*)(lds + PG8_SA(b, h) + aoff + m * 2048 + k * 1024); } while (0)
#define PG8_LDB(dst, b, h) do { _Pragma("unroll") for (int n = 0; n < 2; ++n) _Pragma("unroll") for (int k = 0; k < 2; ++k) dst[n][k] = *(const LAS bf16x8*)(lds + PG8_SB(b, h) + boff + n * 2048 + k * 1024); } while (0)
#define PG8_MMA(ai, bj, At, Bt) do { __builtin_amdgcn_s_setprio(1); _Pragma("unroll") for (int m = 0; m < 4; ++m) _Pragma("unroll") for (int n = 0; n < 2; ++n) _Pragma("unroll") for (int k = 0; k < 2; ++k) \
        acc[ai][bj][m][n] = mma16(Bt[n][k], At[m][k], acc[ai][bj][m][n]); __builtin_amdgcn_s_setprio(0); } while (0)
#define PG8_WAIT_V(n) asm volatile("s_waitcnt vmcnt(" #n ")" ::: "memory")
#define PG8_WAIT_L(n) asm volatile("s_waitcnt lgkmcnt(" #n ")" ::: "memory")
#define PG8_BAR __builtin_amdgcn_s_barrier()
#define PG8_SCHED __builtin_amdgcn_sched_barrier(0)
#define PG8_ABASE(u) ((const char*)(a1_ ? ((u).pn < 8 ? a0_ : ((u).pn < 16 ? a1_ : ((u).pn < 24 ? a2_ : a3_))) : a0_) + (size_t)(u).pm * tstepA + (size_t)(u).k0 * kstep)
#define PG8_BBASE(u) ((const char*)g.Bt + (size_t)(u).pn * tstepB + (size_t)(u).k0 * kstep)
    Unit cur, nxt; int ui = 0;
    if (!S.next(0, cur)) return;
    typedef typename Epi::AccT AccT;
    AccT acc[2][2][4][2];
#pragma unroll
    for (int a = 0; a < 2; ++a)
#pragma unroll
        for (int b = 0; b < 2; ++b)
#pragma unroll
            for (int m = 0; m < 4; ++m)
#pragma unroll
                for (int n = 0; n < 2; ++n) acc[a][b][m][n] = AccT{};
    bf16x8 At[4][2], B0[2][2], B1[2][2];
    const char* cA = PG8_ABASE(cur); const char* cB = PG8_BBASE(cur);
    if constexpr (Epi::PRE) E.stage(lds, cur, wid, lane, 0);
    PG8_STAGE(PG8_SB(0, 0), cB, voffB); PG8_STAGE(PG8_SB(0, 1), cB + hstepB, voffB); PG8_STAGE(PG8_SA(0, 0), cA, voffA); PG8_STAGE(PG8_SA(0, 1), cA + hstepA, voffA);
    if (wr == 1) PG8_BAR;
    PG8_WAIT_V(2); PG8_BAR;
    PG8_STAGE(PG8_SB(1, 0), cB + kstep, voffB); PG8_STAGE(PG8_SA(1, 0), cA + kstep, voffA); PG8_STAGE(PG8_SB(1, 1), cB + hstepB + kstep, voffB);
    PG8_WAIT_V(6); PG8_BAR;
    for (;;) {
        const bool has_next = S.next(ui + 1, nxt);
        const char* nA = has_next ? PG8_ABASE(nxt) : cA; const char* nB = has_next ? PG8_BBASE(nxt) : cB;
        const int nt = cur.nt;
        for (int t = 0; t < nt; t += 2) {
            const bool last = (t == nt - 2);
            const char* a1 = cA + (size_t)(t + 1) * kstep;
            const char* a2 = last ? nA : cA + (size_t)(t + 2) * kstep; const char* b2 = last ? nB : cB + (size_t)(t + 2) * kstep;
            const char* a3 = a2 + kstep; const char* b3 = b2 + kstep;
            PG8_LDB(B0, 0, 0); PG8_LDB(B1, 0, 1); PG8_SCHED; PG8_LDA(At, 0, 0); PG8_STAGE(PG8_SA(1, 1), a1 + hstepA, voffA);
            PG8_WAIT_V(8); PG8_WAIT_L(0); PG8_BAR; PG8_MMA(0, 0, At, B0); PG8_MMA(0, 1, At, B1); PG8_BAR; PG8_SCHED;
            PG8_LDA(At, 0, 1); PG8_STAGE(PG8_SB(0, 0), b2, voffB); PG8_STAGE(PG8_SB(0, 1), b2 + hstepB, voffB); PG8_STAGE(PG8_SA(0, 0), a2, voffA);
            PG8_WAIT_V(8); PG8_WAIT_L(0); PG8_BAR; PG8_MMA(1, 0, At, B0); PG8_MMA(1, 1, At, B1); PG8_BAR; PG8_SCHED;
            PG8_LDB(B0, 1, 0); PG8_LDB(B1, 1, 1); PG8_SCHED; PG8_LDA(At, 1, 0); PG8_STAGE(PG8_SA(0, 1), a2 + hstepA, voffA);
            PG8_WAIT_V(8); PG8_WAIT_L(0); PG8_BAR; PG8_MMA(0, 0, At, B0); PG8_MMA(0, 1, At, B1); PG8_BAR; PG8_SCHED;
            PG8_LDA(At, 1, 1); PG8_STAGE(PG8_SB(1, 0), b3, voffB); PG8_STAGE(PG8_SB(1, 1), b3 + hstepB, voffB); PG8_STAGE(PG8_SA(1, 0), a3, voffA);
            PG8_WAIT_V(8); PG8_WAIT_L(0); PG8_BAR; PG8_MMA(1, 0, At, B0); PG8_MMA(1, 1, At, B1); PG8_BAR; PG8_SCHED;
        }
        if (wr == 0) PG8_BAR;
        if constexpr (Epi::PRE) E(acc, cur, wr, wc, fr, fq, lds, ui & 1); else E(acc, cur, wr, wc, fr, fq);
        if (!has_next) break;
#pragma unroll
        for (int a = 0; a < 2; ++a)
#pragma unroll
            for (int b = 0; b < 2; ++b)
#pragma unroll
                for (int m = 0; m < 4; ++m)
#pragma unroll
                    for (int n = 0; n < 2; ++n) acc[a][b][m][n] = AccT{};
        cur = nxt; cA = nA; cB = nB; ++ui;
        if constexpr (Epi::PRE) E.stage(lds, cur, wid, lane, ui & 1);
        if (wr == 1) PG8_BAR;
    }
    PG8_WAIT_V(0);
    PG8_BAR;
#undef PG8_SA
#undef PG8_SB
#undef PG8_STAGE
#undef PG8_LDA
#undef PG8_LDB
#undef PG8_MMA
#undef PG8_WAIT_V
#undef PG8_WAIT_L
#undef PG8_BAR
#undef PG8_SCHED
#undef PG8_ABASE
#undef PG8_BBASE
}

typedef f32x4 Acc[2][2][4][2];
struct EpiSwiGLU {
    typedef f32x4 AccT;
    static constexpr bool PERM = true;
    static constexpr bool PRE = false;
    bf16* H;
    __device__ __forceinline__ void operator()(const Acc& acc, const Unit& u, int wr, int wc, int fr, int fq) const {
        const int row0 = u.pm * BM + wr * 64 + fr, col0 = u.pn * HALF + wc * 32 + 8 * fq;
#pragma unroll
        for (int ai = 0; ai < 2; ++ai)
#pragma unroll
            for (int m = 0; m < 4; ++m) {
                bf16* rowp = H + (size_t)(row0 + ai * HALF + m * 16) * FF + col0;
                float h[8];
#pragma unroll
                for (int n = 0; n < 2; ++n)
#pragma unroll
                    for (int e = 0; e < 4; ++e) { const float gt = acc[ai][0][m][n][e], up = acc[ai][1][m][n][e]; h[4 * n + e] = gt * sigmoidf_(gt) * up; }
                u32x4 w; w.x = cvt_pk_bf16(h[0], h[1]); w.y = cvt_pk_bf16(h[2], h[3]); w.z = cvt_pk_bf16(h[4], h[5]); w.w = cvt_pk_bf16(h[6], h[7]);
                *(u32x4*)rowp = w;
            }
    }
};
typedef i32x4 AccI[2][2][4][2];
struct EpiSwiGLUI8 {
    typedef i32x4 AccT;
    static constexpr bool PERM = true;
    static constexpr bool PRE = true;
    bf16* H; const float* sx; const float* cmax;
    __device__ __forceinline__ void stage(LAS unsigned char* lds, const Unit& u, int wid, int lane, int par) const {
        const float* src = wid < 4 ? sx + (size_t)u.pm * BM + wid * 64 + lane : cmax + (size_t)u.pn * BM + (wid - 4) * 64 + lane;
        __builtin_amdgcn_global_load_lds((const unsigned*)src, (LAS unsigned*)(lds + SCL_OFF + par * 2048 + wid * 256), 4, 0, 0);
    }
    __device__ __forceinline__ void operator()(const AccI& acc, const Unit& u, int wr, int wc, int fr, int fq, const LAS unsigned char* lds, int par) const {
        const int row0 = u.pm * BM + wr * 64 + fr, col0 = u.pn * HALF + wc * 32 + 8 * fq, cb = wc * 32 + 8 * fq;
        const LAS float* sl = (const LAS float*)(lds + SCL_OFF + par * 2048); const LAS float* cl = sl + 256;
        constexpr float Q2 = -LOG2E / (127.f * 127.f), QU = -(127.f / H8_CLIP) / (LOG2E * 127.f * 127.f);
        f32x2 gs[4], us[4];
        { const f32x4 g0 = *(const LAS f32x4*)(cl + cb) * Q2, g1 = *(const LAS f32x4*)(cl + cb + 4) * Q2, u0 = *(const LAS f32x4*)(cl + cb + HALF) * QU, u1 = *(const LAS f32x4*)(cl + cb + HALF + 4) * QU;
          gs[0] = (f32x2){g0[0], g0[1]}; gs[1] = (f32x2){g0[2], g0[3]}; gs[2] = (f32x2){g1[0], g1[1]}; gs[3] = (f32x2){g1[2], g1[3]};
          us[0] = (f32x2){u0[0], u0[1]}; us[1] = (f32x2){u0[2], u0[3]}; us[2] = (f32x2){u1[0], u1[1]}; us[3] = (f32x2){u1[2], u1[3]}; }
#pragma unroll
        for (int ai = 0; ai < 2; ++ai)
#pragma unroll
            for (int m = 0; m < 4; ++m) {
                const int r = row0 + ai * HALF + m * 16; const float sr = sl[wr * 64 + fr + ai * HALF + m * 16]; const f32x2 sr2 = (f32x2){sr, sr};
                unsigned char* rowp = (unsigned char*)H + (size_t)r * FF + col0;
                u32x2 w = (u32x2){0u, 0u};
#pragma unroll
                for (int p = 0; p < 4; ++p) {
                    const int n = p >> 1, e = (p & 1) * 2;
                    const f32x2 cg = (f32x2){(float)acc[ai][0][m][n][e], (float)acc[ai][0][m][n][e + 1]}, cu = (f32x2){(float)acc[ai][1][m][n][e], (float)acc[ai][1][m][n][e + 1]};
                    const f32x2 z = cg * (sr2 * gs[p]), up = cu * (sr2 * us[p]);
                    const f32x2 dn = (f32x2){fexp2(z[0]), fexp2(z[1])} + (f32x2){1.f, 1.f};
                    const f32x2 t = z * (f32x2){frcp(dn[0]), frcp(dn[1])};
                    const f32x2 q = __builtin_elementwise_fma(t, up, (f32x2){128.f, 128.f});
                    unsigned wd = n ? w.y : w.x;
                    wd = __builtin_amdgcn_cvt_pk_u8_f32(q[0], e, wd); wd = __builtin_amdgcn_cvt_pk_u8_f32(q[1], e + 1, wd);
                    if (n) w.y = wd; else w.x = wd;
                }
                w.x ^= 0x80808080u; w.y ^= 0x80808080u;
                *(u32x2*)rowp = w;
            }
    }
};
template <int HALFSC> struct ResidAcc { typedef f32x4 T; };
template <> struct ResidAcc<1> { typedef i32x4 T; };
template <int HALFSC, int RAWIN = 0> struct EpiResid {
    typedef typename ResidAcc<HALFSC>::T AccT;
    static constexpr bool PERM = true;
    static constexpr bool PRE = false;
    static constexpr float alpha = ALPHA, s = HALFSC ? 0.5f : 1.0f;
    bf16* VF; const float* st; const float* g; const float* b; float* PART; const float* cmax; const float* xin;
    __device__ __forceinline__ void operator()(const AccT (&acci)[2][2][4][2], const Unit& u, int wr, int wc, int fr, int fq) const {
        const int rl0 = wr * 64 + fr, col0 = u.pn * BM + wc * 32 + 8 * fq;
        f32x4 acc[2][2][4][2];
        if constexpr (HALFSC) {
#pragma unroll
            for (int bj = 0; bj < 2; ++bj)
#pragma unroll
                for (int n = 0; n < 2; ++n) { const f32x4 cs = *(const f32x4*)(cmax + col0 + bj * HALF + n * 4) * (H8_CLIP / (127.f * 127.f));
#pragma unroll
                    for (int ai = 0; ai < 2; ++ai)
#pragma unroll
                        for (int m = 0; m < 4; ++m) { const i32x4 q = acci[ai][bj][m][n]; acc[ai][bj][m][n] = (f32x4){(float)q[0], (float)q[1], (float)q[2], (float)q[3]} * cs; } }
        } else {
#pragma unroll
            for (int ai = 0; ai < 2; ++ai)
#pragma unroll
                for (int bj = 0; bj < 2; ++bj)
#pragma unroll
                    for (int m = 0; m < 4; ++m)
#pragma unroll
                        for (int n = 0; n < 2; ++n) acc[ai][bj][m][n] = acci[ai][bj][m][n];
        }
        bf16* vf_ = VF; float* part_ = PART; const float* st_ = st; const float* g_ = g; const float* b_ = b;
        if (u.ks >= 0) {
#pragma unroll
            for (int ai = 0; ai < 2; ++ai)
#pragma unroll
                for (int m = 0; m < 4; ++m) { float* p = part_ + ((size_t)(u.ks * BM + rl0 + ai * HALF + m * 16)) * DM + col0;
                    if (rl0 + ai * HALF + m * 16 < NROWS - (MP - BM)) {
#pragma unroll
                        for (int bj = 0; bj < 2; ++bj)
#pragma unroll
                            for (int n = 0; n < 2; ++n) *(f32x4*)(p + bj * HALF + n * 4) = acc[ai][bj][m][n]; } }
            return;
        }
        f32x4 gv[2][2], bv[2][2];
#pragma unroll
        for (int bj = 0; bj < 2; ++bj)
#pragma unroll
            for (int n = 0; n < 2; ++n) { gv[bj][n] = (f32x4){1.f, 1.f, 1.f, 1.f}; bv[bj][n] = (f32x4){0.f, 0.f, 0.f, 0.f};
                if (st_) { gv[bj][n] = *(const f32x4*)(g_ + col0 + bj * HALF + n * 4); bv[bj][n] = *(const f32x4*)(b_ + col0 + bj * HALF + n * 4); } }
#pragma unroll
        for (int ai = 0; ai < 2; ++ai)
#pragma unroll
            for (int m = 0; m < 4; ++m) {
                const int r = u.pm * BM + rl0 + ai * HALF + m * 16; const size_t off = (size_t)r * DM + col0;
                float mu = 0.f, rs = 1.f; if (st_) { const f32x2 t = *(const f32x2*)(st_ + 2 * (size_t)r); mu = t[0]; rs = t[1]; }
                const int bb_ = r / RS, tt_ = r - bb_ * RS - 1; const float* xr_ = xin + (size_t)(bb_ * T + (tt_ < 0 ? 0 : tt_)) * DM + col0;
#pragma unroll
                for (int bj = 0; bj < 2; ++bj) { u32x4 w8 = (u32x4){0u, 0u, 0u, 0u}; if (!RAWIN) w8 = *(const u32x4*)(vf_ + off + bj * HALF); f32x4 o[2];
#pragma unroll
                    for (int n = 0; n < 2; ++n) { f32x4 x;
                        if (RAWIN) { x = *(const f32x4*)(xr_ + bj * HALF + n * 4); if (tt_ < 0) x = (f32x4){0.f, 0.f, 0.f, 0.f}; }
                        else { const unsigned wa = n ? w8.z : w8.x, wb = n ? w8.w : w8.y; const f32x4 v = (f32x4){bflo(wa), bfhi(wa), bflo(wb), bfhi(wb)}; x = (v - mu) * rs * gv[bj][n] + bv[bj][n]; }
                        o[n] = x * alpha + acc[ai][bj][m][n] * s; }
                    u32x4 wo; wo.x = cvt_pk_bf16(o[0][0], o[0][1]); wo.y = cvt_pk_bf16(o[0][2], o[0][3]); wo.z = cvt_pk_bf16(o[1][0], o[1][1]); wo.w = cvt_pk_bf16(o[1][2], o[1][3]);
                    *(u32x4*)(vf_ + off + bj * HALF) = wo; }
            }
    }
};
struct EpiRwkv {
    typedef f32x4 AccT;
    static constexpr bool PERM = true;
    static constexpr bool PRE = false;
    bf16* RKV; float* Z;
    __device__ __forceinline__ void operator()(const Acc& acc, const Unit& u, int wr, int wc, int fr, int fq) const {
        const int row0 = u.pm * BM + wr * 64 + fr;
        bf16* rkv_ = RKV; float* z_ = Z; asm volatile("" : "+s"(rkv_), "+s"(z_));
        if (u.pn < 24) {
            bf16* base = rkv_ + (size_t)(u.pn >> 3) * ACT_ELEMS; const int col0 = (u.pn & 7) * BM + wc * 32 + 8 * fq;
#pragma unroll
            for (int ai = 0; ai < 2; ++ai)
#pragma unroll
                for (int m = 0; m < 4; ++m)
#pragma unroll
                    for (int bj = 0; bj < 2; ++bj) { const f32x4 v0 = acc[ai][bj][m][0], v1 = acc[ai][bj][m][1];
                        u32x4 w; w.x = cvt_pk_bf16(v0[0], v0[1]); w.y = cvt_pk_bf16(v0[2], v0[3]); w.z = cvt_pk_bf16(v1[0], v1[1]); w.w = cvt_pk_bf16(v1[2], v1[3]);
                        *(u32x4*)(base + (size_t)(row0 + ai * HALF + m * 16) * DM + col0 + bj * HALF) = w; }
        } else {
            const int col0 = (u.pn - 24) * BM + wc * 32 + 8 * fq;
#pragma unroll
            for (int ai = 0; ai < 2; ++ai)
#pragma unroll
                for (int m = 0; m < 4; ++m)
#pragma unroll
                    for (int bj = 0; bj < 2; ++bj) { float* p = z_ + (size_t)(row0 + ai * HALF + m * 16) * 1024 + col0 + bj * HALF;
                        *(f32x4*)p = acc[ai][bj][m][0]; *(f32x4*)(p + 4) = acc[ai][bj][m][1]; }
        }
    }
};
struct EpiLora2 {
    typedef f32x4 AccT;
    static constexpr bool PERM = true;
    static constexpr bool PRE = false;
    bf16 *WAG, *GGp; const float *w0, *a0;
    __device__ __forceinline__ void operator()(const Acc& acc, const Unit& u, int wr, int wc, int fr, int fq) const {
        const int row0 = u.pm * BM + wr * 64 + fr; const int kind = u.pn >> 3;
        bf16* wag_ = WAG; bf16* gg_ = GGp; const float* w0_ = w0; const float* a0_ = a0; asm volatile("" : "+s"(wag_), "+s"(gg_), "+s"(w0_), "+s"(a0_));
        bf16* base = wag_ + (size_t)kind * ACT_ELEMS; if (kind == 2) base = gg_; const float* bias = w0_; if (kind != 0) bias = a0_;
#pragma unroll
        for (int bj = 0; bj < 2; ++bj) {
            const int col0 = (u.pn & 7) * BM + bj * HALF + wc * 32 + 8 * fq;
            f32x4 b0 = (f32x4){0.f, 0.f, 0.f, 0.f}, b1 = b0;
            if (kind < 2) { b0 = *(const f32x4*)(bias + col0); b1 = *(const f32x4*)(bias + col0 + 4); }
#pragma unroll
            for (int ai = 0; ai < 2; ++ai)
#pragma unroll
                for (int m = 0; m < 4; ++m) { float h[8];
#pragma unroll
                    for (int e = 0; e < 4; ++e) { h[e] = acc[ai][bj][m][0][e] + b0[e]; h[4 + e] = acc[ai][bj][m][1][e] + b1[e]; }
                    if (kind == 0) {
#pragma unroll
                        for (int e = 0; e < 8; ++e) h[e] = -0.60653066f * sigmoidf_(h[e]);
                    } else if (kind == 1) {
#pragma unroll
                        for (int e = 0; e < 8; ++e) h[e] = sigmoidf_(h[e]);
                    }
                    u32x4 w; w.x = cvt_pk_bf16(h[0], h[1]); w.y = cvt_pk_bf16(h[2], h[3]); w.z = cvt_pk_bf16(h[4], h[5]); w.w = cvt_pk_bf16(h[6], h[7]);
                    *(u32x4*)(base + (size_t)(row0 + ai * HALF + m * 16) * DM + col0) = w; }
        }
    }
};
struct EpiKV {
    typedef f32x4 AccT;
    static constexpr bool PERM = true;
    static constexpr bool PRE = false;
    float* out; bf16* KB;
    __device__ __forceinline__ void operator()(const Acc& acc, const Unit& u, int wr, int wc, int fr, int fq) const {
        const int row0 = u.pm * BM + wr * 64 + fr; const int isv = u.pn >= 8 ? 1 : 0; const int col0 = (u.pn & 7) * BM + wc * 32 + 8 * fq;
        float* out_ = out; bf16* kb_ = KB; asm volatile("" : "+s"(out_), "+s"(kb_));
#pragma unroll
        for (int ai = 0; ai < 2; ++ai)
#pragma unroll
            for (int m = 0; m < 4; ++m) {
                const int r = row0 + ai * HALF + m * 16; int samp, b, t;
                if (!row_decode(r, samp, b, t)) continue;
                size_t fofs = O_KP + (size_t)isv * (O_VP - O_KP) + (size_t)(b * T + t) * DM;
                if (samp) fofs = O_KS + (size_t)isv * (O_VS - O_KS) + (size_t)(b * TS + t) * DM;
                float* fo = out_ + fofs + col0;
                bf16* bo = kb_ + (size_t)isv * ((WS_VB - WS_KB) / 2) + (size_t)(samp ? NB * T + b * KVS + PAST + t : b * T + t) * DM + col0;
#pragma unroll
                for (int bj = 0; bj < 2; ++bj) { const f32x4 v0 = acc[ai][bj][m][0], v1 = acc[ai][bj][m][1]; *(f32x4*)(fo + bj * HALF) = v0; *(f32x4*)(fo + bj * HALF + 4) = v1;
                    u32x4 w; w.x = cvt_pk_bf16(v0[0], v0[1]); w.y = cvt_pk_bf16(v0[2], v0[3]); w.z = cvt_pk_bf16(v1[0], v1[1]); w.w = cvt_pk_bf16(v1[2], v1[3]); *(u32x4*)(bo + bj * HALF) = w; }
            }
    }
};
struct EpiKVQ {
    typedef f32x4 AccT;
    static constexpr bool PERM = true;
    static constexpr bool PRE = false;
    float* out; bf16* KB; bf16* Q;
    __device__ __forceinline__ void operator()(const Acc& acc, const Unit& u, int wr, int wc, int fr, int fq) const {
        if (u.pn < 16) { EpiKV e{out, KB}; e(acc, u, wr, wc, fr, fq); return; }
        const int row0 = u.pm * BM + wr * 64 + fr, col0 = (u.pn - 16) * BM + wc * 32 + 8 * fq;
#pragma unroll
        for (int ai = 0; ai < 2; ++ai)
#pragma unroll
            for (int m = 0; m < 4; ++m)
#pragma unroll
                for (int bj = 0; bj < 2; ++bj) { const f32x4 v0 = acc[ai][bj][m][0] * QSCALE, v1 = acc[ai][bj][m][1] * QSCALE;
                    u32x4 w; w.x = cvt_pk_bf16(v0[0], v0[1]); w.y = cvt_pk_bf16(v0[2], v0[3]); w.z = cvt_pk_bf16(v1[0], v1[1]); w.w = cvt_pk_bf16(v1[2], v1[3]);
                    *(u32x4*)(Q + (size_t)(row0 + ai * HALF + m * 16) * DM + col0 + bj * HALF) = w; }
    }
};
struct EpiQ {
    typedef f32x4 AccT;
    static constexpr bool PERM = true;
    static constexpr bool PRE = false;
    bf16* Q;
    __device__ __forceinline__ void operator()(const Acc& acc, const Unit& u, int wr, int wc, int fr, int fq) const {
        const int row0 = u.pm * BM + wr * 64 + fr, col0 = u.pn * BM + wc * 32 + 8 * fq;
#pragma unroll
        for (int ai = 0; ai < 2; ++ai)
#pragma unroll
            for (int m = 0; m < 4; ++m)
#pragma unroll
                for (int bj = 0; bj < 2; ++bj) { const f32x4 v0 = acc[ai][bj][m][0] * QSCALE, v1 = acc[ai][bj][m][1] * QSCALE;
                    u32x4 w; w.x = cvt_pk_bf16(v0[0], v0[1]); w.y = cvt_pk_bf16(v0[2], v0[3]); w.z = cvt_pk_bf16(v1[0], v1[1]); w.w = cvt_pk_bf16(v1[2], v1[3]);
                    *(u32x4*)(Q + (size_t)(row0 + ai * HALF + m * 16) * DM + col0 + bj * HALF) = w; }
    }
};
}

struct Args { const float* in[31]; float* out; unsigned char* ws; int ph_lo, ph_hi; };
struct Frame {
    LAS unsigned char* lds; volatile LAS unsigned* MISC; gu32* ctl;
    int tid, lane, wave, vcu, G;
};

__device__ __forceinline__ void tr_item(const float* W, int N, int k0, int n0, LAS float* scr, int lane, bf16* dst, size_t ldd, const float* sc, int mode) {
    float tv[32];
#pragma unroll
    for (int i = 0; i < 32; ++i) tv[i] = W[(size_t)(k0 + 2 * i + (lane >> 5)) * N + n0 + (lane & 31)];
    if (mode) {
#pragma unroll
        for (int i = 0; i < 32; ++i) { const float s = sc[k0 + 2 * i + (lane >> 5)]; tv[i] *= (mode == 1) ? s : (1.f - s); }
    }
#pragma unroll
    for (int i = 0; i < 32; ++i) scr[(2 * i + (lane >> 5)) * 33 + (lane & 31)] = tv[i];
    LDS_WAIT(); asm volatile("" ::: "memory");
    const int c = lane & 7;
#pragma unroll
    for (int j = 0; j < 4; ++j) { const int n = (lane >> 3) + 8 * j; const LAS float* s = scr + (8 * c) * 33 + n;
        u32x4 o; o.x = pk2(s[0 * 33], s[1 * 33]); o.y = pk2(s[2 * 33], s[3 * 33]); o.z = pk2(s[4 * 33], s[5 * 33]); o.w = pk2(s[6 * 33], s[7 * 33]);
        *(u32x4*)(dst + (size_t)n * ldd + 8 * c) = o; }
    LDS_WAIT(); asm volatile("" ::: "memory");
}

__device__ __forceinline__ void p0_prologue(Frame& F, const Args& a) {
    LAS float* scr = (LAS float*)(F.lds + F.wave * 16384);
    const int gw = F.vcu * NWAVES + F.wave, NGW = F.G * NWAVES, lane = F.lane;
    unsigned char* ws = a.ws;
    constexpr int I_IN = 32 * 352, I_OUT = 88 * 64, I_SQ = 32 * 64, I_KV = 32 * 128, I_L96 = 32 * 3, I_L256 = 32 * 8;
    constexpr int N0 = 4 * I_IN, N1 = N0 + 4 * I_OUT, N2 = N1 + 3 * I_SQ, N3 = N2 + 2 * (2 * I_L96 + I_L256), N4 = N3 + 3 * I_SQ, N5 = N4 + I_KV;
    for (int it = gw; it < N5; it += NGW) {
        if (it < N0) {
            const int mi = it / I_IN, r = it % I_IN, kb = r / 352, nb = r % 352, n0 = nb * 32;
            const int isup = n0 >= FF, c = isup ? n0 - FF : n0, drow = (c >> 7) * 256 + isup * 128 + (c & 127);
            const float* W = a.in[8] + (size_t)mi * DM * 2 * FF; float m = 0.f;
#pragma unroll
            for (int i = 0; i < 32; ++i) m = fmaxf(m, fabsf(W[(size_t)(kb * 64 + 2 * i + (lane >> 5)) * (2 * FF) + n0 + (lane & 31)]));
            m = fmaxf(m, __shfl_xor(m, 32));
            if (lane < 32) atomicMax((unsigned*)(F.ctl + CW_CMAX) + mi * 2 * FF + drow + lane, __float_as_uint(m));
        } else if (it < N1) {
            const int q = it - N0, mi = q / I_OUT, r = q % I_OUT, kb = r / 64, nb = r % 64;
            const float* W = a.in[9] + (size_t)mi * FF * DM; float m = 0.f;
#pragma unroll
            for (int i = 0; i < 32; ++i) m = fmaxf(m, fabsf(W[(size_t)(kb * 64 + 2 * i + (lane >> 5)) * DM + nb * 32 + (lane & 31)]));
            m = fmaxf(m, __shfl_xor(m, 32));
            if (lane < 32) atomicMax((unsigned*)(F.ctl + CW_CMAX2) + mi * DM + nb * 32 + lane, __float_as_uint(m));
        } else if (it < N2) {
            const int q = it - N1, j = q / I_SQ, rr = q % I_SQ, kb = rr / 64, nb = rr % 64;
            tr_item(a.in[11] + (size_t)j * DM * DM, DM, kb * 64, nb * 32, scr, lane, (bf16*)(ws + WS_WCAT) + (size_t)(j * DM + nb * 32) * KCAT + kb * 64, KCAT, nullptr, 0);
        } else if (it < N3) {
            int q = it - N2; const int half = q / (2 * I_L96 + I_L256); q %= (2 * I_L96 + I_L256);
            const float* W; int N, mix, rowoff;
            if (q < I_L96) { W = a.in[13]; N = 96; mix = 1; rowoff = 0; } else if (q < 2 * I_L96) { q -= I_L96; W = a.in[16]; N = 96; mix = 4; rowoff = 96; } else { q -= 2 * I_L96; W = a.in[18]; N = 256; mix = 5; rowoff = 192; }
            const int nbn = N / 32, kb = q / nbn, nb = q % nbn;
            tr_item(W, N, kb * 64, nb * 32, scr, lane, (bf16*)(ws + WS_WCAT) + (size_t)(6144 + half * 512 + rowoff + nb * 32) * KCAT + kb * 64, KCAT, a.in[10] + mix * DM, half ? 1 : 2);
        } else if (it < N4) {
            const int q = it - N3, j = q / I_SQ, r = q % I_SQ, kb = r / 64, nb = r % 64;
            const float* W = j == 0 ? a.in[25] : (j == 1 ? a.in[27] : a.in[30]); const size_t wo = j == 0 ? WS_WOR : (j == 1 ? WS_WQ : WS_WOD);
            tr_item(W, DM, kb * 64, nb * 32, scr, lane, (bf16*)(ws + wo) + (size_t)(nb * 32) * DM + kb * 64, DM, nullptr, 0);
        } else {
            const int q = it - N4, kb = q / 128, nb = q % 128;
            tr_item(a.in[26], 4096, kb * 64, nb * 32, scr, lane, (bf16*)(ws + WS_WKV) + (size_t)(nb * 32) * DM + kb * 64, DM, nullptr, 0);
        }
    }
    const int gt = F.vcu * 512 + F.tid, NGT = F.G * 512;
    for (int i = gt; i < 2 * 64 * KCAT / 8; i += NGT) { const int hf = i / (64 * KCAT / 8), j = i % (64 * KCAT / 8);
        *(u32x4*)((bf16*)(ws + WS_WCAT) + (size_t)(6592 + hf * 512) * KCAT + (size_t)j * 8) = (u32x4){0u, 0u, 0u, 0u}; }
    for (int i = gt; i < NL2 * (KL2 / 8); i += NGT) {
        const int n = i / (KL2 / 8), k8 = (i % (KL2 / 8)) * 8, kind = n >> 11, nn = n & 2047;
        const int klo = kind == 0 ? 0 : (kind == 1 ? 96 : 192), khi = kind == 0 ? 96 : (kind == 1 ? 192 : 448);
        const float* W = kind == 0 ? a.in[14] : (kind == 1 ? a.in[17] : a.in[19]);
        float v[8];
#pragma unroll
        for (int e = 0; e < 8; ++e) { const int k = k8 + e; v[e] = (k >= klo && k < khi) ? W[(size_t)(k - klo) * DM + nn] : 0.f; }
        u32x4 o; o.x = pk2(v[0], v[1]); o.y = pk2(v[2], v[3]); o.z = pk2(v[4], v[5]); o.w = pk2(v[6], v[7]);
        *(u32x4*)((bf16*)(ws + WS_WL2) + (size_t)n * KL2 + k8) = o;
    }
    bf16* XF = (bf16*)(ws + WS_XF); unsigned char* XQ = ws + WS_XQ; float* SX = (float*)(ws + WS_SX);
    for (int r0 = gw; r0 < MP; r0 += 3 * NGW) {
        f32x4 v[3][8];
#pragma unroll
        for (int k = 0; k < 3; ++k) { const int r = r0 + k * NGW; int samp = 0, b = 0, t = 0; const bool ok = r < MP && row_decode(r, samp, b, t);
            const float* src = samp ? a.in[1] + (size_t)(b * TS + t) * DM : a.in[0] + (size_t)(b * T + t) * DM;
#pragma unroll
            for (int j = 0; j < 8; ++j) { v[k][j] = (f32x4){0.f, 0.f, 0.f, 0.f}; if (ok) v[k][j] = *(const f32x4*)(src + 4 * lane + 256 * j); } }
#pragma unroll
        for (int k = 0; k < 3; ++k) { const int r = r0 + k * NGW;
            if (r < MP) { float m = 0.f;
#pragma unroll
                for (int j = 0; j < 8; ++j) { const int c = 4 * lane + 256 * j;
                    if (r >= 128 * 256) { u32x2 w; w.x = pk2(v[k][j][0], v[k][j][1]); w.y = pk2(v[k][j][2], v[k][j][3]); *(u32x2*)(XF + (size_t)r * DM + c) = w; }
                    m = fmaxf(fmaxf(m, fmaxf(fabsf(v[k][j][0]), fabsf(v[k][j][1]))), fmaxf(fabsf(v[k][j][2]), fabsf(v[k][j][3]))); }
                m = wave_max_dpp(m); const float inv = m > 0.f ? 127.f / m : 0.f;
                if (lane == 0) SX[r] = m;
#pragma unroll
                for (int j = 0; j < 8; ++j) *(unsigned*)(XQ + (size_t)r * DM + 4 * lane + 256 * j) = q8x4(v[k][j], inv); } }
    }
}
__device__ __forceinline__ void tr_item_i8(const float* W, int N, int k0, int n0, LAS float* scr, int lane, unsigned char* dst, size_t ldd, const float* cm) {
    float tv[32];
#pragma unroll
    for (int i = 0; i < 32; ++i) tv[i] = W[(size_t)(k0 + 2 * i + (lane >> 5)) * N + n0 + (lane & 31)];
#pragma unroll
    for (int i = 0; i < 32; ++i) scr[(2 * i + (lane >> 5)) * 33 + (lane & 31)] = tv[i];
    LDS_WAIT(); asm volatile("" ::: "memory");
    const int ch = lane & 3;
#pragma unroll
    for (int j = 0; j < 2; ++j) { const int n = (lane >> 2) + 16 * j; const float cmx = cm[n]; const float inv = cmx > 0.f ? 127.f / cmx : 0.f; const LAS float* sp = scr + (16 * ch) * 33 + n;
        u32x4 o;
        o.x = q8x4((f32x4){sp[0 * 33], sp[1 * 33], sp[2 * 33], sp[3 * 33]}, inv); o.y = q8x4((f32x4){sp[4 * 33], sp[5 * 33], sp[6 * 33], sp[7 * 33]}, inv);
        o.z = q8x4((f32x4){sp[8 * 33], sp[9 * 33], sp[10 * 33], sp[11 * 33]}, inv); o.w = q8x4((f32x4){sp[12 * 33], sp[13 * 33], sp[14 * 33], sp[15 * 33]}, inv);
        *(u32x4*)(dst + (size_t)n * ldd + 16 * ch) = o; }
    LDS_WAIT(); asm volatile("" ::: "memory");
}
__device__ __forceinline__ void p0_quant_win(Frame& F, const Args& a) {
    LAS float* scr = (LAS float*)(F.lds + F.wave * 16384);
    const int gw = F.vcu * NWAVES + F.wave, NGW = F.G * NWAVES, lane = F.lane;
    constexpr int I_IN = 32 * 352, I_OUT = 88 * 64;
    for (int it = gw; it < 4 * (I_IN + I_OUT); it += NGW) {
        if (it < 4 * I_IN) {
            const int mi = it / I_IN, r = it % I_IN, kb = r / 352, nb = r % 352, n0 = nb * 32, k0 = kb * 64;
            const int isup = n0 >= FF, c = isup ? n0 - FF : n0, drow = (c >> 7) * 256 + isup * 128 + (c & 127);
            tr_item_i8(a.in[8] + (size_t)mi * DM * 2 * FF, 2 * FF, k0, n0, scr, lane, a.ws + WS_WIN + mi * WIN_STRIDE + (size_t)drow * DM + k0, DM, (const float*)(F.ctl + CW_CMAX) + mi * 2 * FF + drow);
        } else {
            const int q = it - 4 * I_IN, mi = q / I_OUT, r = q % I_OUT, kb = r / 64, nb = r % 64;
            tr_item_i8(a.in[9] + (size_t)mi * FF * DM, DM, kb * 64, nb * 32, scr, lane, a.ws + WS_WOUT + mi * WOUT_STRIDE + (size_t)(nb * 32) * FF + kb * 64, FF, (const float*)(F.ctl + CW_CMAX2) + mi * DM + nb * 32);
        }
    }
}
constexpr int SPECIAL_ROW0 = 128 * 256;
__device__ __forceinline__ void ln_load(const Args& a, int r, int lane, f32x4 (&v)[8]) {
    const bf16* VF = (const bf16*)(a.ws + WS_XF);
#pragma unroll
    for (int j = 0; j < 8; ++j) { const u32x2 w = *(const u32x2*)(VF + (size_t)r * DM + 4 * lane + 256 * j); v[j] = (f32x4){bflo(w.x), bfhi(w.x), bflo(w.y), bfhi(w.y)}; }
}
__device__ __forceinline__ f32x4 ld4(const float* p) { return *(const f32x4*)p; }
__device__ __forceinline__ f32x4 ld4(const LAS float* p) { return *(const LAS f32x4*)p; }
template <typename GP> __device__ __forceinline__ void ln_row(const Args& a, int r, int lane, GP g, GP bta, const float* gprev, const float* bprev, float alpha, float spart, bool own, f32x4 (&v)[8], int nsplit) {
    bf16* VF = (bf16*)(a.ws + WS_XF); float* ST = (float*)(a.ws + WS_STATS); const float* PART = (const float*)(a.ws + WS_PART);
    if (own && r >= SPECIAL_ROW0) {
        float mu = 0.f, rs = 1.f; if (gprev) { const f32x2 t = *(const f32x2*)(ST + 2 * (size_t)r); mu = t[0]; rs = t[1]; }
#pragma unroll
        for (int j = 0; j < 8; ++j) { const int c = 4 * lane + 256 * j; f32x4 x = v[j];
            if (gprev) x = (v[j] - mu) * rs * *(const f32x4*)(gprev + c) + *(const f32x4*)(bprev + c);
            const float* pp = PART + (size_t)(r - SPECIAL_ROW0) * DM + c;
            f32x4 p = (f32x4){0.f, 0.f, 0.f, 0.f};
            if (r < NROWS) { p = *(const f32x4*)pp + *(const f32x4*)(pp + (size_t)256 * DM);
                if (nsplit == 4) p = p + (*(const f32x4*)(pp + (size_t)512 * DM) + *(const f32x4*)(pp + (size_t)768 * DM)); }
            const f32x4 o = x * alpha + p * spart; u32x2 w; w.x = pk2(o[0], o[1]); w.y = pk2(o[2], o[3]); *(u32x2*)(VF + (size_t)r * DM + c) = w;
            v[j] = (f32x4){bflo(w.x), bfhi(w.x), bflo(w.y), bfhi(w.y)}; }
    }
    float s = 0.f;
#pragma unroll
    for (int j = 0; j < 8; ++j) s += (v[j][0] + v[j][1]) + (v[j][2] + v[j][3]);
    const float mean = wave_sum_dpp(s) * (1.f / DM); float s2 = 0.f;
#pragma unroll
    for (int j = 0; j < 8; ++j) { v[j] = v[j] - mean; s2 += (v[j][0] * v[j][0] + v[j][1] * v[j][1]) + (v[j][2] * v[j][2] + v[j][3] * v[j][3]); }
    const float rstd = 1.f / sqrtf(wave_sum_dpp(s2) * (1.f / DM) + LN_EPS);
    if (own && lane == 0) *(f32x2*)(ST + 2 * (size_t)r) = (f32x2){mean, rstd};
#pragma unroll
    for (int j = 0; j < 8; ++j) { const int c = 4 * lane + 256 * j; v[j] = v[j] * rstd * ld4(g + c) + ld4(bta + c); }
}
__device__ __forceinline__ void ln_loadraw(const Args& a, int r, int lane, u32x2 (&w)[8]) {
    const bf16* VF = (const bf16*)(a.ws + WS_XF);
#pragma unroll
    for (int j = 0; j < 8; ++j) w[j] = *(const u32x2*)(VF + (size_t)r * DM + 4 * lane + 256 * j);
}
__device__ __forceinline__ void ln_pass_row(const Args& a, int r, int lane, const u32x2 (&w)[8], const LAS float* g, const LAS float* bta, const float* gprev, const float* bprev, float spart, bf16* XB, int final, int q8, int nsplit) {
    f32x4 v[8];
#pragma unroll
    for (int j = 0; j < 8; ++j) v[j] = (f32x4){bflo(w[j].x), bfhi(w[j].x), bflo(w[j].y), bfhi(w[j].y)};
    asm volatile("" : "+v"(g), "+v"(bta));
    ln_row(a, r, lane, g, bta, gprev, bprev, ALPHA, spart, true, v, nsplit);
    if (final) {
        int samp, b, t; if (row_decode(r, samp, b, t)) { float* o = a.out + (samp ? O_YS + (size_t)(b * TS + t) * DM : O_YP + (size_t)(b * T + t) * DM);
#pragma unroll
            for (int j = 0; j < 8; ++j) *(f32x4*)(o + 4 * lane + 256 * j) = v[j]; }
    } else {
        if (XB) {
#pragma unroll
            for (int j = 0; j < 8; ++j) { u32x2 o; o.x = pk2(v[j][0], v[j][1]); o.y = pk2(v[j][2], v[j][3]); *(u32x2*)(XB + (size_t)r * DM + 4 * lane + 256 * j) = o; }
        }
        if (q8) {
            float m = 0.f;
#pragma unroll
            for (int j = 0; j < 8; ++j) m = fmaxf(fmaxf(m, fmaxf(fabsf(v[j][0]), fabsf(v[j][1]))), fmaxf(fabsf(v[j][2]), fabsf(v[j][3])));
            m = wave_max_dpp(m); const float inv = m > 0.f ? 127.f / m : 0.f;
            if (lane == 0) ((float*)(a.ws + WS_SX))[r] = m;
#pragma unroll
            for (int j = 0; j < 8; ++j) *(unsigned*)(a.ws + WS_XQ + (size_t)r * DM + 4 * lane + 256 * j) = q8x4(v[j], inv);
        }
    }
}
__device__ __forceinline__ void ln_pass(Frame& F, const Args& a, const float* g_, const float* bta_, const float* gprev, const float* bprev, float spart, bf16* XB, int final, int q8, int nsplit) {
    const int gw = F.vcu * NWAVES + F.wave, NGW = F.G * NWAVES, lane = F.lane;
    LAS float* gl = (LAS float*)F.lds; LAS float* bl = gl + DM;
    for (int i = F.tid; i < DM; i += NWAVES * 64) { gl[i] = g_[i]; bl[i] = bta_[i]; }
    __syncthreads();
    const LAS float* g = gl; const LAS float* bta = bl;
    u32x2 cur[3][8], nxt[3][8];
#pragma unroll
    for (int k = 0; k < 3; ++k)
#pragma unroll
        for (int j = 0; j < 8; ++j) { cur[k][j] = (u32x2){0u, 0u}; nxt[k][j] = (u32x2){0u, 0u}; }
#pragma unroll
    for (int k = 0; k < 3; ++k) if (gw + k * NGW < MP) ln_loadraw(a, gw + k * NGW, lane, cur[k]);
    for (int r = gw; r < MP; r += 3 * NGW) {
#pragma unroll
        for (int k = 0; k < 3; ++k) if (r + (3 + k) * NGW < MP) ln_loadraw(a, r + (3 + k) * NGW, lane, nxt[k]);
#pragma unroll
        for (int k = 0; k < 3; ++k) if (r + k * NGW < MP) ln_pass_row(a, r + k * NGW, lane, cur[k], g, bta, gprev, bprev, spart, XB, final, q8, nsplit);
#pragma unroll
        for (int k = 0; k < 3; ++k)
#pragma unroll
            for (int j = 0; j < 8; ++j) cur[k][j] = nxt[k][j];
    }
}
__device__ __forceinline__ void ln_mix_pass(Frame& F, const Args& a, const float* g_, const float* bta_, float spart, int nsplit) {
    const int gw = F.vcu * NWAVES + F.wave, NGW = F.G * NWAVES, lane = F.lane;
    LAS float* gl = (LAS float*)F.lds; LAS float* bl = gl + DM; LAS float* ml = gl + 2 * DM;
    for (int i = F.tid; i < DM; i += NWAVES * 64) { gl[i] = g_[i]; bl[i] = bta_[i]; ml[i] = a.in[10][i]; ml[DM + i] = a.in[10][2 * DM + i]; ml[2 * DM + i] = a.in[10][3 * DM + i]; }
    __syncthreads();
    const LAS float* g = gl; const LAS float* bta = bl;
    bf16* XB = (bf16*)(a.ws + WS_XBA); bf16* M0 = (bf16*)(a.ws + WS_XBB); bf16* M2 = (bf16*)(a.ws + WS_MIX2); bf16* M3 = (bf16*)(a.ws + WS_MIX3);
    for (int blk = gw; blk * 17 < MP; blk += NGW) {
        const int r0 = blk * 17, r1 = (r0 + 17 < MP) ? r0 + 17 : MP;
        f32x4 yp[8];
#pragma unroll
        for (int j = 0; j < 8; ++j) yp[j] = (f32x4){0.f, 0.f, 0.f, 0.f};
        u32x2 cur[3][8], nxt[3][8];
#pragma unroll
        for (int k = 0; k < 3; ++k)
#pragma unroll
            for (int j = 0; j < 8; ++j) { cur[k][j] = (u32x2){0u, 0u}; nxt[k][j] = (u32x2){0u, 0u}; }
#pragma unroll
        for (int k = 0; k < 3; ++k) if (r0 + k < r1) ln_loadraw(a, r0 + k, lane, cur[k]);
        { int samp, b, t; const bool ok = row_decode(r0, samp, b, t);
          if (ok && r0 <= SPECIAL_ROW0) { ln_load(a, r0 - 1, lane, yp); ln_row(a, r0 - 1, lane, g, bta, nullptr, nullptr, ALPHA, spart, false, yp, nsplit); } }
        for (int rt = r0; rt < r1; rt += 3) {
#pragma unroll
            for (int k = 0; k < 3; ++k) if (rt + 3 + k < r1) ln_loadraw(a, rt + 3 + k, lane, nxt[k]);
#pragma unroll
            for (int k = 0; k < 3; ++k) { const int r = rt + k;
              if (r < r1) {
                int samp, b, t; const bool ok = row_decode(r, samp, b, t);
                f32x4 v[8];
#pragma unroll
                for (int j = 0; j < 8; ++j) v[j] = (f32x4){bflo(cur[k][j].x), bfhi(cur[k][j].x), bflo(cur[k][j].y), bfhi(cur[k][j].y)};
                asm volatile("" : "+v"(g), "+v"(bta));
                ln_row(a, r, lane, g, bta, nullptr, nullptr, ALPHA, spart, true, v, nsplit);
                if (!ok && r < NROWS) {
                    const bool sm = r >= SROW0; const int bb = sm ? (r - SROW0) / SRS : 0;
#pragma unroll
                    for (int j = 0; j < 8; ++j) { v[j] = (f32x4){0.f, 0.f, 0.f, 0.f}; if (sm) v[j] = *(const f32x4*)(a.in[5] + (size_t)bb * DM + 4 * lane + 256 * j); }
                }
                if (ok && t == (samp ? TS - 1 : T - 1)) { float* o = a.out + (samp ? O_SHS : O_SHP) + (size_t)b * DM;
#pragma unroll
                    for (int j = 0; j < 8; ++j) *(f32x4*)(o + 4 * lane + 256 * j) = v[j]; }
                const LAS float* mu_ = ml + 4 * lane; asm volatile("" : "+v"(mu_));
#pragma unroll
                for (int j = 0; j < 8; ++j) { const int c = 4 * lane + 256 * j; const size_t off = (size_t)r * DM + c;
                    u32x2 w; w.x = pk2(v[j][0], v[j][1]); w.y = pk2(v[j][2], v[j][3]); *(u32x2*)(XB + off) = w;
                    if (ok) { const f32x4 d = yp[j] - v[j];
                        const f32x4 m0 = v[j] + d * ld4(mu_ + 0 * DM + 256 * j), m2 = v[j] + d * ld4(mu_ + 1 * DM + 256 * j), m3 = v[j] + d * ld4(mu_ + 2 * DM + 256 * j);
                        w.x = pk2(m0[0], m0[1]); w.y = pk2(m0[2], m0[3]); *(u32x2*)(M0 + off) = w;
                        w.x = pk2(m2[0], m2[1]); w.y = pk2(m2[2], m2[3]); *(u32x2*)(M2 + off) = w;
                        w.x = pk2(m3[0], m3[1]); w.y = pk2(m3[2], m3[3]); *(u32x2*)(M3 + off) = w; }
                    yp[j] = v[j]; }
              } }
#pragma unroll
            for (int k = 0; k < 3; ++k)
#pragma unroll
                for (int j = 0; j < 8; ++j) cur[k][j] = nxt[k][j];
        }
    }
}
__device__ __forceinline__ void lora_hidden_pass(Frame& F, const Args& a) {
    const int gt = F.vcu * 512 + F.tid, NGT = F.G * 512;
    const float* Z = (const float*)((unsigned char*)a.out + DO_Z); bf16* L = (bf16*)(a.ws + WS_L);
    for (int i0 = gt; i0 < MP * 64; i0 += 4 * NGT) {
        const int c = (i0 & 63) * 8;
        f32x4 x0[4], x1[4];
#pragma unroll
        for (int u = 0; u < 4; ++u) { const int i = i0 + u * NGT, r = i >> 6; x0[u] = (f32x4){0.f, 0.f, 0.f, 0.f}; x1[u] = x0[u];
            if (i < MP * 64 && c < 448) { const float* z1 = Z + (size_t)r * 1024 + c; x0[u] = *(const f32x4*)z1; x1[u] = *(const f32x4*)(z1 + 4);
                if (r > 0) { const float* z2 = Z + (size_t)(r - 1) * 1024 + 512 + c; x0[u] = x0[u] + *(const f32x4*)z2; x1[u] = x1[u] + *(const f32x4*)(z2 + 4); } } }
#pragma unroll
        for (int u = 0; u < 4; ++u) { const int i = i0 + u * NGT, r = i >> 6; float h[8];
#pragma unroll
            for (int e = 0; e < 8; ++e) h[e] = 0.f;
            if (c < 448) {
#pragma unroll
                for (int e = 0; e < 8; ++e) { const float x = e < 4 ? x0[u][e & 3] : x1[u][e & 3]; float y;
                    if (c < 96) y = 1.f - 2.f * frcp(fexp2(x * (2.f * LOG2E)) + 1.f); else if (c < 192) y = x; else y = sigmoidf_(x);
                    h[e] = y; }
            }
            if (i < MP * 64) { u32x4 w; w.x = pk2(h[0], h[1]); w.y = pk2(h[2], h[3]); w.z = pk2(h[4], h[5]); w.w = pk2(h[6], h[7]);
                *(u32x4*)(L + (size_t)r * KL2 + c) = w; } }
    }
}

__device__ __forceinline__ void cache_convert(Frame& F, const Args& a) {
    const int gt = F.vcu * 512 + F.tid, NGT = F.G * 512;
    bf16* KB = (bf16*)(a.ws + WS_KB); bf16* VB = (bf16*)(a.ws + WS_VB);
    constexpr int PER = NB * PAST * DM / 8;
    static_assert((2 * PER) % 4 == 0, "cache_convert: four pieces per turn");
    for (int i0 = gt; i0 < 2 * PER; i0 += 4 * NGT) {
        f32x4 v0[4], v1[4];
#pragma unroll
        for (int u = 0; u < 4; ++u) { const int i = i0 + u * NGT; v0[u] = (f32x4){0.f, 0.f, 0.f, 0.f}; v1[u] = v0[u];
            if (i < 2 * PER) { const int which = i >= PER, q = which ? i - PER : i; const float* src = a.in[2 + which] + (size_t)q * 8; v0[u] = *(const f32x4*)src; v1[u] = *(const f32x4*)(src + 4); } }
#pragma unroll
        for (int u = 0; u < 4; ++u) { const int i = i0 + u * NGT;
            if (i < 2 * PER) { const int which = i >= PER, q = which ? i - PER : i; const size_t e = (size_t)q * 8; const int b = (int)(e / ((size_t)PAST * DM)); const size_t rem = e - (size_t)b * PAST * DM;
                u32x4 o; o.x = pk2(v0[u][0], v0[u][1]); o.y = pk2(v0[u][2], v0[u][3]); o.z = pk2(v1[u][0], v1[u][1]); o.w = pk2(v1[u][2], v1[u][3]);
                *(u32x4*)((which ? VB : KB) + (size_t)(NB * T + b * KVS) * DM + rem) = o; } }
    }
}

constexpr int S2_CB = 43264, S2_AL = 0, S2_RH = 4608, S2_BE = 9216, S2_KA = 13824, S2_BH = 18432, S2_KH = 24576, S2_VT = 30720, S2_NT = 36864, S2_MKA = 38400, S2_MBR = 39936, S2_MKR = 41472, S2_PC = 43008;
constexpr int S2_YST = 2 * S2_CB, S2_RKS = S2_YST + 16384, S2_RAW = S2_RKS + 256, S2_END = S2_RAW + 20480;
static_assert(S2_END <= RING_BYTES, "scan LDS map");
__device__ __forceinline__ f32x4 mfma4(float a, float b, f32x4 c) { return __builtin_amdgcn_mfma_f32_16x16x4f32(a, b, c, 0, 0, 0); }
__device__ __forceinline__ void scan_unit(Frame& F, const Args& a, int samp, int b, int h, int abl) {
    const int lane = F.lane, w = F.wave, tid = F.tid, c = lane & 15, q = lane >> 4;
    const int nsteps = samp ? TS : T, row0 = samp ? SROW0 + b * SRS + 1 : b * RS + 1;
    const int niter = (nsteps + 31) >> 5;
    LAS unsigned char* lds = F.lds;
    const bf16* gR = (const bf16*)((unsigned char*)a.out + DO_R); const bf16* gK = (const bf16*)((unsigned char*)a.out + DO_KR);
    const bf16* gV = (const bf16*)((unsigned char*)a.out + DO_VV); const bf16* gW = (const bf16*)((unsigned char*)a.out + DO_WLD);
    const bf16* gA = (const bf16*)((unsigned char*)a.out + DO_AG); const bf16* gG = (const bf16*)(a.ws + WS_XBB);
    bf16* Y = (bf16*)(a.ws + WS_XBA);
    const float kk_w = a.in[20][h * 64 + lane], ka_w = a.in[21][h * 64 + lane], rk_w = a.in[22][h * 64 + lane], lg = a.in[23][h * 64 + lane], lb = a.in[24][h * 64 + lane];
    f32x4 ST[4];
#pragma unroll
    for (int mt = 0; mt < 4; ++mt)
#pragma unroll
        for (int i = 0; i < 4; ++i) ST[mt][i] = (samp && w < 4) ? a.in[4][((size_t)(b * 32 + h) * 64 + 16 * w + c) * 64 + 16 * mt + 4 * q + i] : 0.f;
    u32x4 pre[5];
#define S2_LOAD(it) do { const int t_ = tid - 256, tok_ = t_ >> 3, pc_ = t_ & 7, step_ = (it) * 32 + tok_; const size_t go_ = (size_t)(row0 + step_) * DM + h * 64 + pc_ * 8; const bool ok_ = step_ < nsteps; \
        pre[0] = pre[1] = pre[2] = pre[3] = pre[4] = (u32x4){0u, 0u, 0u, 0u}; \
        if (ok_) { pre[0] = *(const u32x4*)(gR + go_); pre[1] = *(const u32x4*)(gK + go_); pre[2] = *(const u32x4*)(gV + go_); pre[3] = *(const u32x4*)(gW + go_); pre[4] = *(const u32x4*)(gA + go_); } } while (0)
#define S2_STORE() do { const int t_ = tid - 256, tok_ = t_ >> 3, pc_ = t_ & 7; _Pragma("unroll") for (int j = 0; j < 5; ++j) \
        *(LAS u32x4*)(lds + S2_RAW + ((j * 32 + tok_) * 64 + pc_ * 8) * 2) = pre[j]; } while (0)
    u32x4 vrN = (u32x4){0u, 0u, 0u, 0u}, grN = (u32x4){0u, 0u, 0u, 0u};
    const float* lgp = a.in[23] + h * 64 + 8 * (lane & 7); const float* lbp = a.in[24] + h * 64 + 8 * (lane & 7);
    const f32x4 lg0_ = *(const f32x4*)lgp, lg1_ = *(const f32x4*)(lgp + 4), lb0_ = *(const f32x4*)lbp, lb1_ = *(const f32x4*)(lbp + 4);
#define S2_VGLOAD(it) do { const int step_ = (it) * 32 + (w - 4) + 4 * (lane >> 3); vrN = (u32x4){0u, 0u, 0u, 0u}; grN = (u32x4){0u, 0u, 0u, 0u}; \
        if (step_ < nsteps) { const size_t go_ = (size_t)(row0 + step_) * DM + h * 64 + 8 * (lane & 7); vrN = *(const u32x4*)(gV + go_); grN = *(const u32x4*)(gG + go_); } } while (0)
#define S2_POST(it) do { const LAS float* yb_ = (const LAS float*)(lds + S2_YST + ((it) & 1) * 8192); const LAS float* rkb_ = (const LAS float*)(lds + S2_RKS + ((it) & 1) * 128); \
        const int tok_ = (w - 4) + 4 * (lane >> 3), step_ = (it) * 32 + tok_; \
        const f32x4 y0_ = *(const LAS f32x4*)(yb_ + tok_ * 64 + 8 * (lane & 7)), y1_ = *(const LAS f32x4*)(yb_ + tok_ * 64 + 8 * (lane & 7) + 4); const float rk_ = rkb_[tok_]; \
        const float mu_ = grp8_sum(((y0_[0] + y0_[1]) + (y0_[2] + y0_[3])) + ((y1_[0] + y1_[1]) + (y1_[2] + y1_[3]))) * (1.f / 64.f); \
        const f32x4 d0_ = y0_ - mu_, d1_ = y1_ - mu_; \
        const float var_ = grp8_sum(((d0_[0] * d0_[0] + d0_[1] * d0_[1]) + (d0_[2] * d0_[2] + d0_[3] * d0_[3])) + ((d1_[0] * d1_[0] + d1_[1] * d1_[1]) + (d1_[2] * d1_[2] + d1_[3] * d1_[3]))) * (1.f / 64.f); \
        const float rs_ = __builtin_amdgcn_rsqf(var_ + GN_EPS); \
        const f32x4 v0_ = (f32x4){bflo(vrN.x), bfhi(vrN.x), bflo(vrN.y), bfhi(vrN.y)}, v1_ = (f32x4){bflo(vrN.z), bfhi(vrN.z), bflo(vrN.w), bfhi(vrN.w)}; \
        const f32x4 g0_ = (f32x4){bflo(grN.x), bfhi(grN.x), bflo(grN.y), bfhi(grN.y)}, g1_ = (f32x4){bflo(grN.z), bfhi(grN.z), bflo(grN.w), bfhi(grN.w)}; \
        const f32x4 o0_ = (d0_ * rs_ * lg0_ + lb0_ + v0_ * rk_) * g0_, o1_ = (d1_ * rs_ * lg1_ + lb1_ + v1_ * rk_) * g1_; \
        if (step_ < nsteps) { u32x4 w_; w_.x = pk2(o0_[0], o0_[1]); w_.y = pk2(o0_[2], o0_[3]); w_.z = pk2(o1_[0], o1_[1]); w_.w = pk2(o1_[2], o1_[3]); \
            *(u32x4*)(Y + (size_t)(row0 + step_) * DM + h * 64 + 8 * (lane & 7)) = w_; } } while (0)
    if (w >= 4) { S2_LOAD(0); S2_STORE(); if (niter > 1) S2_LOAD(1); }
    __syncthreads();
    for (int it = 0; it < niter; ++it) {
        if (abl != 1) {
            const int ch = w >> 2, t0 = 4 * (w & 3);
            const LAS bf16* raw = (const LAS bf16*)(lds + S2_RAW);
            LAS unsigned char* cb = lds + ch * S2_CB;
            float ldv[16];
#pragma unroll
            for (int t = 0; t < 16; ++t) ldv[t] = bf2f(raw[(3 * 32 + ch * 16 + t) * 64 + lane]);
            float Gm = 0.f, gc = 0.f;
#pragma unroll
            for (int t = 0; t < 16; ++t) { Gm += (t < t0) ? ldv[t] : 0.f; gc += ldv[t]; }
            float G[4]; { float g = Gm;
#pragma unroll
                for (int i = 0; i < 4; ++i) { g += bf2f(raw[(3 * 32 + ch * 16 + t0 + i) * 64 + lane]); G[i] = g; } }
            f32x4 bh, kh, vt;
            float eGm = fexp2(Gm * LOG2E);
            const float eGC = fexp2(gc * LOG2E);
            float rr[4], kr[4], aa[4], kkr[4], ss[4], kmod[4], rks[4];
#pragma unroll
            for (int i = 0; i < 4; ++i) { const int tk = ch * 16 + t0 + i;
                rr[i] = bf2f(raw[(0 * 32 + tk) * 64 + lane]); kr[i] = bf2f(raw[(1 * 32 + tk) * 64 + lane]); vt[i] = bf2f(raw[(2 * 32 + tk) * 64 + lane]); aa[i] = bf2f(raw[(4 * 32 + tk) * 64 + lane]); }
#pragma unroll
            for (int i = 0; i < 4; ++i) { kkr[i] = kr[i] * kk_w; ss[i] = kkr[i] * kkr[i]; kmod[i] = kr[i] * (1.f + (aa[i] - 1.f) * ka_w); rks[i] = rr[i] * kmod[i] * rk_w; }
            wave_sum_dpp4(ss); wave_sum_dpp4(rks);
#pragma unroll
            for (int i = 0; i < 4; ++i) {
                const int tk = ch * 16 + t0 + i, t = t0 + i;
                const float kk = kkr[i] * __builtin_amdgcn_rsqf(fmaxf(ss[i], 1e-24f)), bb = kk * aa[i];
                const float eG = fexp2(G[i] * LOG2E), enG = fexp2(-G[i] * LOG2E), eCG = eGC * enG;
                *(LAS float*)(cb + S2_AL + (t * 72 + lane) * 4) = -kk * eGm;
                *(LAS float*)(cb + S2_BE + (t * 72 + lane) * 4) = bb * enG;
                *(LAS float*)(cb + S2_KA + (t * 72 + lane) * 4) = kmod[i] * enG;
                *(LAS float*)(cb + S2_RH + (t * 72 + lane) * 4) = rr[i] * eG;
                bh[i] = bb * eCG; kh[i] = kmod[i] * eCG; eGm = eG;
                if (lane == 0) *(LAS float*)(lds + S2_RKS + (it & 1) * 128 + tk * 4) = rks[i];
            }
            *(LAS f32x4*)(cb + S2_BH + (lane * 24 + t0) * 4) = bh; *(LAS f32x4*)(cb + S2_KH + (lane * 24 + t0) * 4) = kh; *(LAS f32x4*)(cb + S2_VT + (lane * 24 + t0) * 4) = vt;
            if ((w & 3) == 0) *(LAS float*)(cb + S2_PC + lane * 4) = eGC;
        }
        __syncthreads();
        if (abl != 2) {
            const int ch = w >> 2, tile = w & 3;
            LAS unsigned char* cb = lds + ch * S2_CB;
            const LAS float* Ym = (const LAS float*)(cb + S2_AL + (tile >> 1) * 4608);
            const LAS float* Xm = (const LAS float*)(cb + S2_BE + (tile & 1) * 4608);
            f32x4 acc = (f32x4){0.f, 0.f, 0.f, 0.f};
#pragma unroll
            for (int s2 = 0; s2 < 2; ++s2) {
                const f32x4 ya0 = *(const LAS f32x4*)(Ym + c * 72 + 32 * s2 + 4 * q), ya1 = *(const LAS f32x4*)(Ym + c * 72 + 32 * s2 + 16 + 4 * q);
                const f32x4 xb0 = *(const LAS f32x4*)(Xm + c * 72 + 32 * s2 + 4 * q), xb1 = *(const LAS f32x4*)(Xm + c * 72 + 32 * s2 + 16 + 4 * q);
                const u32x4 pa = (u32x4){cvt_pk_bf16(ya0[0], ya0[1]), cvt_pk_bf16(ya0[2], ya0[3]), cvt_pk_bf16(ya1[0], ya1[1]), cvt_pk_bf16(ya1[2], ya1[3])};
                const u32x4 pb = (u32x4){cvt_pk_bf16(xb0[0], xb0[1]), cvt_pk_bf16(xb0[2], xb0[3]), cvt_pk_bf16(xb1[0], xb1[1]), cvt_pk_bf16(xb1[2], xb1[3])};
                acc = __builtin_amdgcn_mfma_f32_16x16x32_bf16(__builtin_bit_cast(bf16x8, pa), __builtin_bit_cast(bf16x8, pb), acc, 0, 0, 0); }
            LAS float* outm = (LAS float*)(cb + S2_NT + tile * 1536);
#pragma unroll
            for (int i = 0; i < 4; ++i) { const int t = 4 * q + i; const bool keep = (tile < 2) ? (c < t) : (c <= t); outm[t * 24 + c] = keep ? acc[i] : 0.f; }
        }
        __syncthreads();
        if (w < 4) { if (abl != 3) {
#pragma unroll 1
            for (int ch = 0; ch < 2; ++ch) {
                const LAS unsigned char* cb = lds + ch * S2_CB;
                f32x4 al[4], rh[4], bhv[4], khv[4], pcv[4];
#pragma unroll
                for (int mt = 0; mt < 4; ++mt) {
                    al[mt] = *(const LAS f32x4*)(cb + S2_AL + (c * 72 + 16 * mt + 4 * q) * 4); rh[mt] = *(const LAS f32x4*)(cb + S2_RH + (c * 72 + 16 * mt + 4 * q) * 4);
                    bhv[mt] = *(const LAS f32x4*)(cb + S2_BH + ((16 * mt + c) * 24 + 4 * q) * 4); khv[mt] = *(const LAS f32x4*)(cb + S2_KH + ((16 * mt + c) * 24 + 4 * q) * 4);
                    pcv[mt] = *(const LAS f32x4*)(cb + S2_PC + (16 * mt + 4 * q) * 4);
                }
                f32x4 nt = *(const LAS f32x4*)(cb + S2_NT + (c * 24 + 4 * q) * 4); const f32x4 mka = *(const LAS f32x4*)(cb + S2_MKA + (c * 24 + 4 * q) * 4);
                const f32x4 mbr = *(const LAS f32x4*)(cb + S2_MBR + (c * 24 + 4 * q) * 4), mkr = *(const LAS f32x4*)(cb + S2_MKR + (c * 24 + 4 * q) * 4);
                const f32x4 vb = *(const LAS f32x4*)(cb + S2_VT + ((16 * w + c) * 24 + 4 * q) * 4);
                const f32x4 nd1 = *(const LAS f32x4*)(cb + S2_NT + ((4 * q + 1) * 24 + 4 * q) * 4), nd2 = *(const LAS f32x4*)(cb + S2_NT + ((4 * q + 2) * 24 + 4 * q) * 4), nd3 = *(const LAS f32x4*)(cb + S2_NT + ((4 * q + 3) * 24 + 4 * q) * 4);
                if (q == (c >> 2)) nt = (f32x4){0.f, 0.f, 0.f, 0.f};
#define S2_PK8(x0, x1) __builtin_bit_cast(bf16x8, (u32x4){cvt_pk_bf16((x0)[0], (x0)[1]), cvt_pk_bf16((x0)[2], (x0)[3]), cvt_pk_bf16((x1)[0], (x1)[1]), cvt_pk_bf16((x1)[2], (x1)[3])})
                const bf16x8 st01 = S2_PK8(ST[0], ST[1]), st23 = S2_PK8(ST[2], ST[3]);
                const f32x4 zero4 = (f32x4){0.f, 0.f, 0.f, 0.f};
                f32x4 rhs = (f32x4){0.f, 0.f, 0.f, 0.f};
                rhs = __builtin_amdgcn_mfma_f32_16x16x32_bf16(S2_PK8(al[0], al[1]), st01, rhs, 0, 0, 0);
                rhs = __builtin_amdgcn_mfma_f32_16x16x32_bf16(S2_PK8(al[2], al[3]), st23, rhs, 0, 0, 0);
                rhs = __builtin_amdgcn_mfma_f32_16x16x32_bf16(S2_PK8(mka, zero4), S2_PK8(vb, zero4), rhs, 0, 0, 0);
                f32x4 ut = rhs;
#define S2_INBLK() do { ut[1] += nd1[0] * ut[0]; ut[2] += nd2[0] * ut[0] + nd2[1] * ut[1]; ut[3] += nd3[0] * ut[0] + nd3[1] * ut[1] + nd3[2] * ut[2]; } while (0)
                if (q == 0) S2_INBLK();
                const bf16x8 ntb = S2_PK8(nt, zero4);
#pragma unroll
                for (int qq = 1; qq < 4; ++qq) {
                    const f32x4 x = __builtin_amdgcn_mfma_f32_16x16x32_bf16(ntb, S2_PK8(ut, zero4), zero4, 0, 0, 0);
                    if (q == qq) { ut = rhs + x; S2_INBLK(); }
                }
#undef S2_INBLK
                f32x4 yv = (f32x4){0.f, 0.f, 0.f, 0.f};
                yv = __builtin_amdgcn_mfma_f32_16x16x32_bf16(S2_PK8(rh[0], rh[1]), st01, yv, 0, 0, 0);
                yv = __builtin_amdgcn_mfma_f32_16x16x32_bf16(S2_PK8(rh[2], rh[3]), st23, yv, 0, 0, 0);
                const bf16x8 uvb = S2_PK8(ut, vb);
                yv = __builtin_amdgcn_mfma_f32_16x16x32_bf16(S2_PK8(mbr, mkr), uvb, yv, 0, 0, 0);
                LAS float* yst = (LAS float*)(lds + S2_YST + (it & 1) * 8192);
#pragma unroll
                for (int i = 0; i < 4; ++i) yst[(ch * 16 + 4 * q + i) * 64 + 16 * w + c] = yv[i];
#pragma unroll
                for (int mt = 0; mt < 4; ++mt) ST[mt] = __builtin_amdgcn_mfma_f32_16x16x32_bf16(S2_PK8(bhv[mt], khv[mt]), uvb, ST[mt] * pcv[mt], 0, 0, 0);
#undef S2_PK8
            } }
        } else if (abl != 4) {
            if (it + 1 < niter) S2_STORE();
            if (it + 2 < niter) S2_LOAD(it + 2);
            if (it > 0) S2_POST(it - 1);
            S2_VGLOAD(it);
        }
        __syncthreads();
    }
    if (w >= 4) S2_POST(niter - 1);
    else {
        float* so = a.out + (samp ? O_WKVS : O_WKVP) + (size_t)(b * 32 + h) * 4096;
#pragma unroll
        for (int mt = 0; mt < 4; ++mt)
#pragma unroll
            for (int i = 0; i < 4; ++i) so[(16 * w + c) * 64 + 16 * mt + 4 * q + i] = ST[mt][i];
    }
    __syncthreads();
#undef S2_LOAD
#undef S2_STORE
#undef S2_POST
#undef S2_VGLOAD
}

__device__ __forceinline__ int crow(int r, int hi) { return (r & 3) + 8 * (r >> 2) + 4 * hi; }
__device__ __forceinline__ s16x4 vtr(const LAS unsigned char* p) { typedef short v4i16_t __attribute__((ext_vector_type(4))); return __builtin_bit_cast(s16x4, __builtin_amdgcn_ds_read_tr16_b64_v4i16((LAS v4i16_t*)p)); }
__device__ __forceinline__ void attn_unit(Frame& F, const Args& a, int qbase, int kvbase, int hp, int nt0, int ntstep, int NT, int nkeys, int nrg_valid, int nq_valid, float lam, int abl) {
    const int lane = F.lane, wid = F.wave, tid = F.tid, r32 = lane & 31, hi = lane >> 5, rg = wid >> 1, sub = wid & 1;
    const bf16* Q = (const bf16*)((unsigned char*)a.out + DO_Q); bf16* O = (bf16*)(a.ws + WS_XBB);
    const bf16* KB = (const bf16*)(a.ws + WS_KB); const bf16* VB = (const bf16*)(a.ws + WS_VB);
    LAS unsigned char* lds = F.lds; LAS float* wsf = (LAS float*)(lds + ATT_WSF_OFF) + wid * 64;
    const int myNT = rg < nrg_valid ? nt0 + ntstep * (rg >> 1) : 0;
    bf16x8 qr[4];
#pragma unroll
    for (int d0 = 0; d0 < 4; ++d0) qr[d0] = *(const bf16x8*)(Q + (size_t)(qbase + rg * 32 + r32) * DM + (2 * hp + sub) * 64 + d0 * 16 + hi * 8);
    f32x16 o[4];
#pragma unroll
    for (int d = 0; d < 4; ++d)
#pragma unroll
        for (int i = 0; i < 16; ++i) o[d][i] = 0.f;
    float mref = 0.f, lsum = 0.f;
    f32x16 negm;
#pragma unroll
    for (int i = 0; i < 16; ++i) negm[i] = 0.f;
    const bf16* ksrc = KB + (size_t)(kvbase + 8 * wid + (lane >> 3)) * DM + (2 * hp) * 64 + ((lane & 7) ^ ((lane >> 3) & 7)) * 8;
    const bf16* vsrc0 = VB + (size_t)(kvbase + (wid & 3) * 16 + (lane >> 2)) * DM + hp * 128 + (wid >> 2) * 32 + (lane & 3) * 8;
    const bf16* vsrc1 = vsrc0 + 64;
#define AT_DMA(j, slot) do { LAS unsigned char* sb_ = lds + (slot); const size_t to_ = (size_t)(j) * 64 * DM; \
        __builtin_amdgcn_global_load_lds((const unsigned*)(ksrc + to_), (LAS unsigned*)(sb_ + wid * 1024), 16, 0, 0); \
        __builtin_amdgcn_global_load_lds((const unsigned*)(ksrc + to_ + 64), (LAS unsigned*)(sb_ + 8192 + wid * 1024), 16, 0, 0); \
        __builtin_amdgcn_global_load_lds((const unsigned*)(vsrc0 + to_), (LAS unsigned*)(sb_ + 16384 + (wid >> 2) * 4096 + (wid & 3) * 1024), 16, 0, 0); \
        __builtin_amdgcn_global_load_lds((const unsigned*)(vsrc1 + to_), (LAS unsigned*)(sb_ + 16384 + ((wid >> 2) + 2) * 4096 + (wid & 3) * 1024), 16, 0, 0); } while (0)
    AT_DMA(0, 0);
    if (NT > 1) AT_DMA(1, 32768);
    int slot_c = 0, slot_n = 65536;
    const int vtoff = ((lane >> 4) & 1) * 32 + (lane & 3) * 8 + (4 * hi + ((lane & 15) >> 2)) * 64;
    constexpr float ATT_THR = 8.f;
    for (int j = 0; j < NT; ++j) {
        if (j + 1 < NT) asm volatile("s_waitcnt vmcnt(4)" ::: "memory"); else asm volatile("s_waitcnt vmcnt(0)" ::: "memory");
        asm volatile("s_waitcnt lgkmcnt(0)" ::: "memory"); __builtin_amdgcn_s_barrier(); asm volatile("" ::: "memory");
        asm volatile("" : "+s"(slot_c), "+s"(slot_n));
        if (j + 2 < NT) AT_DMA(j + 2, slot_n);
        if (j < myNT && abl != 1) {
            const LAS unsigned char* sb = lds + slot_c; const LAS unsigned char* Ks = sb + sub * 8192; const LAS unsigned char* Vs = sb + 16384;
            f32x16 p0 = negm, p1 = negm;
            bf16x8 kf[4];
#pragma unroll
            for (int d0 = 0; d0 < 2; ++d0) { kf[2 * d0] = *(const LAS bf16x8*)(Ks + r32 * 128 + (((2 * d0 + hi) ^ (r32 & 7)) << 4)); kf[2 * d0 + 1] = *(const LAS bf16x8*)(Ks + 4096 + r32 * 128 + (((2 * d0 + hi) ^ (r32 & 7)) << 4)); }
            __builtin_amdgcn_sched_barrier(0);
#pragma unroll
            for (int d0 = 0; d0 < 2; ++d0) { p0 = __builtin_amdgcn_mfma_f32_32x32x16_bf16(kf[2 * d0], qr[d0], p0, 0, 0, 0); p1 = __builtin_amdgcn_mfma_f32_32x32x16_bf16(kf[2 * d0 + 1], qr[d0], p1, 0, 0, 0); }
#pragma unroll
            for (int d0 = 2; d0 < 4; ++d0) { kf[2 * d0 - 4] = *(const LAS bf16x8*)(Ks + r32 * 128 + (((2 * d0 + hi) ^ (r32 & 7)) << 4)); kf[2 * d0 - 3] = *(const LAS bf16x8*)(Ks + 4096 + r32 * 128 + (((2 * d0 + hi) ^ (r32 & 7)) << 4)); }
#pragma unroll
            for (int d0 = 2; d0 < 4; ++d0) { p0 = __builtin_amdgcn_mfma_f32_32x32x16_bf16(kf[2 * d0 - 4], qr[d0], p0, 0, 0, 0); p1 = __builtin_amdgcn_mfma_f32_32x32x16_bf16(kf[2 * d0 - 3], qr[d0], p1, 0, 0, 0); }
            if ((j + 1) * 64 > nkeys) {
#pragma unroll
                for (int i = 0; i < 16; ++i) { const int kx = j * 64 + crow(i, hi); if (kx >= nkeys) p0[i] = -1e30f; if (kx + 32 >= nkeys) p1[i] = -1e30f; }
            }
            float ra = __builtin_fmaxf(__builtin_fmaxf(p0[0], p0[1]), p1[0]), rb = __builtin_fmaxf(__builtin_fmaxf(p0[2], p0[3]), p1[1]); ra = __builtin_fmaxf(__builtin_fmaxf(ra, p1[2]), p1[3]);
#pragma unroll
            for (int i = 4; i < 16; i += 4) { ra = __builtin_fmaxf(__builtin_fmaxf(ra, p0[i]), p0[i + 1]); rb = __builtin_fmaxf(__builtin_fmaxf(rb, p0[i + 2]), p0[i + 3]);
                ra = __builtin_fmaxf(__builtin_fmaxf(ra, p1[i]), p1[i + 1]); rb = __builtin_fmaxf(__builtin_fmaxf(rb, p1[i + 2]), p1[i + 3]); }
            float rm = __builtin_fmaxf(ra, rb);
            rm = __builtin_fmaxf(rm, __shfl_xor(rm, 32));
            if (j == 0 || __any(rm > ATT_THR)) {
                const float dl = (j == 0) ? rm : __builtin_fmaxf(rm, 0.f);
                mref += dl;
#pragma unroll
                for (int i = 0; i < 16; ++i) { p0[i] -= dl; p1[i] -= dl; negm[i] = -mref; }
                const float f = fexp2(-dl); lsum *= f;
                if (hi == 0) wsf[r32] = f;
                LDS_WAIT();
#pragma unroll
                for (int i = 0; i < 16; ++i) { const float ff = wsf[crow(i, hi)];
#pragma unroll
                    for (int d = 0; d < 4; ++d) o[d][i] *= ff; }
            }
            float ps = 0.f, ps1 = 0.f;
#pragma unroll
            for (int i = 0; i < 16; ++i) { p0[i] = fexp2(p0[i]); p1[i] = fexp2(p1[i]); ps += p0[i]; ps1 += p1[i]; }
            lsum += ps + ps1;
            bf16x8 pa[4];
            { u32x4 t0, t1, t2, t3;
              t0.x = cvt_pk_bf16(p0[0], p0[1]); t0.y = cvt_pk_bf16(p0[2], p0[3]); t0.z = cvt_pk_bf16(p0[4], p0[5]); t0.w = cvt_pk_bf16(p0[6], p0[7]);
              t1.x = cvt_pk_bf16(p0[8], p0[9]); t1.y = cvt_pk_bf16(p0[10], p0[11]); t1.z = cvt_pk_bf16(p0[12], p0[13]); t1.w = cvt_pk_bf16(p0[14], p0[15]);
              t2.x = cvt_pk_bf16(p1[0], p1[1]); t2.y = cvt_pk_bf16(p1[2], p1[3]); t2.z = cvt_pk_bf16(p1[4], p1[5]); t2.w = cvt_pk_bf16(p1[6], p1[7]);
              t3.x = cvt_pk_bf16(p1[8], p1[9]); t3.y = cvt_pk_bf16(p1[10], p1[11]); t3.z = cvt_pk_bf16(p1[12], p1[13]); t3.w = cvt_pk_bf16(p1[14], p1[15]);
              pa[0] = __builtin_bit_cast(bf16x8, t0); pa[1] = __builtin_bit_cast(bf16x8, t1); pa[2] = __builtin_bit_cast(bf16x8, t2); pa[3] = __builtin_bit_cast(bf16x8, t3); }
#define AT_VLD(dst, d) do { _Pragma("unroll") for (int ks = 0; ks < 4; ++ks) { dst[2 * ks] = vtr(Vs + (d) * 4096 + ks * 1024 + vtoff); dst[2 * ks + 1] = vtr(Vs + (d) * 4096 + ks * 1024 + 512 + vtoff); } } while (0)
#define AT_PV(src, d) do { _Pragma("unroll") for (int ks = 0; ks < 4; ++ks) { const bf16x8 vf = (bf16x8){src[2 * ks][0], src[2 * ks][1], src[2 * ks][2], src[2 * ks][3], src[2 * ks + 1][0], src[2 * ks + 1][1], src[2 * ks + 1][2], src[2 * ks + 1][3]}; \
                o[d] = __builtin_amdgcn_mfma_f32_32x32x16_bf16(pa[ks], vf, o[d], 0, 0, 0); } } while (0)
            if (abl != 2) {
            s16x4 va[8], vb2[8];
            AT_VLD(va, 0); __builtin_amdgcn_sched_barrier(0);
            AT_VLD(vb2, 1); __builtin_amdgcn_sched_barrier(0); AT_PV(va, 0); __builtin_amdgcn_sched_barrier(0);
            AT_VLD(va, 2); __builtin_amdgcn_sched_barrier(0); AT_PV(vb2, 1); __builtin_amdgcn_sched_barrier(0);
            AT_VLD(vb2, 3); __builtin_amdgcn_sched_barrier(0); AT_PV(va, 2); __builtin_amdgcn_sched_barrier(0);
            AT_PV(vb2, 3);
            }
#undef AT_VLD
#undef AT_PV
        }
        slot_c = (slot_c == 65536) ? 0 : slot_c + 32768; slot_n = (slot_n == 65536) ? 0 : slot_n + 32768;
    }
    asm volatile("s_waitcnt vmcnt(0) lgkmcnt(0)" ::: "memory"); __builtin_amdgcn_s_barrier(); asm volatile("" ::: "memory");
    lsum += __shfl_xor(lsum, 32);
    if (hi == 0) wsf[32 + r32] = lsum;
    LDS_WAIT();
    LAS float* E = (LAS float*)lds;
    if (myNT > 0) {
#pragma unroll
        for (int i = 0; i < 16; ++i) { const float rl = frcp(wsf[32 + crow(i, hi)]);
#pragma unroll
            for (int d = 0; d < 4; ++d) E[((rg * 2 + sub) * 32 + crow(i, hi)) * 128 + d * 32 + r32] = o[d][i] * rl; }
    }
    __syncthreads();
    if (myNT > 0) {
        const f32x2 sg = *(const f32x2*)(a.in[29] + 2 * lane);
        for (int qq = 0; qq < 16; ++qq) { const int q = 16 * sub + qq;
            if (q >= nq_valid) break;
            const f32x2 e0 = *(const LAS f32x2*)(E + ((rg * 2 + 0) * 32 + q) * 128 + 2 * lane), e1 = *(const LAS f32x2*)(E + ((rg * 2 + 1) * 32 + q) * 128 + 2 * lane);
            const f32x2 ov = e0 - e1 * lam; const float ss = wave_sum_dpp(ov[0] * ov[0] + ov[1] * ov[1]);
            const float sc = __builtin_amdgcn_rsqf(ss * (1.f / 128.f) + LN_EPS) * (1.f - LAMBDA_INIT);
            *(unsigned*)(O + (size_t)(qbase + rg * 32 + q) * DM + hp * 128 + 2 * lane) = pk2(ov[0] * sc * sg[0], ov[1] * sc * sg[1]);
        }
    }
    __syncthreads();
#undef AT_DMA
}

constexpr int NPHASE = 23;
__global__ void __launch_bounds__(NWAVES * 64, 2) mk_fwd(Args args) {
    extern __shared__ __attribute__((aligned(16))) unsigned char lds_raw[];
    Frame F;
    F.lds = (LAS unsigned char*)lds_raw;
    F.MISC = (volatile LAS unsigned*)(F.lds + MISC_OFF);
    F.tid = threadIdx.x; F.lane = F.tid & 63; F.wave = __builtin_amdgcn_readfirstlane(F.tid >> 6);
    F.G = gridDim.x; { const int bx = blockIdx.x; F.vcu = (F.G % 8 == 0) ? (bx % 8) * (F.G / 8) + bx / 8 : bx; }
    unsigned char* ws = args.ws;
    F.ctl = (gu32*)(ws + WS_CTL);
    for (int u = F.tid; u < (LDS_BYTES - LDSCTL_OFF) / 4; u += NWAVES * 64) ((LAS unsigned*)(F.lds + LDSCTL_OFF))[u] = 0u;
    __syncthreads();
    XcdBarrier bar; bar.bar = (unsigned*)(F.ctl + CW_BAR); bar.x = 0; bar.st = nullptr;
    if (MK_SINGLE) bar = xcd_barrier_post((unsigned*)(F.ctl + CW_BAR), F.MISC + 8);
    const int lo = args.ph_lo, hi = args.ph_hi;
#define IN(k) (lo <= (k) && (k) < hi)
#define REP(k) for (int rep_ = 0; rep_ < ((k) == MK_DUP ? 2 : 1); ++rep_)
#define SEAM(k) do { if (IN(k) && IN((k) + 1)) xcd_barrier(bar); } while (0)
    const float* ln_g = args.in[6]; const float* ln_b = args.in[7];
    bf16* VF = (bf16*)(ws + WS_XF); const float* STATS = (const float*)(ws + WS_STATS); float* PART = (float*)(ws + WS_PART);
    bf16* XBA = (bf16*)(ws + WS_XBA); bf16* XBB = (bf16*)(ws + WS_XBB); bf16* HB = (bf16*)(ws + WS_H);
    unsigned char* dob = (unsigned char*)args.out;

#define FFN_G1(mi) do { pg8::Gemm g{(const bf16*)(ws + WS_XQ), (const bf16*)(ws + WS_WIN + (mi) * WIN_STRIDE), MP, 2 * FF, DM / 2, DM / 2, nullptr, nullptr, nullptr}; pg8::StaticOrder S; S.init(MP, 2 * FF, DM / 2, F.G, (int)blockIdx.x, 0); \
        pg8::EpiSwiGLUI8 E{HB, (const float*)(ws + WS_SX), (const float*)(F.ctl + CW_CMAX) + (mi) * 2 * FF}; pg8::gemm_phase<pg8::EpiSwiGLUI8>(F.lds, g, S, E); } while (0)
#define RESID_GEMM(A_, W_, Kk, lnprev, sc, CM_) do { pg8::Gemm g{A_, (const bf16*)(ws + (W_)), MP, DM, (sc) ? (Kk) / 2 : (Kk), (sc) ? (Kk) / 2 : (Kk), nullptr, nullptr, nullptr}; pg8::StaticOrder S; S.init(MP, DM, (sc) ? (Kk) / 2 : (Kk), F.G, (int)blockIdx.x, (sc) ? 2 : 4); \
        pg8::EpiResid<sc> E{VF, (lnprev) >= 0 ? STATS : nullptr, ln_g + ((lnprev) >= 0 ? (lnprev) : 0) * DM, ln_b + ((lnprev) >= 0 ? (lnprev) : 0) * DM, PART, CM_, nullptr}; \
        pg8::gemm_phase<pg8::EpiResid<sc>>(F.lds, g, S, E); } while (0)
#define LN_PASS(lncur, lnprev, sc, XB_, fin, q8_, nsp) ln_pass(F, args, ln_g + (lncur) * DM, ln_b + (lncur) * DM, (lnprev) >= 0 ? ln_g + ((lnprev) >= 0 ? (lnprev) : 0) * DM : nullptr, ln_b + ((lnprev) >= 0 ? (lnprev) : 0) * DM, sc, XB_, fin, q8_, nsp)

    if (IN(0)) { p0_prologue(F, args); xcd_barrier(bar); p0_quant_win(F, args); } SEAM(0);
    if (IN(1)) { REP(1) { FFN_G1(0); } } SEAM(1);
    if (IN(2)) { pg8::Gemm g{HB, (const bf16*)(ws + WS_WOUT), MP, DM, FF / 2, FF / 2, nullptr, nullptr, nullptr}; pg8::StaticOrder S; S.init(MP, DM, FF / 2, F.G, (int)blockIdx.x, 2);
        pg8::EpiResid<1, 1> E{VF, nullptr, ln_g, ln_b, PART, (const float*)(F.ctl + CW_CMAX2), args.in[0]}; pg8::gemm_phase<pg8::EpiResid<1, 1>>(F.lds, g, S, E); } SEAM(2);
    if (IN(3)) { ln_mix_pass(F, args, ln_g + 0 * DM, ln_b + 0 * DM, 0.5f, 2); } SEAM(3);
    if (IN(4)) REP(4) { pg8::Gemm g{XBB, (const bf16*)(ws + WS_WCAT), MP, NCAT, KCAT, DM, (const bf16*)(ws + WS_MIX2), (const bf16*)(ws + WS_MIX3), XBA}; pg8::StaticOrder S; S.init(MP, NCAT, KCAT, F.G, (int)blockIdx.x, 0);
        pg8::EpiRwkv E{(bf16*)(dob + DO_R), (float*)(dob + DO_Z)}; pg8::gemm_phase<pg8::EpiRwkv>(F.lds, g, S, E); } SEAM(4);
    if (IN(5)) { lora_hidden_pass(F, args); } SEAM(5);
    if (IN(6)) { pg8::Gemm g{(const bf16*)(ws + WS_L), (const bf16*)(ws + WS_WL2), MP, NL2, KL2, KL2, nullptr, nullptr, nullptr}; pg8::StaticOrder S; S.init(MP, NL2, KL2, F.G, (int)blockIdx.x, 0, 1);
        pg8::EpiLora2 E{(bf16*)(dob + DO_WLD), XBB, args.in[12], args.in[15]}; pg8::gemm_phase<pg8::EpiLora2>(F.lds, g, S, E); } SEAM(6);
    if (IN(7)) REP(7) {
        const int abl = (MK_DUP == 7 && rep_ == 0) ? MK_ABL : 0;
        for (int u = F.vcu; u < 512; u += F.G) { const int samp = u >= 256, bh = u & 255; scan_unit(F, args, samp, bh >> 5, bh & 31, abl); }
    } SEAM(7);
    if (IN(8)) { RESID_GEMM(XBA, WS_WOR, DM, 0, 0, (const float*)nullptr); } SEAM(8);
    if (IN(9)) { LN_PASS(1, 0, 1.0f, (bf16*)nullptr, 0, 1, 4); } SEAM(9);
    if (IN(10)) { FFN_G1(1); } SEAM(10);
    if (IN(11)) { RESID_GEMM(HB, WS_WOUT + 1 * WOUT_STRIDE, FF, 1, 1, (const float*)(F.ctl + CW_CMAX2) + 1 * DM); } SEAM(11);
    if (IN(12)) { LN_PASS(2, 1, 0.5f, XBA, 0, 1, 2); } SEAM(12);
    if (IN(13)) { FFN_G1(2); } SEAM(13);
    if (IN(14)) { RESID_GEMM(HB, WS_WOUT + 2 * WOUT_STRIDE, FF, 2, 1, (const float*)(F.ctl + CW_CMAX2) + 2 * DM); } SEAM(14);
    if (IN(15)) { LN_PASS(3, 2, 0.5f, XBB, 0, 0, 2); cache_convert(F, args); } SEAM(15);
    if (IN(16)) { pg8::Gemm g{XBA, (const bf16*)(ws + WS_WKV), MP, 3 * DM, DM, DM, XBA, XBB, XBB}; pg8::StaticOrder S; S.init(MP, 3 * DM, DM, F.G, (int)blockIdx.x, 0);
        pg8::EpiKVQ E{args.out, (bf16*)(ws + WS_KB), (bf16*)(dob + DO_Q)}; pg8::gemm_phase<pg8::EpiKVQ>(F.lds, g, S, E); } SEAM(16);
    if (IN(17)) REP(17) {
        const int abl = (MK_DUP == 17 && rep_ == 0) ? MK_ABL : 0;
        const float l0 = args.in[28][F.lane] * args.in[28][64 + F.lane], l1 = args.in[28][128 + F.lane] * args.in[28][192 + F.lane];
        const float lam = __expf(wave_sum(l0)) - __expf(wave_sum(l1)) + LAMBDA_INIT;
        for (int i = 0; i < 8; ++i) { const int pidx = F.vcu + F.G * i; if (pidx >= 2048) break; const int bhp = pidx >> 4, us = pidx & 15, b = bhp >> 4, hp = bhp & 15;
#pragma unroll 1
            for (int k = 0; k < 2; ++k) { const int uq = k ? 31 - us : us;
                attn_unit(F, args, b * RS + 1 + uq * 128, b * T, hp, 2 * uq + 1, 1, 2 * uq + 2, 1 << 30, 4, 32, lam, abl); } }
        for (int u = F.vcu; u < 128; u += F.G) { const int b = u >> 4, hp = u & 15;
            attn_unit(F, args, SROW0 + b * SRS + 1, NB * T + b * KVS, hp, 17, 0, 17, KVS, 1, 16, lam, abl); }
    } SEAM(17);
    if (IN(18)) { RESID_GEMM(XBB, WS_WOD, DM, 3, 0, (const float*)nullptr); } SEAM(18);
    if (IN(19)) { LN_PASS(4, 3, 1.0f, (bf16*)nullptr, 0, 1, 4); } SEAM(19);
    if (IN(20)) { FFN_G1(3); } SEAM(20);
    if (IN(21)) { RESID_GEMM(HB, WS_WOUT + 3 * WOUT_STRIDE, FF, 4, 1, (const float*)(F.ctl + CW_CMAX2) + 3 * DM); } SEAM(21);
    if (IN(22)) REP(22) { LN_PASS(5, 4, 0.5f, XBA, 1, 0, 2); }
#undef IN
#undef SEAM
#undef REP
}

extern "C" void kernel_launch(void* const* d_in, const int* in_sizes, int n_in, void* d_out, int out_size, void* d_ws, size_t ws_size, hipStream_t stream) {
    static int grid = 0;
    if (grid == 0) {
        if (n_in != 31 || (size_t)out_size != O_TOTAL || ws_size < WS_END) { fprintf(stderr, "kernel_launch: unexpected sizes n_in %d out %d ws %zu\n", n_in, out_size, ws_size); grid = -1; return; }
        int dev = 0, cus = 0, per_cu = 0;
        if (hipGetDevice(&dev) != hipSuccess || hipDeviceGetAttribute(&cus, hipDeviceAttributeMultiprocessorCount, dev) != hipSuccess) { grid = -1; return; }
        if (hipFuncSetAttribute((const void*)mk_fwd, hipFuncAttributeMaxDynamicSharedMemorySize, LDS_BYTES) != hipSuccess) { fprintf(stderr, "kernel_launch: hipFuncSetAttribute failed\n"); grid = -1; return; }
        if (hipOccupancyMaxActiveBlocksPerMultiprocessor(&per_cu, (const void*)mk_fwd, NWAVES * 64, LDS_BYTES) != hipSuccess || per_cu < 1) { fprintf(stderr, "kernel_launch: occupancy query says %d\n", per_cu); }
        (void)hipGetLastError();
        grid = cus;
    }
    if (grid < 0) return;
    (void)hipMemsetAsync((char*)d_ws + WS_CTL, 0, CTL_ZERO_BYTES, stream);
    Args a{};
    for (int i = 0; i < 31; ++i) a.in[i] = (const float*)d_in[i];
    a.out = (float*)d_out; a.ws = (unsigned char*)d_ws;
#if MK_SINGLE
    a.ph_lo = 0; a.ph_hi = NPHASE;
    hipLaunchKernelGGL(mk_fwd, dim3(grid), dim3(NWAVES * 64), LDS_BYTES, stream, a);
#else
    for (int p = 0; p < NPHASE; ++p) { a.ph_lo = p; a.ph_hi = p + 1; hipLaunchKernelGGL(mk_fwd, dim3(grid), dim3(NWAVES * 64), LDS_BYTES, stream, a); }
#endif
}
```

```cpp
#include <hip/hip_runtime.h>
#include <cstdio>
#include <cstdint>

#ifndef MK_DUP
#define MK_DUP -1
#endif
#ifndef MK_ABL
#define MK_ABL 0
#endif
#ifndef MK_SINGLE
#define MK_SINGLE 1
#endif

#define GAS __attribute__((address_space(1)))
#define LAS __attribute__((address_space(3)))
typedef unsigned short bf16;
typedef short bf16x8 __attribute__((ext_vector_type(8)));
typedef short s16x4 __attribute__((ext_vector_type(4)));
typedef float f32x2 __attribute__((ext_vector_type(2)));
typedef float f32x4 __attribute__((ext_vector_type(4)));
typedef float f32x16 __attribute__((ext_vector_type(16)));
typedef unsigned u32x2 __attribute__((ext_vector_type(2)));
typedef unsigned u32x4 __attribute__((ext_vector_type(4)));
typedef int i32x4 __attribute__((ext_vector_type(4)));
typedef GAS unsigned gu32;

constexpr int DM = 2048, FF = 5632, T = 4096, NB = 8, TS = 16, PAST = 1024;
constexpr int RS = T + 1;
constexpr int SROW0 = NB * RS;
constexpr int SRS = TS + 1;
constexpr int NROWS = SROW0 + NB * SRS;
constexpr int MP = 33024;
constexpr int KVS = PAST + TS;
constexpr int KVROWS = NB * T + NB * KVS;
constexpr int NCAT = 7168, KCAT = 2048;
constexpr int NL2 = 6144, KL2 = 512;
constexpr float LN_EPS = 1e-5f, GN_EPS = 64e-5f;
constexpr float ALPHA = 1.41421356237f;
constexpr float LOG2E = 1.4426950408889634f;
constexpr float QSCALE = 0.125f * LOG2E;
constexpr float LAMBDA_INIT = 0.35550906f;

constexpr size_t MiB = 1u << 20;
constexpr size_t WS_CTL = 0, CTL_ZERO_BYTES = 1 * MiB;
constexpr size_t WS_WIN = 2 * MiB;
constexpr size_t WIN_STRIDE = (size_t)2 * FF * DM;
constexpr size_t WS_WOUT = 178 * MiB;
constexpr size_t WOUT_STRIDE = (size_t)DM * FF;
constexpr float H8_CLIP = 8.f;
constexpr size_t WS_WCAT = 266 * MiB;
constexpr size_t WS_WL2 = 318 * MiB;
constexpr size_t WS_WOR = 324 * MiB, WS_WOD = 332 * MiB, WS_WKV = 340 * MiB, WS_WQ = 356 * MiB;
constexpr size_t WS_XF = 364 * MiB;
constexpr size_t WS_XBA = 623 * MiB;
constexpr size_t WS_XBB = 753 * MiB;
constexpr size_t WS_H = 883 * MiB;
constexpr size_t WS_PART = 1240 * MiB;
constexpr size_t WS_STATS = 1248 * MiB;
constexpr size_t WS_XQ = 1250 * MiB;
constexpr size_t WS_SX = 1316 * MiB;
constexpr size_t WS_END = 1318 * MiB;
constexpr size_t ACT_BYTES = (size_t)MP * DM * 2;
constexpr size_t WS_MIX2 = WS_H, WS_MIX3 = WS_H + ACT_BYTES, WS_L = WS_H + 2 * ACT_BYTES;
constexpr size_t WS_KB = WS_H, WS_VB = WS_H + 161 * MiB;
constexpr size_t O_YP = 0, O_YS = 67108864, O_KP = 67371008, O_VP = 134479872, O_WKVP = 201588736, O_SHP = 202637312,
                 O_KS = 202653696, O_VS = 202915840, O_WKVS = 203177984, O_SHS = 204226560, O_TOTAL = 204242944;
constexpr size_t DO_Q = 0, DO_R = 0, DO_KR = ACT_BYTES, DO_VV = 2 * ACT_BYTES, DO_Z = 3 * ACT_BYTES, DO_WLD = 3 * ACT_BYTES, DO_AG = 4 * ACT_BYTES;
static_assert(DO_AG + ACT_BYTES <= O_WKVP * 4, "d_out scratch overlays end before the wkv/shift outputs");
constexpr size_t ACT_ELEMS = (size_t)MP * DM;

constexpr int CW_TMO = 0, CW_BAR = 4096;
constexpr int CW_CMAX2 = 131072;
constexpr int CW_CMAX = 65536;

constexpr int RING_BYTES = 131072;
constexpr int LDSCTL_OFF = RING_BYTES, MISC_OFF = LDSCTL_OFF + 320;
constexpr int SCL_OFF = RING_BYTES + 4096;
constexpr int ATT_WSF_OFF = RING_BYTES + 1024;
constexpr int LDS_BYTES = 147456;
constexpr int NWAVES = 8;

#define LDS_WAIT() asm volatile("s_waitcnt lgkmcnt(0)" ::: "memory")
#define VM_WAIT() asm volatile("s_waitcnt vmcnt(0)" ::: "memory")
__device__ __forceinline__ unsigned f2bf(float f) { unsigned u = __builtin_bit_cast(unsigned, f); return (u + 0x7fffu + ((u >> 16) & 1u)) >> 16; }
__device__ __forceinline__ unsigned pk2(float lo, float hi) { return f2bf(lo) | (f2bf(hi) << 16); }
__device__ __forceinline__ float bf2f(unsigned short h) { return __builtin_bit_cast(float, (unsigned)h << 16); }
__device__ __forceinline__ float bflo(unsigned w) { return __builtin_bit_cast(float, w << 16); }
__device__ __forceinline__ float bfhi(unsigned w) { return __builtin_bit_cast(float, w & 0xffff0000u); }
__device__ __forceinline__ unsigned cvt_pk_bf16(float lo, float hi) { unsigned r; asm volatile("v_cvt_pk_bf16_f32 %0, %1, %2" : "=v"(r) : "v"(lo), "v"(hi)); return r; }
__device__ __forceinline__ float fexp2(float x) { return __builtin_amdgcn_exp2f(x); }
__device__ __forceinline__ float frcp(float x) { return __builtin_amdgcn_rcpf(x); }
__device__ __forceinline__ float sigmoidf_(float z) { return frcp(1.f + fexp2(-z * LOG2E)); }
__device__ __forceinline__ float wave_sum(float v) {
#pragma unroll
    for (int o = 1; o < 64; o <<= 1) v += __shfl_xor(v, o);
    return v;
}
template <int CTRL, int RMASK> __device__ __forceinline__ float dpp_f(float old, float v) {
    return __builtin_bit_cast(float, __builtin_amdgcn_update_dpp(__builtin_bit_cast(int, old), __builtin_bit_cast(int, v), CTRL, RMASK, 0xf, false));
}
__device__ __forceinline__ float wave_sum_dpp(float v) {
    v += dpp_f<0x121, 0xf>(0.f, v);
    v += dpp_f<0x122, 0xf>(0.f, v);
    v += dpp_f<0x124, 0xf>(0.f, v);
    v += dpp_f<0x128, 0xf>(0.f, v);
    v += dpp_f<0x142, 0xa>(0.f, v);
    v += dpp_f<0x143, 0xc>(0.f, v);
    return __builtin_bit_cast(float, __builtin_amdgcn_readlane(__builtin_bit_cast(int, v), 63));
}
__device__ __forceinline__ void wave_sum_dpp4(float (&v)[4]) {
#define WS4_STEP(CTRL, RM) _Pragma("unroll") for (int i = 0; i < 4; ++i) v[i] += dpp_f<CTRL, RM>(0.f, v[i]);
    WS4_STEP(0x121, 0xf) WS4_STEP(0x122, 0xf) WS4_STEP(0x124, 0xf) WS4_STEP(0x128, 0xf) WS4_STEP(0x142, 0xa) WS4_STEP(0x143, 0xc)
#undef WS4_STEP
#pragma unroll
    for (int i = 0; i < 4; ++i) v[i] = __builtin_bit_cast(float, __builtin_amdgcn_readlane(__builtin_bit_cast(int, v[i]), 63));
}
__device__ __forceinline__ float wave_max_dpp(float v) {
    v = fmaxf(v, dpp_f<0x121, 0xf>(0.f, v));
    v = fmaxf(v, dpp_f<0x122, 0xf>(0.f, v));
    v = fmaxf(v, dpp_f<0x124, 0xf>(0.f, v));
    v = fmaxf(v, dpp_f<0x128, 0xf>(0.f, v));
    v = fmaxf(v, dpp_f<0x142, 0xa>(0.f, v));
    v = fmaxf(v, dpp_f<0x143, 0xc>(0.f, v));
    return __builtin_bit_cast(float, __builtin_amdgcn_readlane(__builtin_bit_cast(int, v), 63));
}
__device__ __forceinline__ float grp8_sum(float v) {
    v += dpp_f<0xB1, 0xf>(0.f, v);
    v += dpp_f<0x4E, 0xf>(0.f, v);
    v += dpp_f<0x141, 0xf>(0.f, v);
    return v;
}
__device__ __forceinline__ unsigned q8x4(f32x4 v, float inv) {
    const int a = (int)__builtin_rintf(v[0] * inv), b = (int)__builtin_rintf(v[1] * inv), c = (int)__builtin_rintf(v[2] * inv), d = (int)__builtin_rintf(v[3] * inv);
    return ((unsigned)a & 0xffu) | (((unsigned)b & 0xffu) << 8) | (((unsigned)c & 0xffu) << 16) | ((unsigned)d << 24);
}
__device__ __forceinline__ bool row_decode(int r, int& samp, int& b, int& t) {
    if (r < SROW0) { b = r / RS; t = r - b * RS - 1; samp = 0; return t >= 0; }
    if (r < NROWS) { const int q = r - SROW0; b = q / SRS; t = q - b * SRS - 1; samp = 1; return t >= 0; }
    samp = 0; b = 0; t = -1; return false;
}

#define XB_TMO      128
#define XB_XCNT(j)  (256  + 64 * (j))
#define XB_XSUB(j)  (1280 + 64 * (j))
#define XB_XGEN(j)  (2304 + 64 * (j))
#define XB_TOP      3328
#define XB_TOPGEN   3392
#define XCD_BAR_WORDS 3456
#define XB_SPIN_CAP (1u << 24)
__device__ __forceinline__ unsigned xb_ld(unsigned* p)              { return __hip_atomic_load(p, __ATOMIC_RELAXED, __HIP_MEMORY_SCOPE_AGENT); }
__device__ __forceinline__ unsigned xb_add(unsigned* p, unsigned v) { return __hip_atomic_fetch_add(p, v, __ATOMIC_RELAXED, __HIP_MEMORY_SCOPE_AGENT); }
__device__ __forceinline__ unsigned xb_xcc_id() { return (unsigned)__builtin_amdgcn_s_getreg((3 << 11) | 20) & 0xFu; }
#define XB_SPIN(cond, bar) do { unsigned _sp = 0; while (cond) { __builtin_amdgcn_s_sleep(1); \
    if ((++_sp & 255u) == 0u) { if (xb_ld(&(bar)[XB_TMO])) break; if (_sp > XB_SPIN_CAP) { atomicAdd(&(bar)[XB_TMO], 1u); break; } } } } while (0)
struct XcdBarrier { unsigned* bar; unsigned x; volatile LAS unsigned* st; };
__device__ __forceinline__ XcdBarrier xcd_barrier_post(unsigned* bar, volatile LAS unsigned* st) {
    XcdBarrier b; b.bar = bar; b.x = xb_xcc_id(); b.st = st;
    if (threadIdx.x == 0) (void)xb_add(&bar[XB_XCNT(b.x)], 1u);
    return b;
}
__device__ __forceinline__ void xcd_barrier_complete(unsigned* bar, unsigned x, unsigned& nloc, unsigned& nx) {
    const unsigned G = gridDim.x * gridDim.y * gridDim.z;
    unsigned sum, cnt, mine, sp = 0u;
    for (;;) {
        sum = 0u; cnt = 0u; mine = 0u;
#pragma unroll
        for (unsigned j = 0; j < 16; ++j) { const unsigned c = xb_ld(&bar[XB_XCNT(j)]); sum += c; cnt += (c > 0u) ? 1u : 0u; mine = (j == x) ? c : mine; }
        if (sum == G) break;
        __builtin_amdgcn_s_sleep(1);
        if ((++sp & 255u) == 0u) { if (xb_ld(&bar[XB_TMO])) break; if (sp > XB_SPIN_CAP) { atomicAdd(&bar[XB_TMO], 1u); break; } }
    }
    nloc = mine > 0u ? mine : 1u; nx = cnt > 0u ? cnt : 1u;
}
__device__ __forceinline__ void xcd_barrier(const XcdBarrier& b) {
    asm volatile("s_waitcnt vmcnt(0)" ::: "memory");
    __syncthreads();
    if (threadIdx.x == 0) {
        unsigned* bar = b.bar;
        __builtin_amdgcn_s_waitcnt(0);
        unsigned nloc = b.st[0], nx = b.st[1];
        if (nloc == 0u) { xcd_barrier_complete(bar, b.x, nloc, nx); b.st[0] = nloc; b.st[1] = nx; }
        const unsigned old = xb_add(&bar[XB_XSUB(b.x)], 1u);
        const unsigned gen = old / nloc;
        if (old + 1u == (gen + 1u) * nloc) {
            __builtin_amdgcn_fence(__ATOMIC_RELEASE, "agent");
            asm volatile("s_waitcnt vmcnt(0)" ::: "memory");
            const unsigned og = xb_add(&bar[XB_TOP], 1u);
            const unsigned tg = og / nx;
            if (og + 1u == (tg + 1u) * nx) xb_add(&bar[XB_TOPGEN], 1u);
            else XB_SPIN(xb_ld(&bar[XB_TOPGEN]) == tg, bar);
            __builtin_amdgcn_fence(__ATOMIC_ACQUIRE, "agent");
            xb_add(&bar[XB_XGEN(b.x)], 1u);
            asm volatile("s_waitcnt vmcnt(0)" ::: "memory");
        } else {
            XB_SPIN(xb_ld(&bar[XB_XGEN(b.x)]) == gen, bar);
            __builtin_amdgcn_fence(__ATOMIC_ACQUIRE, "agent");
            asm volatile("s_waitcnt vmcnt(0)" ::: "memory");
        }
    }
    __syncthreads();
}

namespace pg8 {
constexpr int BM = 256, BK = 64, HALF = 128, HTB = HALF * BK * 2, STAGE_BYTES = 8 * HTB, NXCD = 8, WGM = 8;
__host__ __device__ __forceinline__ int lds_byte(int r, int c) { const int st = (r >> 4) * 2 + (c >> 5), rr = r & 15, cc = c & 31, ob = rr * 64 + cc * 2; return st * 1024 + (ob ^ (((ob >> 9) & 1) << 5)); }
__host__ __device__ __forceinline__ void stage_rc(int b, int& R, int& C) { const int st = b / 1024, sb = b % 1024, swz = sb ^ (((sb >> 9) & 1) << 5); R = (st >> 1) * 16 + swz / 64; C = (st & 1) * 32 + (swz % 64) / 2; }
__host__ __device__ __forceinline__ int perm32(int rho) { const int n = rho >> 4, i = rho & 15; return 8 * (i >> 2) + 4 * n + (i & 3); }
struct Unit { int pm, pn, ks, k0, nt; };
struct Gemm { const bf16* A; const bf16* Bt; int M, N, K, lda; const bf16 *A1, *A2, *A3; };
struct StaticOrder {
    int nM, nN, nwg, G, c, nt, split, lora;
    __device__ __forceinline__ void init(int M, int N, int K, int G_, int c_, int split_, int lora_ = 0) { split = split_; lora = lora_; nM = M / BM - (split_ ? 1 : 0); nN = N / BM; nwg = nM * nN; G = G_; c = c_; nt = K / BK; }
    __device__ __forceinline__ bool next(int i, Unit& u) const {
        const long L = (long)i * G + c;
        if (L >= (long)nwg + nN * split) return false;
        const bool sp = L >= nwg;
        int wgid = sp ? 0 : (int)L; { const int q = nwg / NXCD, r = nwg % NXCD, xcd = wgid % NXCD, off = wgid / NXCD; wgid = (xcd < r ? xcd * (q + 1) : r * (q + 1) + (xcd - r) * q) + off; }
        const int nig = WGM * nN, gid = wgid / nig, fm = gid * WGM, gsz = (nM - fm) < WGM ? (nM - fm) : WGM;
        const int sidx = sp ? (int)(L - nwg) : 0, sks = sidx / nN, snt = split ? nt / split : nt;
        const int pm_ = sp ? nM : fm + ((wgid % nig) % gsz), pn_ = sp ? sidx % nN : (wgid % nig) / gsz, ks_ = sp ? sks : -1, nt_ = sp ? snt : nt, k0_ = sp ? sks * snt : 0;
        u.pm = pm_; u.pn = pn_; u.ks = ks_; u.k0 = k0_; u.nt = nt_;
        if (lora) { const int kind = pn_ >> 3; u.k0 = kind == 0 ? 0 : (kind == 1 ? 1 : 3); u.nt = kind == 2 ? 4 : 2; }
        return true;
    }
};
__device__ __forceinline__ f32x4 mma16(bf16x8 b, bf16x8 a, f32x4 c) { return __builtin_amdgcn_mfma_f32_16x16x32_bf16(b, a, c, 0, 0, 0); }
__device__ __forceinline__ i32x4 mma16(bf16x8 b, bf16x8 a, i32x4 c) { return __builtin_amdgcn_mfma_i32_16x16x64_i8(__builtin_bit_cast(i32x4, b), __builtin_bit_cast(i32x4, a), c, 0, 0, 0); }
template <class Epi>
__device__ __forceinline__ void gemm_phase(LAS unsigned char* lds, const Gemm g, const StaticOrder& S, const Epi& E) {
    const int tid = threadIdx.x, wid = __builtin_amdgcn_readfirstlane(tid >> 6), lane = tid & 63, wr = wid >> 2, wc = wid & 3, fr = lane & 15, fq = lane >> 4;
    const int K = g.K, lda = g.lda;
    const bf16* a0_ = g.A; const bf16* a1_ = g.A1; const bf16* a2_ = g.A2; const bf16* a3_ = g.A3; asm volatile("" : "+s"(a0_), "+s"(a1_), "+s"(a2_), "+s"(a3_));
    unsigned voffA[2], voffB[2];
#pragma unroll
    for (int i = 0; i < 2; ++i) { int R, C; stage_rc(tid * 16 + i * 8192, R, C); const int Rb = Epi::PERM ? ((R & ~31) + perm32(R & 31)) : R;
        voffA[i] = (unsigned)(R * lda + C) * 2u; voffB[i] = (unsigned)(Rb * K + C) * 2u; }
    const size_t kstep = (size_t)(BK * 2);
    const size_t hstepA = (size_t)HALF * lda * 2, hstepB = (size_t)HALF * K * 2;
    const size_t tstepA = 2 * hstepA, tstepB = 2 * hstepB;
    const unsigned ldsw = (unsigned)wid * 1024u;
    const int aoff = lds_byte(wr * 64 + fr, fq * 8), boff = lds_byte(wc * 32 + fr, fq * 8);
#define PG8_SA(b, h) (((b) * 2 + (h)) * HTB)
#define PG8_SB(b, h) ((4 + (b) * 2 + (h)) * HTB)
#define PG8_STAGE(bufoff, gbase, voff) do { _Pragma("unroll") for (int _i = 0; _i < 2; ++_i) \
        __builtin_amdgcn_global_load_lds((const unsigned*)((const char*)(gbase) + (voff)[_i]), (LAS unsigned*)(lds + (bufoff) + ldsw + _i * 8192), 16, 0, 0); } while (0)
#define PG8_LDA(dst, b, h) do { _Pragma("unroll") for (int m = 0; m < 4; ++m) _Pragma("unroll") for (int k = 0; k < 2; ++k) dst[m][k] = *(const LAS bf16x8*)(lds + PG8_SA(b, h) + aoff + m * 2048 + k * 1024); } while (0)
#define PG8_LDB(dst, b, h) do { _Pragma("unroll") for (int n = 0; n < 2; ++n) _Pragma("unroll") for (int k = 0; k < 2; ++k) dst[n][k] = *(const LAS bf16x8*)(lds + PG8_SB(b, h) + boff + n * 2048 + k * 1024); } while (0)
#define PG8_MMA(ai, bj, At, Bt) do { __builtin_amdgcn_s_setprio(1); _Pragma("unroll") for (int m = 0; m < 4; ++m) _Pragma("unroll") for (int n = 0; n < 2; ++n) _Pragma("unroll") for (int k = 0; k < 2; ++k) \
        acc[ai][bj][m][n] = mma16(Bt[n][k], At[m][k], acc[ai][bj][m][n]); __builtin_amdgcn_s_setprio(0); } while (0)
#define PG8_WAIT_V(n) asm volatile("s_waitcnt vmcnt(" #n ")" ::: "memory")
#define PG8_WAIT_L(n) asm volatile("s_waitcnt lgkmcnt(" #n ")" ::: "memory")
#define PG8_BAR __builtin_amdgcn_s_barrier()
#define PG8_SCHED __builtin_amdgcn_sched_barrier(0)
#define PG8_ABASE(u) ((const char*)(a1_ ? ((u).pn < 8 ? a0_ : ((u).pn < 16 ? a1_ : ((u).pn < 24 ? a2_ : a3_))) : a0_) + (size_t)(u).pm * tstepA + (size_t)(u).k0 * kstep)
#define PG8_BBASE(u) ((const char*)g.Bt + (size_t)(u).pn * tstepB + (size_t)(u).k0 * kstep)
    Unit cur, nxt; int ui = 0;
    if (!S.next(0, cur)) return;
    typedef typename Epi::AccT AccT;
    AccT acc[2][2][4][2];
#pragma unroll
    for (int a = 0; a < 2; ++a)
#pragma unroll
        for (int b = 0; b < 2; ++b)
#pragma unroll
            for (int m = 0; m < 4; ++m)
#pragma unroll
                for (int n = 0; n < 2; ++n) acc[a][b][m][n] = AccT{};
    bf16x8 At[4][2], B0[2][2], B1[2][2];
    const char* cA = PG8_ABASE(cur); const char* cB = PG8_BBASE(cur);
    if constexpr (Epi::PRE) E.stage(lds, cur, wid, lane, 0);
    PG8_STAGE(PG8_SB(0, 0), cB, voffB); PG8_STAGE(PG8_SB(0, 1), cB + hstepB, voffB); PG8_STAGE(PG8_SA(0, 0), cA, voffA); PG8_STAGE(PG8_SA(0, 1), cA + hstepA, voffA);
    if (wr == 1) PG8_BAR;
    PG8_WAIT_V(2); PG8_BAR;
    PG8_STAGE(PG8_SB(1, 0), cB + kstep, voffB); PG8_STAGE(PG8_SA(1, 0), cA + kstep, voffA); PG8_STAGE(PG8_SB(1, 1), cB + hstepB + kstep, voffB);
    PG8_WAIT_V(6); PG8_BAR;
    for (;;) {
        const bool has_next = S.next(ui + 1, nxt);
        const char* nA = has_next ? PG8_ABASE(nxt) : cA; const char* nB = has_next ? PG8_BBASE(nxt) : cB;
        const int nt = cur.nt;
        for (int t = 0; t < nt; t += 2) {
            const bool last = (t == nt - 2);
            const char* a1 = cA + (size_t)(t + 1) * kstep;
            const char* a2 = last ? nA : cA + (size_t)(t + 2) * kstep; const char* b2 = last ? nB : cB + (size_t)(t + 2) * kstep;
            const char* a3 = a2 + kstep; const char* b3 = b2 + kstep;
            PG8_LDB(B0, 0, 0); PG8_LDB(B1, 0, 1); PG8_SCHED; PG8_LDA(At, 0, 0); PG8_STAGE(PG8_SA(1, 1), a1 + hstepA, voffA);
            PG8_WAIT_V(8); PG8_WAIT_L(0); PG8_BAR; PG8_MMA(0, 0, At, B0); PG8_MMA(0, 1, At, B1); PG8_BAR; PG8_SCHED;
            PG8_LDA(At, 0, 1); PG8_STAGE(PG8_SB(0, 0), b2, voffB); PG8_STAGE(PG8_SB(0, 1), b2 + hstepB, voffB); PG8_STAGE(PG8_SA(0, 0), a2, voffA);
            PG8_WAIT_V(8); PG8_WAIT_L(0); PG8_BAR; PG8_MMA(1, 0, At, B0); PG8_MMA(1, 1, At, B1); PG8_BAR; PG8_SCHED;
            PG8_LDB(B0, 1, 0); PG8_LDB(B1, 1, 1); PG8_SCHED; PG8_LDA(At, 1, 0); PG8_STAGE(PG8_SA(0, 1), a2 + hstepA, voffA);
            PG8_WAIT_V(8); PG8_WAIT_L(0); PG8_BAR; PG8_MMA(0, 0, At, B0); PG8_MMA(0, 1, At, B1); PG8_BAR; PG8_SCHED;
            PG8_LDA(At, 1, 1); PG8_STAGE(PG8_SB(1, 0), b3, voffB); PG8_STAGE(PG8_SB(1, 1), b3 + hstepB, voffB); PG8_STAGE(PG8_SA(1, 0), a3, voffA);
            PG8_WAIT_V(8); PG8_WAIT_L(0); PG8_BAR; PG8_MMA(1, 0, At, B0); PG8_MMA(1, 1, At, B1); PG8_BAR; PG8_SCHED;
        }
        if (wr == 0) PG8_BAR;
        if constexpr (Epi::PRE) E(acc, cur, wr, wc, fr, fq, lds, ui & 1); else E(acc, cur, wr, wc, fr, fq);
        if (!has_next) break;
#pragma unroll
        for (int a = 0; a < 2; ++a)
#pragma unroll
            for (int b = 0; b < 2; ++b)
#pragma unroll
                for (int m = 0; m < 4; ++m)
#pragma unroll
                    for (int n = 0; n < 2; ++n) acc[a][b][m][n] = AccT{};
        cur = nxt; cA = nA; cB = nB; ++ui;
        if constexpr (Epi::PRE) E.stage(lds, cur, wid, lane, ui & 1);
        if (wr == 1) PG8_BAR;
    }
    PG8_WAIT_V(0);
    PG8_BAR;
#undef PG8_SA
#undef PG8_SB
#undef PG8_STAGE
#undef PG8_LDA
#undef PG8_LDB
#undef PG8_MMA
#undef PG8_WAIT_V
#undef PG8_WAIT_L
#undef PG8_BAR
#undef PG8_SCHED
#undef PG8_ABASE
#undef PG8_BBASE
}

typedef f32x4 Acc[2][2][4][2];
struct EpiSwiGLU {
    typedef f32x4 AccT;
    static constexpr bool PERM = true;
    static constexpr bool PRE = false;
    bf16* H;
    __device__ __forceinline__ void operator()(const Acc& acc, const Unit& u, int wr, int wc, int fr, int fq) const {
        const int row0 = u.pm * BM + wr * 64 + fr, col0 = u.pn * HALF + wc * 32 + 8 * fq;
#pragma unroll
        for (int ai = 0; ai < 2; ++ai)
#pragma unroll
            for (int m = 0; m < 4; ++m) {
                bf16* rowp = H + (size_t)(row0 + ai * HALF + m * 16) * FF + col0;
                float h[8];
#pragma unroll
                for (int n = 0; n < 2; ++n)
#pragma unroll
                    for (int e = 0; e < 4; ++e) { const float gt = acc[ai][0][m][n][e], up = acc[ai][1][m][n][e]; h[4 * n + e] = gt * sigmoidf_(gt) * up; }
                u32x4 w; w.x = cvt_pk_bf16(h[0], h[1]); w.y = cvt_pk_bf16(h[2], h[3]); w.z = cvt_pk_bf16(h[4], h[5]); w.w = cvt_pk_bf16(h[6], h[7]);
                *(u32x4*)rowp = w;
            }
    }
};
typedef i32x4 AccI[2][2][4][2];
struct EpiSwiGLUI8 {
    typedef i32x4 AccT;
    static constexpr bool PERM = true;
    static constexpr bool PRE = true;
    bf16* H; const float* sx; const float* cmax;
    __device__ __forceinline__ void stage(LAS unsigned char* lds, const Unit& u, int wid, int lane, int par) const {
        const float* src = wid < 4 ? sx + (size_t)u.pm * BM + wid * 64 + lane : cmax + (size_t)u.pn * BM + (wid - 4) * 64 + lane;
        __builtin_amdgcn_global_load_lds((const unsigned*)src, (LAS unsigned*)(lds + SCL_OFF + par * 2048 + wid * 256), 4, 0, 0);
    }
    __device__ __forceinline__ void operator()(const AccI& acc, const Unit& u, int wr, int wc, int fr, int fq, const LAS unsigned char* lds, int par) const {
        const int row0 = u.pm * BM + wr * 64 + fr, col0 = u.pn * HALF + wc * 32 + 8 * fq, cb = wc * 32 + 8 * fq;
        const LAS float* sl = (const LAS float*)(lds + SCL_OFF + par * 2048); const LAS float* cl = sl + 256;
        constexpr float Q2 = -LOG2E / (127.f * 127.f), QU = -(127.f / H8_CLIP) / (LOG2E * 127.f * 127.f);
        f32x2 gs[4], us[4];
        { const f32x4 g0 = *(const LAS f32x4*)(cl + cb) * Q2, g1 = *(const LAS f32x4*)(cl + cb + 4) * Q2, u0 = *(const LAS f32x4*)(cl + cb + HALF) * QU, u1 = *(const LAS f32x4*)(cl + cb + HALF + 4) * QU;
          gs[0] = (f32x2){g0[0], g0[1]}; gs[1] = (f32x2){g0[2], g0[3]}; gs[2] = (f32x2){g1[0], g1[1]}; gs[3] = (f32x2){g1[2], g1[3]};
          us[0] = (f32x2){u0[0], u0[1]}; us[1] = (f32x2){u0[2], u0[3]}; us[2] = (f32x2){u1[0], u1[1]}; us[3] = (f32x2){u1[2], u1[3]}; }
#pragma unroll
        for (int ai = 0; ai < 2; ++ai)
#pragma unroll
            for (int m = 0; m < 4; ++m) {
                const int r = row0 + ai * HALF + m * 16; const float sr = sl[wr * 64 + fr + ai * HALF + m * 16]; const f32x2 sr2 = (f32x2){sr, sr};
                unsigned char* rowp = (unsigned char*)H + (size_t)r * FF + col0;
                u32x2 w = (u32x2){0u, 0u};
#pragma unroll
                for (int p = 0; p < 4; ++p) {
                    const int n = p >> 1, e = (p & 1) * 2;
                    const f32x2 cg = (f32x2){(float)acc[ai][0][m][n][e], (float)acc[ai][0][m][n][e + 1]}, cu = (f32x2){(float)acc[ai][1][m][n][e], (float)acc[ai][1][m][n][e + 1]};
                    const f32x2 z = cg * (sr2 * gs[p]), up = cu * (sr2 * us[p]);
                    const f32x2 dn = (f32x2){fexp2(z[0]), fexp2(z[1])} + (f32x2){1.f, 1.f};
                    const f32x2 t = z * (f32x2){frcp(dn[0]), frcp(dn[1])};
                    const f32x2 q = __builtin_elementwise_fma(t, up, (f32x2){128.f, 128.f});
                    unsigned wd = n ? w.y : w.x;
                    wd = __builtin_amdgcn_cvt_pk_u8_f32(q[0], e, wd); wd = __builtin_amdgcn_cvt_pk_u8_f32(q[1], e + 1, wd);
                    if (n) w.y = wd; else w.x = wd;
                }
                w.x ^= 0x80808080u; w.y ^= 0x80808080u;
                *(u32x2*)rowp = w;
            }
    }
};
template <int HALFSC> struct ResidAcc { typedef f32x4 T; };
template <> struct ResidAcc<1> { typedef i32x4 T; };
template <int HALFSC, int RAWIN = 0> struct EpiResid {
    typedef typename ResidAcc<HALFSC>::T AccT;
    static constexpr bool PERM = true;
    static constexpr bool PRE = false;
    static constexpr float alpha = ALPHA, s = HALFSC ? 0.5f : 1.0f;
    bf16* VF; const float* st; const float* g; const float* b; float* PART; const float* cmax; const float* xin;
    __device__ __forceinline__ void operator()(const AccT (&acci)[2][2][4][2], const Unit& u, int wr, int wc, int fr, int fq) const {
        const int rl0 = wr * 64 + fr, col0 = u.pn * BM + wc * 32 + 8 * fq;
        f32x4 acc[2][2][4][2];
        if constexpr (HALFSC) {
#pragma unroll
            for (int bj = 0; bj < 2; ++bj)
#pragma unroll
                for (int n = 0; n < 2; ++n) { const f32x4 cs = *(const f32x4*)(cmax + col0 + bj * HALF + n * 4) * (H8_CLIP / (127.f * 127.f));
#pragma unroll
                    for (int ai = 0; ai < 2; ++ai)
#pragma unroll
                        for (int m = 0; m < 4; ++m) { const i32x4 q = acci[ai][bj][m][n]; acc[ai][bj][m][n] = (f32x4){(float)q[0], (float)q[1], (float)q[2], (float)q[3]} * cs; } }
        } else {
#pragma unroll
            for (int ai = 0; ai < 2; ++ai)
#pragma unroll
                for (int bj = 0; bj < 2; ++bj)
#pragma unroll
                    for (int m = 0; m < 4; ++m)
#pragma unroll
                        for (int n = 0; n < 2; ++n) acc[ai][bj][m][n] = acci[ai][bj][m][n];
        }
        bf16* vf_ = VF; float* part_ = PART; const float* st_ = st; const float* g_ = g; const float* b_ = b;
        if (u.ks >= 0) {
#pragma unroll
            for (int ai = 0; ai < 2; ++ai)
#pragma unroll
                for (int m = 0; m < 4; ++m) { float* p = part_ + ((size_t)(u.ks * BM + rl0 + ai * HALF + m * 16)) * DM + col0;
                    if (rl0 + ai * HALF + m * 16 < NROWS - (MP - BM)) {
#pragma unroll
                        for (int bj = 0; bj < 2; ++bj)
#pragma unroll
                            for (int n = 0; n < 2; ++n) *(f32x4*)(p + bj * HALF + n * 4) = acc[ai][bj][m][n]; } }
            return;
        }
        f32x4 gv[2][2], bv[2][2];
#pragma unroll
        for (int bj = 0; bj < 2; ++bj)
#pragma unroll
            for (int n = 0; n < 2; ++n) { gv[bj][n] = (f32x4){1.f, 1.f, 1.f, 1.f}; bv[bj][n] = (f32x4){0.f, 0.f, 0.f, 0.f};
                if (st_) { gv[bj][n] = *(const f32x4*)(g_ + col0 + bj * HALF + n * 4); bv[bj][n] = *(const f32x4*)(b_ + col0 + bj * HALF + n * 4); } }
#pragma unroll
        for (int ai = 0; ai < 2; ++ai)
#pragma unroll
            for (int m = 0; m < 4; ++m) {
                const int r = u.pm * BM + rl0 + ai * HALF + m * 16; const size_t off = (size_t)r * DM + col0;
                float mu = 0.f, rs = 1.f; if (st_) { const f32x2 t = *(const f32x2*)(st_ + 2 * (size_t)r); mu = t[0]; rs = t[1]; }
                const int bb_ = r / RS, tt_ = r - bb_ * RS - 1; const float* xr_ = xin + (size_t)(bb_ * T + (tt_ < 0 ? 0 : tt_)) * DM + col0;
#pragma unroll
                for (int bj = 0; bj < 2; ++bj) { u32x4 w8 = (u32x4){0u, 0u, 0u, 0u}; if (!RAWIN) w8 = *(const u32x4*)(vf_ + off + bj * HALF); f32x4 o[2];
#pragma unroll
                    for (int n = 0; n < 2; ++n) { f32x4 x;
                        if (RAWIN) { x = *(const f32x4*)(xr_ + bj * HALF + n * 4); if (tt_ < 0) x = (f32x4){0.f, 0.f, 0.f, 0.f}; }
                        else { const unsigned wa = n ? w8.z : w8.x, wb = n ? w8.w : w8.y; const f32x4 v = (f32x4){bflo(wa), bfhi(wa), bflo(wb), bfhi(wb)}; x = (v - mu) * rs * gv[bj][n] + bv[bj][n]; }
                        o[n] = x * alpha + acc[ai][bj][m][n] * s; }
                    u32x4 wo; wo.x = cvt_pk_bf16(o[0][0], o[0][1]); wo.y = cvt_pk_bf16(o[0][2], o[0][3]); wo.z = cvt_pk_bf16(o[1][0], o[1][1]); wo.w = cvt_pk_bf16(o[1][2], o[1][3]);
                    *(u32x4*)(vf_ + off + bj * HALF) = wo; }
            }
    }
};
struct EpiRwkv {
    typedef f32x4 AccT;
    static constexpr bool PERM = true;
    static constexpr bool PRE = false;
    bf16* RKV; float* Z;
    __device__ __forceinline__ void operator()(const Acc& acc, const Unit& u, int wr, int wc, int fr, int fq) const {
        const int row0 = u.pm * BM + wr * 64 + fr;
        bf16* rkv_ = RKV; float* z_ = Z; asm volatile("" : "+s"(rkv_), "+s"(z_));
        if (u.pn < 24) {
            bf16* base = rkv_ + (size_t)(u.pn >> 3) * ACT_ELEMS; const int col0 = (u.pn & 7) * BM + wc * 32 + 8 * fq;
#pragma unroll
            for (int ai = 0; ai < 2; ++ai)
#pragma unroll
                for (int m = 0; m < 4; ++m)
#pragma unroll
                    for (int bj = 0; bj < 2; ++bj) { const f32x4 v0 = acc[ai][bj][m][0], v1 = acc[ai][bj][m][1];
                        u32x4 w; w.x = cvt_pk_bf16(v0[0], v0[1]); w.y = cvt_pk_bf16(v0[2], v0[3]); w.z = cvt_pk_bf16(v1[0], v1[1]); w.w = cvt_pk_bf16(v1[2], v1[3]);
                        *(u32x4*)(base + (size_t)(row0 + ai * HALF + m * 16) * DM + col0 + bj * HALF) = w; }
        } else {
            const int col0 = (u.pn - 24) * BM + wc * 32 + 8 * fq;
#pragma unroll
            for (int ai = 0; ai < 2; ++ai)
#pragma unroll
                for (int m = 0; m < 4; ++m)
#pragma unroll
                    for (int bj = 0; bj < 2; ++bj) { float* p = z_ + (size_t)(row0 + ai * HALF + m * 16) * 1024 + col0 + bj * HALF;
                        *(f32x4*)p = acc[ai][bj][m][0]; *(f32x4*)(p + 4) = acc[ai][bj][m][1]; }
        }
    }
};
struct EpiLora2 {
    typedef f32x4 AccT;
    static constexpr bool PERM = true;
    static constexpr bool PRE = false;
    bf16 *WAG, *GGp; const float *w0, *a0;
    __device__ __forceinline__ void operator()(const Acc& acc, const Unit& u, int wr, int wc, int fr, int fq) const {
        const int row0 = u.pm * BM + wr * 64 + fr; const int kind = u.pn >> 3;
        bf16* wag_ = WAG; bf16* gg_ = GGp; const float* w0_ = w0; const float* a0_ = a0; asm volatile("" : "+s"(wag_), "+s"(gg_), "+s"(w0_), "+s"(a0_));
        bf16* base = wag_ + (size_t)kind * ACT_ELEMS; if (kind == 2) base = gg_; const float* bias = w0_; if (kind != 0) bias = a0_;
#pragma unroll
        for (int bj = 0; bj < 2; ++bj) {
            const int col0 = (u.pn & 7) * BM + bj * HALF + wc * 32 + 8 * fq;
            f32x4 b0 = (f32x4){0.f, 0.f, 0.f, 0.f}, b1 = b0;
            if (kind < 2) { b0 = *(const f32x4*)(bias + col0); b1 = *(const f32x4*)(bias + col0 + 4); }
#pragma unroll
            for (int ai = 0; ai < 2; ++ai)
#pragma unroll
                for (int m = 0; m < 4; ++m) { float h[8];
#pragma unroll
                    for (int e = 0; e < 4; ++e) { h[e] = acc[ai][bj][m][0][e] + b0[e]; h[4 + e] = acc[ai][bj][m][1][e] + b1[e]; }
                    if (kind == 0) {
#pragma unroll
                        for (int e = 0; e < 8; ++e) h[e] = -0.60653066f * sigmoidf_(h[e]);
                    } else if (kind == 1) {
#pragma unroll
                        for (int e = 0; e < 8; ++e) h[e] = sigmoidf_(h[e]);
                    }
                    u32x4 w; w.x = cvt_pk_bf16(h[0], h[1]); w.y = cvt_pk_bf16(h[2], h[3]); w.z = cvt_pk_bf16(h[4], h[5]); w.w = cvt_pk_bf16(h[6], h[7]);
                    *(u32x4*)(base + (size_t)(row0 + ai * HALF + m * 16) * DM + col0) = w; }
        }
    }
};
struct EpiKV {
    typedef f32x4 AccT;
    static constexpr bool PERM = true;
    static constexpr bool PRE = false;
    float* out; bf16* KB;
    __device__ __forceinline__ void operator()(const Acc& acc, const Unit& u, int wr, int wc, int fr, int fq) const {
        const int row0 = u.pm * BM + wr * 64 + fr; const int isv = u.pn >= 8 ? 1 : 0; const int col0 = (u.pn & 7) * BM + wc * 32 + 8 * fq;
        float* out_ = out; bf16* kb_ = KB; asm volatile("" : "+s"(out_), "+s"(kb_));
#pragma unroll
        for (int ai = 0; ai < 2; ++ai)
#pragma unroll
            for (int m = 0; m < 4; ++m) {
                const int r = row0 + ai * HALF + m * 16; int samp, b, t;
                if (!row_decode(r, samp, b, t)) continue;
                size_t fofs = O_KP + (size_t)isv * (O_VP - O_KP) + (size_t)(b * T + t) * DM;
                if (samp) fofs = O_KS + (size_t)isv * (O_VS - O_KS) + (size_t)(b * TS + t) * DM;
                float* fo = out_ + fofs + col0;
                bf16* bo = kb_ + (size_t)isv * ((WS_VB - WS_KB) / 2) + (size_t)(samp ? NB * T + b * KVS + PAST + t : b * T + t) * DM + col0;
#pragma unroll
                for (int bj = 0; bj < 2; ++bj) { const f32x4 v0 = acc[ai][bj][m][0], v1 = acc[ai][bj][m][1]; *(f32x4*)(fo + bj * HALF) = v0; *(f32x4*)(fo + bj * HALF + 4) = v1;
                    u32x4 w; w.x = cvt_pk_bf16(v0[0], v0[1]); w.y = cvt_pk_bf16(v0[2], v0[3]); w.z = cvt_pk_bf16(v1[0], v1[1]); w.w = cvt_pk_bf16(v1[2], v1[3]); *(u32x4*)(bo + bj * HALF) = w; }
            }
    }
};
struct EpiKVQ {
    typedef f32x4 AccT;
    static constexpr bool PERM = true;
    static constexpr bool PRE = false;
    float* out; bf16* KB; bf16* Q;
    __device__ __forceinline__ void operator()(const Acc& acc, const Unit& u, int wr, int wc, int fr, int fq) const {
        if (u.pn < 16) { EpiKV e{out, KB}; e(acc, u, wr, wc, fr, fq); return; }
        const int row0 = u.pm * BM + wr * 64 + fr, col0 = (u.pn - 16) * BM + wc * 32 + 8 * fq;
#pragma unroll
        for (int ai = 0; ai < 2; ++ai)
#pragma unroll
            for (int m = 0; m < 4; ++m)
#pragma unroll
                for (int bj = 0; bj < 2; ++bj) { const f32x4 v0 = acc[ai][bj][m][0] * QSCALE, v1 = acc[ai][bj][m][1] * QSCALE;
                    u32x4 w; w.x = cvt_pk_bf16(v0[0], v0[1]); w.y = cvt_pk_bf16(v0[2], v0[3]); w.z = cvt_pk_bf16(v1[0], v1[1]); w.w = cvt_pk_bf16(v1[2], v1[3]);
                    *(u32x4*)(Q + (size_t)(row0 + ai * HALF + m * 16) * DM + col0 + bj * HALF) = w; }
    }
};
struct EpiQ {
    typedef f32x4 AccT;
    static constexpr bool PERM = true;
    static constexpr bool PRE = false;
    bf16* Q;
    __device__ __forceinline__ void operator()(const Acc& acc, const Unit& u, int wr, int wc, int fr, int fq) const {
        const int row0 = u.pm * BM + wr * 64 + fr, col0 = u.pn * BM + wc * 32 + 8 * fq;
#pragma unroll
        for (int ai = 0; ai < 2; ++ai)
#pragma unroll
            for (int m = 0; m < 4; ++m)
#pragma unroll
                for (int bj = 0; bj < 2; ++bj) { const f32x4 v0 = acc[ai][bj][m][0] * QSCALE, v1 = acc[ai][bj][m][1] * QSCALE;
                    u32x4 w; w.x = cvt_pk_bf16(v0[0], v0[1]); w.y = cvt_pk_bf16(v0[2], v0[3]); w.z = cvt_pk_bf16(v1[0], v1[1]); w.w = cvt_pk_bf16(v1[2], v1[3]);
                    *(u32x4*)(Q + (size_t)(row0 + ai * HALF + m * 16) * DM + col0 + bj * HALF) = w; }
    }
};
}

struct Args { const float* in[31]; float* out; unsigned char* ws; int ph_lo, ph_hi; };
struct Frame {
    LAS unsigned char* lds; volatile LAS unsigned* MISC; gu32* ctl;
    int tid, lane, wave, vcu, G;
};

__device__ __forceinline__ void tr_item(const float* W, int N, int k0, int n0, LAS float* scr, int lane, bf16* dst, size_t ldd, const float* sc, int mode) {
    float tv[32];
#pragma unroll
    for (int i = 0; i < 32; ++i) tv[i] = W[(size_t)(k0 + 2 * i + (lane >> 5)) * N + n0 + (lane & 31)];
    if (mode) {
#pragma unroll
        for (int i = 0; i < 32; ++i) { const float s = sc[k0 + 2 * i + (lane >> 5)]; tv[i] *= (mode == 1) ? s : (1.f - s); }
    }
#pragma unroll
    for (int i = 0; i < 32; ++i) scr[(2 * i + (lane >> 5)) * 33 + (lane & 31)] = tv[i];
    LDS_WAIT(); asm volatile("" ::: "memory");
    const int c = lane & 7;
#pragma unroll
    for (int j = 0; j < 4; ++j) { const int n = (lane >> 3) + 8 * j; const LAS float* s = scr + (8 * c) * 33 + n;
        u32x4 o; o.x = pk2(s[0 * 33], s[1 * 33]); o.y = pk2(s[2 * 33], s[3 * 33]); o.z = pk2(s[4 * 33], s[5 * 33]); o.w = pk2(s[6 * 33], s[7 * 33]);
        *(u32x4*)(dst + (size_t)n * ldd + 8 * c) = o; }
    LDS_WAIT(); asm volatile("" ::: "memory");
}

__device__ __forceinline__ void p0_prologue(Frame& F, const Args& a) {
    LAS float* scr = (LAS float*)(F.lds + F.wave * 16384);
    const int gw = F.vcu * NWAVES + F.wave, NGW = F.G * NWAVES, lane = F.lane;
    unsigned char* ws = a.ws;
    constexpr int I_IN = 32 * 352, I_OUT = 88 * 64, I_SQ = 32 * 64, I_KV = 32 * 128, I_L96 = 32 * 3, I_L256 = 32 * 8;
    constexpr int N0 = 4 * I_IN, N1 = N0 + 4 * I_OUT, N2 = N1 + 3 * I_SQ, N3 = N2 + 2 * (2 * I_L96 + I_L256), N4 = N3 + 3 * I_SQ, N5 = N4 + I_KV;
    const int gt = F.vcu * 512 + F.tid, NGT = F.G * 512;
    for (int i = gt; i < 2 * 64 * KCAT / 8; i += NGT) { const int hf = i / (64 * KCAT / 8), j = i % (64 * KCAT / 8);
        *(u32x4*)((bf16*)(ws + WS_WCAT) + (size_t)(6592 + hf * 512) * KCAT + (size_t)j * 8) = (u32x4){0u, 0u, 0u, 0u}; }
    for (int i = gt; i < NL2 * (KL2 / 8); i += NGT) {
        const int n = i / (KL2 / 8), k8 = (i % (KL2 / 8)) * 8, kind = n >> 11, nn = n & 2047;
        const int klo = kind == 0 ? 0 : (kind == 1 ? 96 : 192), khi = kind == 0 ? 96 : (kind == 1 ? 192 : 448);
        const float* W = kind == 0 ? a.in[14] : (kind == 1 ? a.in[17] : a.in[19]);
        float v[8];
#pragma unroll
        for (int e = 0; e < 8; ++e) { const int k = k8 + e; v[e] = (k >= klo && k < khi) ? W[(size_t)(k - klo) * DM + nn] : 0.f; }
        u32x4 o; o.x = pk2(v[0], v[1]); o.y = pk2(v[2], v[3]); o.z = pk2(v[4], v[5]); o.w = pk2(v[6], v[7]);
        *(u32x4*)((bf16*)(ws + WS_WL2) + (size_t)n * KL2 + k8) = o;
    }
    bf16* XF = (bf16*)(ws + WS_XF); unsigned char* XQ = ws + WS_XQ; float* SX = (float*)(ws + WS_SX);
    for (int r0 = gw; r0 < MP; r0 += 3 * NGW) {
        f32x4 v[3][8];
#pragma unroll
        for (int k = 0; k < 3; ++k) { const int r = r0 + k * NGW; int samp = 0, b = 0, t = 0; const bool ok = r < MP && row_decode(r, samp, b, t);
            const float* src = samp ? a.in[1] + (size_t)(b * TS + t) * DM : a.in[0] + (size_t)(b * T + t) * DM;
#pragma unroll
            for (int j = 0; j < 8; ++j) { v[k][j] = (f32x4){0.f, 0.f, 0.f, 0.f}; if (ok) v[k][j] = *(const f32x4*)(src + 4 * lane + 256 * j); } }
#pragma unroll
        for (int k = 0; k < 3; ++k) { const int r = r0 + k * NGW;
            if (r < MP) { float m = 0.f;
#pragma unroll
                for (int j = 0; j < 8; ++j) { const int c = 4 * lane + 256 * j;
                    if (r >= 128 * 256) { u32x2 w; w.x = pk2(v[k][j][0], v[k][j][1]); w.y = pk2(v[k][j][2], v[k][j][3]); *(u32x2*)(XF + (size_t)r * DM + c) = w; }
                    m = fmaxf(fmaxf(m, fmaxf(fabsf(v[k][j][0]), fabsf(v[k][j][1]))), fmaxf(fabsf(v[k][j][2]), fabsf(v[k][j][3]))); }
                m = wave_max_dpp(m); const float inv = m > 0.f ? 127.f / m : 0.f;
                if (lane == 0) SX[r] = m;
#pragma unroll
                for (int j = 0; j < 8; ++j) *(unsigned*)(XQ + (size_t)r * DM + 4 * lane + 256 * j) = q8x4(v[k][j], inv); } }
    }
    for (int p = gw; p < N5; p += NGW) {
        const int it = p < N5 - N1 ? N1 + p : p - (N5 - N1);
        if (it < N0) {
            const int mi = it / I_IN, r = it % I_IN, kb = r / 352, nb = r % 352, n0 = nb * 32;
            const int isup = n0 >= FF, c = isup ? n0 - FF : n0, drow = (c >> 7) * 256 + isup * 128 + (c & 127);
            const float* W = a.in[8] + (size_t)mi * DM * 2 * FF; float m = 0.f;
#pragma unroll
            for (int i = 0; i < 32; ++i) m = fmaxf(m, fabsf(W[(size_t)(kb * 64 + 2 * i + (lane >> 5)) * (2 * FF) + n0 + (lane & 31)]));
            m = fmaxf(m, __shfl_xor(m, 32));
            if (lane < 32) atomicMax((unsigned*)(F.ctl + CW_CMAX) + mi * 2 * FF + drow + lane, __float_as_uint(m));
        } else if (it < N1) {
            const int q = it - N0, mi = q / I_OUT, r = q % I_OUT, kb = r / 64, nb = r % 64;
            const float* W = a.in[9] + (size_t)mi * FF * DM; float m = 0.f;
#pragma unroll
            for (int i = 0; i < 32; ++i) m = fmaxf(m, fabsf(W[(size_t)(kb * 64 + 2 * i + (lane >> 5)) * DM + nb * 32 + (lane & 31)]));
            m = fmaxf(m, __shfl_xor(m, 32));
            if (lane < 32) atomicMax((unsigned*)(F.ctl + CW_CMAX2) + mi * DM + nb * 32 + lane, __float_as_uint(m));
        } else if (it < N2) {
            const int q = it - N1, j = q / I_SQ, rr = q % I_SQ, kb = rr / 64, nb = rr % 64;
            tr_item(a.in[11] + (size_t)j * DM * DM, DM, kb * 64, nb * 32, scr, lane, (bf16*)(ws + WS_WCAT) + (size_t)(j * DM + nb * 32) * KCAT + kb * 64, KCAT, nullptr, 0);
        } else if (it < N3) {
            int q = it - N2; const int half = q / (2 * I_L96 + I_L256); q %= (2 * I_L96 + I_L256);
            const float* W; int N, mix, rowoff;
            if (q < I_L96) { W = a.in[13]; N = 96; mix = 1; rowoff = 0; } else if (q < 2 * I_L96) { q -= I_L96; W = a.in[16]; N = 96; mix = 4; rowoff = 96; } else { q -= 2 * I_L96; W = a.in[18]; N = 256; mix = 5; rowoff = 192; }
            const int nbn = N / 32, kb = q / nbn, nb = q % nbn;
            tr_item(W, N, kb * 64, nb * 32, scr, lane, (bf16*)(ws + WS_WCAT) + (size_t)(6144 + half * 512 + rowoff + nb * 32) * KCAT + kb * 64, KCAT, a.in[10] + mix * DM, half ? 1 : 2);
        } else if (it < N4) {
            const int q = it - N3, j = q / I_SQ, r = q % I_SQ, kb = r / 64, nb = r % 64;
            const float* W = j == 0 ? a.in[25] : (j == 1 ? a.in[27] : a.in[30]); const size_t wo = j == 0 ? WS_WOR : (j == 1 ? WS_WQ : WS_WOD);
            tr_item(W, DM, kb * 64, nb * 32, scr, lane, (bf16*)(ws + wo) + (size_t)(nb * 32) * DM + kb * 64, DM, nullptr, 0);
        } else {
            const int q = it - N4, kb = q / 128, nb = q % 128;
            tr_item(a.in[26], 4096, kb * 64, nb * 32, scr, lane, (bf16*)(ws + WS_WKV) + (size_t)(nb * 32) * DM + kb * 64, DM, nullptr, 0);
        }
    }
}
__device__ __forceinline__ void tr_item_i8(const float* W, int N, int k0, int n0, LAS float* scr, int lane, unsigned char* dst, size_t ldd, const float* cm) {
    float tv[32];
#pragma unroll
    for (int i = 0; i < 32; ++i) tv[i] = W[(size_t)(k0 + 2 * i + (lane >> 5)) * N + n0 + (lane & 31)];
#pragma unroll
    for (int i = 0; i < 32; ++i) scr[(2 * i + (lane >> 5)) * 33 + (lane & 31)] = tv[i];
    LDS_WAIT(); asm volatile("" ::: "memory");
    const int ch = lane & 3;
#pragma unroll
    for (int j = 0; j < 2; ++j) { const int n = (lane >> 2) + 16 * j; const float cmx = cm[n]; const float inv = cmx > 0.f ? 127.f / cmx : 0.f; const LAS float* sp = scr + (16 * ch) * 33 + n;
        u32x4 o;
        o.x = q8x4((f32x4){sp[0 * 33], sp[1 * 33], sp[2 * 33], sp[3 * 33]}, inv); o.y = q8x4((f32x4){sp[4 * 33], sp[5 * 33], sp[6 * 33], sp[7 * 33]}, inv);
        o.z = q8x4((f32x4){sp[8 * 33], sp[9 * 33], sp[10 * 33], sp[11 * 33]}, inv); o.w = q8x4((f32x4){sp[12 * 33], sp[13 * 33], sp[14 * 33], sp[15 * 33]}, inv);
        *(u32x4*)(dst + (size_t)n * ldd + 16 * ch) = o; }
    LDS_WAIT(); asm volatile("" ::: "memory");
}
__device__ __forceinline__ void p0_quant_win(Frame& F, const Args& a) {
    LAS float* scr = (LAS float*)(F.lds + F.wave * 16384);
    const int gw = F.vcu * NWAVES + F.wave, NGW = F.G * NWAVES, lane = F.lane;
    constexpr int I_IN = 32 * 352, I_OUT = 88 * 64;
    for (int p = gw; p < 4 * (I_IN + I_OUT); p += NGW) {
        const int it = 4 * (I_IN + I_OUT) - 1 - p;
        if (it < 4 * I_IN) {
            const int mi = it / I_IN, r = it % I_IN, kb = r / 352, nb = r % 352, n0 = nb * 32, k0 = kb * 64;
            const int isup = n0 >= FF, c = isup ? n0 - FF : n0, drow = (c >> 7) * 256 + isup * 128 + (c & 127);
            tr_item_i8(a.in[8] + (size_t)mi * DM * 2 * FF, 2 * FF, k0, n0, scr, lane, a.ws + WS_WIN + mi * WIN_STRIDE + (size_t)drow * DM + k0, DM, (const float*)(F.ctl + CW_CMAX) + mi * 2 * FF + drow);
        } else {
            const int q = it - 4 * I_IN, mi = q / I_OUT, r = q % I_OUT, kb = r / 64, nb = r % 64;
            tr_item_i8(a.in[9] + (size_t)mi * FF * DM, DM, kb * 64, nb * 32, scr, lane, a.ws + WS_WOUT + mi * WOUT_STRIDE + (size_t)(nb * 32) * FF + kb * 64, FF, (const float*)(F.ctl + CW_CMAX2) + mi * DM + nb * 32);
        }
    }
}
constexpr int SPECIAL_ROW0 = 128 * 256;
__device__ __forceinline__ void ln_load(const Args& a, int r, int lane, f32x4 (&v)[8]) {
    const bf16* VF = (const bf16*)(a.ws + WS_XF);
#pragma unroll
    for (int j = 0; j < 8; ++j) { const u32x2 w = *(const u32x2*)(VF + (size_t)r * DM + 4 * lane + 256 * j); v[j] = (f32x4){bflo(w.x), bfhi(w.x), bflo(w.y), bfhi(w.y)}; }
}
__device__ __forceinline__ f32x4 ld4(const float* p) { return *(const f32x4*)p; }
__device__ __forceinline__ f32x4 ld4(const LAS float* p) { return *(const LAS f32x4*)p; }
template <typename GP> __device__ __forceinline__ void ln_row(const Args& a, int r, int lane, GP g, GP bta, const float* gprev, const float* bprev, float alpha, float spart, bool own, f32x4 (&v)[8], int nsplit) {
    bf16* VF = (bf16*)(a.ws + WS_XF); float* ST = (float*)(a.ws + WS_STATS); const float* PART = (const float*)(a.ws + WS_PART);
    if (own && r >= SPECIAL_ROW0) {
        float mu = 0.f, rs = 1.f; if (gprev) { const f32x2 t = *(const f32x2*)(ST + 2 * (size_t)r); mu = t[0]; rs = t[1]; }
#pragma unroll
        for (int j = 0; j < 8; ++j) { const int c = 4 * lane + 256 * j; f32x4 x = v[j];
            if (gprev) x = (v[j] - mu) * rs * *(const f32x4*)(gprev + c) + *(const f32x4*)(bprev + c);
            const float* pp = PART + (size_t)(r - SPECIAL_ROW0) * DM + c;
            f32x4 p = (f32x4){0.f, 0.f, 0.f, 0.f};
            if (r < NROWS) { p = *(const f32x4*)pp + *(const f32x4*)(pp + (size_t)256 * DM);
                if (nsplit == 4) p = p + (*(const f32x4*)(pp + (size_t)512 * DM) + *(const f32x4*)(pp + (size_t)768 * DM)); }
            const f32x4 o = x * alpha + p * spart; u32x2 w; w.x = pk2(o[0], o[1]); w.y = pk2(o[2], o[3]); *(u32x2*)(VF + (size_t)r * DM + c) = w;
            v[j] = (f32x4){bflo(w.x), bfhi(w.x), bflo(w.y), bfhi(w.y)}; }
    }
    float s = 0.f;
#pragma unroll
    for (int j = 0; j < 8; ++j) s += (v[j][0] + v[j][1]) + (v[j][2] + v[j][3]);
    const float mean = wave_sum_dpp(s) * (1.f / DM); float s2 = 0.f;
#pragma unroll
    for (int j = 0; j < 8; ++j) { v[j] = v[j] - mean; s2 += (v[j][0] * v[j][0] + v[j][1] * v[j][1]) + (v[j][2] * v[j][2] + v[j][3] * v[j][3]); }
    const float rstd = 1.f / sqrtf(wave_sum_dpp(s2) * (1.f / DM) + LN_EPS);
    if (own && lane == 0) *(f32x2*)(ST + 2 * (size_t)r) = (f32x2){mean, rstd};
#pragma unroll
    for (int j = 0; j < 8; ++j) { const int c = 4 * lane + 256 * j; v[j] = v[j] * rstd * ld4(g + c) + ld4(bta + c); }
}
__device__ __forceinline__ void ln_loadraw(const Args& a, int r, int lane, u32x2 (&w)[8]) {
    const bf16* VF = (const bf16*)(a.ws + WS_XF);
#pragma unroll
    for (int j = 0; j < 8; ++j) w[j] = *(const u32x2*)(VF + (size_t)r * DM + 4 * lane + 256 * j);
}
__device__ __forceinline__ void ln_pass_row(const Args& a, int r, int lane, const u32x2 (&w)[8], const LAS float* g, const LAS float* bta, const float* gprev, const float* bprev, float spart, bf16* XB, int final, int q8, int nsplit) {
    f32x4 v[8];
#pragma unroll
    for (int j = 0; j < 8; ++j) v[j] = (f32x4){bflo(w[j].x), bfhi(w[j].x), bflo(w[j].y), bfhi(w[j].y)};
    asm volatile("" : "+v"(g), "+v"(bta));
    ln_row(a, r, lane, g, bta, gprev, bprev, ALPHA, spart, true, v, nsplit);
    if (final) {
        int samp, b, t; if (row_decode(r, samp, b, t)) { float* o = a.out + (samp ? O_YS + (size_t)(b * TS + t) * DM : O_YP + (size_t)(b * T + t) * DM);
#pragma unroll
            for (int j = 0; j < 8; ++j) *(f32x4*)(o + 4 * lane + 256 * j) = v[j]; }
    } else {
        if (XB) {
#pragma unroll
            for (int j = 0; j < 8; ++j) { u32x2 o; o.x = pk2(v[j][0], v[j][1]); o.y = pk2(v[j][2], v[j][3]); *(u32x2*)(XB + (size_t)r * DM + 4 * lane + 256 * j) = o; }
        }
        if (q8) {
            float m = 0.f;
#pragma unroll
            for (int j = 0; j < 8; ++j) m = fmaxf(fmaxf(m, fmaxf(fabsf(v[j][0]), fabsf(v[j][1]))), fmaxf(fabsf(v[j][2]), fabsf(v[j][3])));
            m = wave_max_dpp(m); const float inv = m > 0.f ? 127.f / m : 0.f;
            if (lane == 0) ((float*)(a.ws + WS_SX))[r] = m;
#pragma unroll
            for (int j = 0; j < 8; ++j) *(unsigned*)(a.ws + WS_XQ + (size_t)r * DM + 4 * lane + 256 * j) = q8x4(v[j], inv);
        }
    }
}
__device__ __forceinline__ void ln_pass(Frame& F, const Args& a, const float* g_, const float* bta_, const float* gprev, const float* bprev, float spart, bf16* XB, int final, int q8, int nsplit) {
    const int gw = F.vcu * NWAVES + F.wave, NGW = F.G * NWAVES, lane = F.lane;
    LAS float* gl = (LAS float*)F.lds; LAS float* bl = gl + DM;
    for (int i = F.tid; i < DM; i += NWAVES * 64) { gl[i] = g_[i]; bl[i] = bta_[i]; }
    __syncthreads();
    const LAS float* g = gl; const LAS float* bta = bl;
    u32x2 cur[3][8], nxt[3][8];
#pragma unroll
    for (int k = 0; k < 3; ++k)
#pragma unroll
        for (int j = 0; j < 8; ++j) { cur[k][j] = (u32x2){0u, 0u}; nxt[k][j] = (u32x2){0u, 0u}; }
#pragma unroll
    for (int k = 0; k < 3; ++k) if (gw + k * NGW < MP) ln_loadraw(a, gw + k * NGW, lane, cur[k]);
    for (int r = gw; r < MP; r += 3 * NGW) {
#pragma unroll
        for (int k = 0; k < 3; ++k) if (r + (3 + k) * NGW < MP) ln_loadraw(a, r + (3 + k) * NGW, lane, nxt[k]);
#pragma unroll
        for (int k = 0; k < 3; ++k) if (r + k * NGW < MP) ln_pass_row(a, r + k * NGW, lane, cur[k], g, bta, gprev, bprev, spart, XB, final, q8, nsplit);
#pragma unroll
        for (int k = 0; k < 3; ++k)
#pragma unroll
            for (int j = 0; j < 8; ++j) cur[k][j] = nxt[k][j];
    }
}
__device__ __forceinline__ void ln_mix_pass(Frame& F, const Args& a, const float* g_, const float* bta_, float spart, int nsplit) {
    const int gw = F.vcu * NWAVES + F.wave, NGW = F.G * NWAVES, lane = F.lane;
    LAS float* gl = (LAS float*)F.lds; LAS float* bl = gl + DM; LAS float* ml = gl + 2 * DM;
    for (int i = F.tid; i < DM; i += NWAVES * 64) { gl[i] = g_[i]; bl[i] = bta_[i]; ml[i] = a.in[10][i]; ml[DM + i] = a.in[10][2 * DM + i]; ml[2 * DM + i] = a.in[10][3 * DM + i]; }
    __syncthreads();
    const LAS float* g = gl; const LAS float* bta = bl;
    bf16* XB = (bf16*)(a.ws + WS_XBA); bf16* M0 = (bf16*)(a.ws + WS_XBB); bf16* M2 = (bf16*)(a.ws + WS_MIX2); bf16* M3 = (bf16*)(a.ws + WS_MIX3);
    for (int blk = gw; blk * 17 < MP; blk += NGW) {
        const int r0 = blk * 17, r1 = (r0 + 17 < MP) ? r0 + 17 : MP;
        f32x4 yp[8];
#pragma unroll
        for (int j = 0; j < 8; ++j) yp[j] = (f32x4){0.f, 0.f, 0.f, 0.f};
        u32x2 cur[3][8], nxt[3][8];
#pragma unroll
        for (int k = 0; k < 3; ++k)
#pragma unroll
            for (int j = 0; j < 8; ++j) { cur[k][j] = (u32x2){0u, 0u}; nxt[k][j] = (u32x2){0u, 0u}; }
#pragma unroll
        for (int k = 0; k < 3; ++k) if (r0 + k < r1) ln_loadraw(a, r0 + k, lane, cur[k]);
        { int samp, b, t; const bool ok = row_decode(r0, samp, b, t);
          if (ok && r0 <= SPECIAL_ROW0) { ln_load(a, r0 - 1, lane, yp); ln_row(a, r0 - 1, lane, g, bta, nullptr, nullptr, ALPHA, spart, false, yp, nsplit); } }
        for (int rt = r0; rt < r1; rt += 3) {
#pragma unroll
            for (int k = 0; k < 3; ++k) if (rt + 3 + k < r1) ln_loadraw(a, rt + 3 + k, lane, nxt[k]);
#pragma unroll
            for (int k = 0; k < 3; ++k) { const int r = rt + k;
              if (r < r1) {
                int samp, b, t; const bool ok = row_decode(r, samp, b, t);
                f32x4 v[8];
#pragma unroll
                for (int j = 0; j < 8; ++j) v[j] = (f32x4){bflo(cur[k][j].x), bfhi(cur[k][j].x), bflo(cur[k][j].y), bfhi(cur[k][j].y)};
                asm volatile("" : "+v"(g), "+v"(bta));
                ln_row(a, r, lane, g, bta, nullptr, nullptr, ALPHA, spart, true, v, nsplit);
                if (!ok && r < NROWS) {
                    const bool sm = r >= SROW0; const int bb = sm ? (r - SROW0) / SRS : 0;
#pragma unroll
                    for (int j = 0; j < 8; ++j) { v[j] = (f32x4){0.f, 0.f, 0.f, 0.f}; if (sm) v[j] = *(const f32x4*)(a.in[5] + (size_t)bb * DM + 4 * lane + 256 * j); }
                }
                if (ok && t == (samp ? TS - 1 : T - 1)) { float* o = a.out + (samp ? O_SHS : O_SHP) + (size_t)b * DM;
#pragma unroll
                    for (int j = 0; j < 8; ++j) *(f32x4*)(o + 4 * lane + 256 * j) = v[j]; }
                const LAS float* mu_ = ml + 4 * lane; asm volatile("" : "+v"(mu_));
#pragma unroll
                for (int j = 0; j < 8; ++j) { const int c = 4 * lane + 256 * j; const size_t off = (size_t)r * DM + c;
                    u32x2 w; w.x = pk2(v[j][0], v[j][1]); w.y = pk2(v[j][2], v[j][3]); *(u32x2*)(XB + off) = w;
                    if (ok) { const f32x4 d = yp[j] - v[j];
                        const f32x4 m0 = v[j] + d * ld4(mu_ + 0 * DM + 256 * j), m2 = v[j] + d * ld4(mu_ + 1 * DM + 256 * j), m3 = v[j] + d * ld4(mu_ + 2 * DM + 256 * j);
                        w.x = pk2(m0[0], m0[1]); w.y = pk2(m0[2], m0[3]); *(u32x2*)(M0 + off) = w;
                        w.x = pk2(m2[0], m2[1]); w.y = pk2(m2[2], m2[3]); *(u32x2*)(M2 + off) = w;
                        w.x = pk2(m3[0], m3[1]); w.y = pk2(m3[2], m3[3]); *(u32x2*)(M3 + off) = w; }
                    yp[j] = v[j]; }
              } }
#pragma unroll
            for (int k = 0; k < 3; ++k)
#pragma unroll
                for (int j = 0; j < 8; ++j) cur[k][j] = nxt[k][j];
        }
    }
}
__device__ __forceinline__ void lora_hidden_pass(Frame& F, const Args& a) {
    const int gt = F.vcu * 512 + F.tid, NGT = F.G * 512;
    const float* Z = (const float*)((unsigned char*)a.out + DO_Z); bf16* L = (bf16*)(a.ws + WS_L);
    for (int i0 = gt; i0 < MP * 64; i0 += 4 * NGT) {
        const int c = (i0 & 63) * 8;
        f32x4 x0[4], x1[4];
#pragma unroll
        for (int u = 0; u < 4; ++u) { const int i = i0 + u * NGT, r = i >> 6; x0[u] = (f32x4){0.f, 0.f, 0.f, 0.f}; x1[u] = x0[u];
            if (i < MP * 64 && c < 448) { const float* z1 = Z + (size_t)r * 1024 + c; x0[u] = *(const f32x4*)z1; x1[u] = *(const f32x4*)(z1 + 4);
                if (r > 0) { const float* z2 = Z + (size_t)(r - 1) * 1024 + 512 + c; x0[u] = x0[u] + *(const f32x4*)z2; x1[u] = x1[u] + *(const f32x4*)(z2 + 4); } } }
#pragma unroll
        for (int u = 0; u < 4; ++u) { const int i = i0 + u * NGT, r = i >> 6; float h[8];
#pragma unroll
            for (int e = 0; e < 8; ++e) h[e] = 0.f;
            if (c < 448) {
#pragma unroll
                for (int e = 0; e < 8; ++e) { const float x = e < 4 ? x0[u][e & 3] : x1[u][e & 3]; float y;
                    if (c < 96) y = 1.f - 2.f * frcp(fexp2(x * (2.f * LOG2E)) + 1.f); else if (c < 192) y = x; else y = sigmoidf_(x);
                    h[e] = y; }
            }
            if (i < MP * 64) { u32x4 w; w.x = pk2(h[0], h[1]); w.y = pk2(h[2], h[3]); w.z = pk2(h[4], h[5]); w.w = pk2(h[6], h[7]);
                *(u32x4*)(L + (size_t)r * KL2 + c) = w; } }
    }
}

__device__ __forceinline__ void cache_convert(Frame& F, const Args& a) {
    const int gt = F.vcu * 512 + F.tid, NGT = F.G * 512;
    bf16* KB = (bf16*)(a.ws + WS_KB); bf16* VB = (bf16*)(a.ws + WS_VB);
    constexpr int PER = NB * PAST * DM / 8;
    static_assert((2 * PER) % 4 == 0, "cache_convert: four pieces per turn");
    for (int i0 = gt; i0 < 2 * PER; i0 += 4 * NGT) {
        f32x4 v0[4], v1[4];
#pragma unroll
        for (int u = 0; u < 4; ++u) { const int i = i0 + u * NGT; v0[u] = (f32x4){0.f, 0.f, 0.f, 0.f}; v1[u] = v0[u];
            if (i < 2 * PER) { const int which = i >= PER, q = which ? i - PER : i; const float* src = a.in[2 + which] + (size_t)q * 8; v0[u] = *(const f32x4*)src; v1[u] = *(const f32x4*)(src + 4); } }
#pragma unroll
        for (int u = 0; u < 4; ++u) { const int i = i0 + u * NGT;
            if (i < 2 * PER) { const int which = i >= PER, q = which ? i - PER : i; const size_t e = (size_t)q * 8; const int b = (int)(e / ((size_t)PAST * DM)); const size_t rem = e - (size_t)b * PAST * DM;
                u32x4 o; o.x = pk2(v0[u][0], v0[u][1]); o.y = pk2(v0[u][2], v0[u][3]); o.z = pk2(v1[u][0], v1[u][1]); o.w = pk2(v1[u][2], v1[u][3]);
                *(u32x4*)((which ? VB : KB) + (size_t)(NB * T + b * KVS) * DM + rem) = o; } }
    }
}

constexpr int S2_CB = 43264, S2_AL = 0, S2_RH = 4608, S2_BE = 9216, S2_KA = 13824, S2_BH = 18432, S2_KH = 24576, S2_VT = 30720, S2_NT = 36864, S2_MKA = 38400, S2_MBR = 39936, S2_MKR = 41472, S2_PC = 43008;
constexpr int S2_YST = 2 * S2_CB, S2_RKS = S2_YST + 16384, S2_RAW = S2_RKS + 256, S2_END = S2_RAW + 20480;
static_assert(S2_END <= RING_BYTES, "scan LDS map");
__device__ __forceinline__ f32x4 mfma4(float a, float b, f32x4 c) { return __builtin_amdgcn_mfma_f32_16x16x4f32(a, b, c, 0, 0, 0); }
__device__ __forceinline__ void scan_unit(Frame& F, const Args& a, int samp, int b, int h, int abl) {
    const int lane = F.lane, w = F.wave, tid = F.tid, c = lane & 15, q = lane >> 4;
    const int nsteps = samp ? TS : T, row0 = samp ? SROW0 + b * SRS + 1 : b * RS + 1;
    const int niter = (nsteps + 31) >> 5;
    LAS unsigned char* lds = F.lds;
    const bf16* gR = (const bf16*)((unsigned char*)a.out + DO_R); const bf16* gK = (const bf16*)((unsigned char*)a.out + DO_KR);
    const bf16* gV = (const bf16*)((unsigned char*)a.out + DO_VV); const bf16* gW = (const bf16*)((unsigned char*)a.out + DO_WLD);
    const bf16* gA = (const bf16*)((unsigned char*)a.out + DO_AG); const bf16* gG = (const bf16*)(a.ws + WS_XBB);
    bf16* Y = (bf16*)(a.ws + WS_XBA);
    const float kk_w = a.in[20][h * 64 + lane], ka_w = a.in[21][h * 64 + lane], rk_w = a.in[22][h * 64 + lane], lg = a.in[23][h * 64 + lane], lb = a.in[24][h * 64 + lane];
    f32x4 ST[4];
#pragma unroll
    for (int mt = 0; mt < 4; ++mt)
#pragma unroll
        for (int i = 0; i < 4; ++i) ST[mt][i] = (samp && w < 4) ? a.in[4][((size_t)(b * 32 + h) * 64 + 16 * w + c) * 64 + 16 * mt + 4 * q + i] : 0.f;
    u32x4 pre[5];
#define S2_LOAD(it) do { const int t_ = tid - 256, tok_ = t_ >> 3, pc_ = t_ & 7, step_ = (it) * 32 + tok_; const size_t go_ = (size_t)(row0 + step_) * DM + h * 64 + pc_ * 8; const bool ok_ = step_ < nsteps; \
        pre[0] = pre[1] = pre[2] = pre[3] = pre[4] = (u32x4){0u, 0u, 0u, 0u}; \
        if (ok_) { pre[0] = *(const u32x4*)(gR + go_); pre[1] = *(const u32x4*)(gK + go_); pre[2] = *(const u32x4*)(gV + go_); pre[3] = *(const u32x4*)(gW + go_); pre[4] = *(const u32x4*)(gA + go_); } } while (0)
#define S2_STORE() do { const int t_ = tid - 256, tok_ = t_ >> 3, pc_ = t_ & 7; _Pragma("unroll") for (int j = 0; j < 5; ++j) \
        *(LAS u32x4*)(lds + S2_RAW + ((j * 32 + tok_) * 64 + pc_ * 8) * 2) = pre[j]; } while (0)
    u32x4 vrN = (u32x4){0u, 0u, 0u, 0u}, grN = (u32x4){0u, 0u, 0u, 0u};
    const float* lgp = a.in[23] + h * 64 + 8 * (lane & 7); const float* lbp = a.in[24] + h * 64 + 8 * (lane & 7);
    const f32x4 lg0_ = *(const f32x4*)lgp, lg1_ = *(const f32x4*)(lgp + 4), lb0_ = *(const f32x4*)lbp, lb1_ = *(const f32x4*)(lbp + 4);
#define S2_VGLOAD(it) do { const int step_ = (it) * 32 + (w - 4) + 4 * (lane >> 3); vrN = (u32x4){0u, 0u, 0u, 0u}; grN = (u32x4){0u, 0u, 0u, 0u}; \
        if (step_ < nsteps) { const size_t go_ = (size_t)(row0 + step_) * DM + h * 64 + 8 * (lane & 7); vrN = *(const u32x4*)(gV + go_); grN = *(const u32x4*)(gG + go_); } } while (0)
#define S2_POST(it) do { const LAS float* yb_ = (const LAS float*)(lds + S2_YST + ((it) & 1) * 8192); const LAS float* rkb_ = (const LAS float*)(lds + S2_RKS + ((it) & 1) * 128); \
        const int tok_ = (w - 4) + 4 * (lane >> 3), step_ = (it) * 32 + tok_; \
        const f32x4 y0_ = *(const LAS f32x4*)(yb_ + tok_ * 64 + 8 * (lane & 7)), y1_ = *(const LAS f32x4*)(yb_ + tok_ * 64 + 8 * (lane & 7) + 4); const float rk_ = rkb_[tok_]; \
        const float mu_ = grp8_sum(((y0_[0] + y0_[1]) + (y0_[2] + y0_[3])) + ((y1_[0] + y1_[1]) + (y1_[2] + y1_[3]))) * (1.f / 64.f); \
        const f32x4 d0_ = y0_ - mu_, d1_ = y1_ - mu_; \
        const float var_ = grp8_sum(((d0_[0] * d0_[0] + d0_[1] * d0_[1]) + (d0_[2] * d0_[2] + d0_[3] * d0_[3])) + ((d1_[0] * d1_[0] + d1_[1] * d1_[1]) + (d1_[2] * d1_[2] + d1_[3] * d1_[3]))) * (1.f / 64.f); \
        const float rs_ = __builtin_amdgcn_rsqf(var_ + GN_EPS); \
        const f32x4 v0_ = (f32x4){bflo(vrN.x), bfhi(vrN.x), bflo(vrN.y), bfhi(vrN.y)}, v1_ = (f32x4){bflo(vrN.z), bfhi(vrN.z), bflo(vrN.w), bfhi(vrN.w)}; \
        const f32x4 g0_ = (f32x4){bflo(grN.x), bfhi(grN.x), bflo(grN.y), bfhi(grN.y)}, g1_ = (f32x4){bflo(grN.z), bfhi(grN.z), bflo(grN.w), bfhi(grN.w)}; \
        const f32x4 o0_ = (d0_ * rs_ * lg0_ + lb0_ + v0_ * rk_) * g0_, o1_ = (d1_ * rs_ * lg1_ + lb1_ + v1_ * rk_) * g1_; \
        if (step_ < nsteps) { u32x4 w_; w_.x = pk2(o0_[0], o0_[1]); w_.y = pk2(o0_[2], o0_[3]); w_.z = pk2(o1_[0], o1_[1]); w_.w = pk2(o1_[2], o1_[3]); \
            *(u32x4*)(Y + (size_t)(row0 + step_) * DM + h * 64 + 8 * (lane & 7)) = w_; } } while (0)
    if (w >= 4) { S2_LOAD(0); S2_STORE(); if (niter > 1) S2_LOAD(1); }
    __syncthreads();
    for (int it = 0; it < niter; ++it) {
        if (abl != 1) {
            const int ch = w >> 2, t0 = 4 * (w & 3);
            const LAS bf16* raw = (const LAS bf16*)(lds + S2_RAW);
            LAS unsigned char* cb = lds + ch * S2_CB;
            float ldv[16];
#pragma unroll
            for (int t = 0; t < 16; ++t) ldv[t] = bf2f(raw[(3 * 32 + ch * 16 + t) * 64 + lane]);
            float Gm = 0.f, gc = 0.f;
#pragma unroll
            for (int t = 0; t < 16; ++t) { Gm += (t < t0) ? ldv[t] : 0.f; gc += ldv[t]; }
            float G[4]; { float g = Gm;
#pragma unroll
                for (int i = 0; i < 4; ++i) { g += bf2f(raw[(3 * 32 + ch * 16 + t0 + i) * 64 + lane]); G[i] = g; } }
            f32x4 bh, kh, vt;
            float eGm = fexp2(Gm * LOG2E);
            const float eGC = fexp2(gc * LOG2E);
            float rr[4], kr[4], aa[4], kkr[4], ss[4], kmod[4], rks[4];
#pragma unroll
            for (int i = 0; i < 4; ++i) { const int tk = ch * 16 + t0 + i;
                rr[i] = bf2f(raw[(0 * 32 + tk) * 64 + lane]); kr[i] = bf2f(raw[(1 * 32 + tk) * 64 + lane]); vt[i] = bf2f(raw[(2 * 32 + tk) * 64 + lane]); aa[i] = bf2f(raw[(4 * 32 + tk) * 64 + lane]); }
#pragma unroll
            for (int i = 0; i < 4; ++i) { kkr[i] = kr[i] * kk_w; ss[i] = kkr[i] * kkr[i]; kmod[i] = kr[i] * (1.f + (aa[i] - 1.f) * ka_w); rks[i] = rr[i] * kmod[i] * rk_w; }
            wave_sum_dpp4(ss); wave_sum_dpp4(rks);
#pragma unroll
            for (int i = 0; i < 4; ++i) {
                const int tk = ch * 16 + t0 + i, t = t0 + i;
                const float kk = kkr[i] * __builtin_amdgcn_rsqf(fmaxf(ss[i], 1e-24f)), bb = kk * aa[i];
                const float eG = fexp2(G[i] * LOG2E), enG = fexp2(-G[i] * LOG2E), eCG = eGC * enG;
                *(LAS float*)(cb + S2_AL + (t * 72 + lane) * 4) = -kk * eGm;
                *(LAS float*)(cb + S2_BE + (t * 72 + lane) * 4) = bb * enG;
                *(LAS float*)(cb + S2_KA + (t * 72 + lane) * 4) = kmod[i] * enG;
                *(LAS float*)(cb + S2_RH + (t * 72 + lane) * 4) = rr[i] * eG;
                bh[i] = bb * eCG; kh[i] = kmod[i] * eCG; eGm = eG;
                if (lane == 0) *(LAS float*)(lds + S2_RKS + (it & 1) * 128 + tk * 4) = rks[i];
            }
            *(LAS f32x4*)(cb + S2_BH + (lane * 24 + t0) * 4) = bh; *(LAS f32x4*)(cb + S2_KH + (lane * 24 + t0) * 4) = kh; *(LAS f32x4*)(cb + S2_VT + (lane * 24 + t0) * 4) = vt;
            if ((w & 3) == 0) *(LAS float*)(cb + S2_PC + lane * 4) = eGC;
        }
        __syncthreads();
        if (abl != 2) {
            const int ch = w >> 2, tile = w & 3;
            LAS unsigned char* cb = lds + ch * S2_CB;
            const LAS float* Ym = (const LAS float*)(cb + S2_AL + (tile >> 1) * 4608);
            const LAS float* Xm = (const LAS float*)(cb + S2_BE + (tile & 1) * 4608);
            f32x4 acc = (f32x4){0.f, 0.f, 0.f, 0.f};
#pragma unroll
            for (int s2 = 0; s2 < 2; ++s2) {
                const f32x4 ya0 = *(const LAS f32x4*)(Ym + c * 72 + 32 * s2 + 4 * q), ya1 = *(const LAS f32x4*)(Ym + c * 72 + 32 * s2 + 16 + 4 * q);
                const f32x4 xb0 = *(const LAS f32x4*)(Xm + c * 72 + 32 * s2 + 4 * q), xb1 = *(const LAS f32x4*)(Xm + c * 72 + 32 * s2 + 16 + 4 * q);
                const u32x4 pa = (u32x4){cvt_pk_bf16(ya0[0], ya0[1]), cvt_pk_bf16(ya0[2], ya0[3]), cvt_pk_bf16(ya1[0], ya1[1]), cvt_pk_bf16(ya1[2], ya1[3])};
                const u32x4 pb = (u32x4){cvt_pk_bf16(xb0[0], xb0[1]), cvt_pk_bf16(xb0[2], xb0[3]), cvt_pk_bf16(xb1[0], xb1[1]), cvt_pk_bf16(xb1[2], xb1[3])};
                acc = __builtin_amdgcn_mfma_f32_16x16x32_bf16(__builtin_bit_cast(bf16x8, pa), __builtin_bit_cast(bf16x8, pb), acc, 0, 0, 0); }
            LAS float* outm = (LAS float*)(cb + S2_NT + tile * 1536);
#pragma unroll
            for (int i = 0; i < 4; ++i) { const int t = 4 * q + i; const bool keep = (tile < 2) ? (c < t) : (c <= t); outm[t * 24 + c] = keep ? acc[i] : 0.f; }
        }
        __syncthreads();
        if (w < 4) { if (abl != 3) {
#pragma unroll 1
            for (int ch = 0; ch < 2; ++ch) {
                const LAS unsigned char* cb = lds + ch * S2_CB;
                f32x4 al[4], rh[4], bhv[4], khv[4], pcv[4];
#pragma unroll
                for (int mt = 0; mt < 4; ++mt) {
                    al[mt] = *(const LAS f32x4*)(cb + S2_AL + (c * 72 + 16 * mt + 4 * q) * 4); rh[mt] = *(const LAS f32x4*)(cb + S2_RH + (c * 72 + 16 * mt + 4 * q) * 4);
                    bhv[mt] = *(const LAS f32x4*)(cb + S2_BH + ((16 * mt + c) * 24 + 4 * q) * 4); khv[mt] = *(const LAS f32x4*)(cb + S2_KH + ((16 * mt + c) * 24 + 4 * q) * 4);
                    pcv[mt] = *(const LAS f32x4*)(cb + S2_PC + (16 * mt + 4 * q) * 4);
                }
                f32x4 nt = *(const LAS f32x4*)(cb + S2_NT + (c * 24 + 4 * q) * 4); const f32x4 mka = *(const LAS f32x4*)(cb + S2_MKA + (c * 24 + 4 * q) * 4);
                const f32x4 mbr = *(const LAS f32x4*)(cb + S2_MBR + (c * 24 + 4 * q) * 4), mkr = *(const LAS f32x4*)(cb + S2_MKR + (c * 24 + 4 * q) * 4);
                const f32x4 vb = *(const LAS f32x4*)(cb + S2_VT + ((16 * w + c) * 24 + 4 * q) * 4);
                const f32x4 nd1 = *(const LAS f32x4*)(cb + S2_NT + ((4 * q + 1) * 24 + 4 * q) * 4), nd2 = *(const LAS f32x4*)(cb + S2_NT + ((4 * q + 2) * 24 + 4 * q) * 4), nd3 = *(const LAS f32x4*)(cb + S2_NT + ((4 * q + 3) * 24 + 4 * q) * 4);
                if (q == (c >> 2)) nt = (f32x4){0.f, 0.f, 0.f, 0.f};
#define S2_PK8(x0, x1) __builtin_bit_cast(bf16x8, (u32x4){cvt_pk_bf16((x0)[0], (x0)[1]), cvt_pk_bf16((x0)[2], (x0)[3]), cvt_pk_bf16((x1)[0], (x1)[1]), cvt_pk_bf16((x1)[2], (x1)[3])})
                const bf16x8 st01 = S2_PK8(ST[0], ST[1]), st23 = S2_PK8(ST[2], ST[3]);
                const f32x4 zero4 = (f32x4){0.f, 0.f, 0.f, 0.f};
                f32x4 rhs = (f32x4){0.f, 0.f, 0.f, 0.f};
                rhs = __builtin_amdgcn_mfma_f32_16x16x32_bf16(S2_PK8(al[0], al[1]), st01, rhs, 0, 0, 0);
                rhs = __builtin_amdgcn_mfma_f32_16x16x32_bf16(S2_PK8(al[2], al[3]), st23, rhs, 0, 0, 0);
                rhs = __builtin_amdgcn_mfma_f32_16x16x32_bf16(S2_PK8(mka, zero4), S2_PK8(vb, zero4), rhs, 0, 0, 0);
                f32x4 ut = rhs;
#define S2_INBLK() do { ut[1] += nd1[0] * ut[0]; ut[2] += nd2[0] * ut[0] + nd2[1] * ut[1]; ut[3] += nd3[0] * ut[0] + nd3[1] * ut[1] + nd3[2] * ut[2]; } while (0)
                if (q == 0) S2_INBLK();
                const bf16x8 ntb = S2_PK8(nt, zero4);
#pragma unroll
                for (int qq = 1; qq < 4; ++qq) {
                    const f32x4 x = __builtin_amdgcn_mfma_f32_16x16x32_bf16(ntb, S2_PK8(ut, zero4), zero4, 0, 0, 0);
                    if (q == qq) { ut = rhs + x; S2_INBLK(); }
                }
#undef S2_INBLK
                f32x4 yv = (f32x4){0.f, 0.f, 0.f, 0.f};
                yv = __builtin_amdgcn_mfma_f32_16x16x32_bf16(S2_PK8(rh[0], rh[1]), st01, yv, 0, 0, 0);
                yv = __builtin_amdgcn_mfma_f32_16x16x32_bf16(S2_PK8(rh[2], rh[3]), st23, yv, 0, 0, 0);
                const bf16x8 uvb = S2_PK8(ut, vb);
                yv = __builtin_amdgcn_mfma_f32_16x16x32_bf16(S2_PK8(mbr, mkr), uvb, yv, 0, 0, 0);
                LAS float* yst = (LAS float*)(lds + S2_YST + (it & 1) * 8192);
#pragma unroll
                for (int i = 0; i < 4; ++i) yst[(ch * 16 + 4 * q + i) * 64 + 16 * w + c] = yv[i];
#pragma unroll
                for (int mt = 0; mt < 4; ++mt) ST[mt] = __builtin_amdgcn_mfma_f32_16x16x32_bf16(S2_PK8(bhv[mt], khv[mt]), uvb, ST[mt] * pcv[mt], 0, 0, 0);
#undef S2_PK8
            } }
        } else if (abl != 4) {
            if (it + 1 < niter) S2_STORE();
            if (it + 2 < niter) S2_LOAD(it + 2);
            if (it > 0) S2_POST(it - 1);
            S2_VGLOAD(it);
        }
        __syncthreads();
    }
    if (w >= 4) S2_POST(niter - 1);
    else {
        float* so = a.out + (samp ? O_WKVS : O_WKVP) + (size_t)(b * 32 + h) * 4096;
#pragma unroll
        for (int mt = 0; mt < 4; ++mt)
#pragma unroll
            for (int i = 0; i < 4; ++i) so[(16 * w + c) * 64 + 16 * mt + 4 * q + i] = ST[mt][i];
    }
    __syncthreads();
#undef S2_LOAD
#undef S2_STORE
#undef S2_POST
#undef S2_VGLOAD
}

__device__ __forceinline__ int crow(int r, int hi) { return (r & 3) + 8 * (r >> 2) + 4 * hi; }
__device__ __forceinline__ s16x4 vtr(const LAS unsigned char* p) { typedef short v4i16_t __attribute__((ext_vector_type(4))); return __builtin_bit_cast(s16x4, __builtin_amdgcn_ds_read_tr16_b64_v4i16((LAS v4i16_t*)p)); }
__device__ __forceinline__ void attn_unit(Frame& F, const Args& a, int qbase, int kvbase, int hp, int nt0, int ntstep, int NT, int nkeys, int nrg_valid, int nq_valid, float lam, int abl) {
    const int lane = F.lane, wid = F.wave, tid = F.tid, r32 = lane & 31, hi = lane >> 5, rg = wid >> 1, sub = wid & 1;
    const bf16* Q = (const bf16*)((unsigned char*)a.out + DO_Q); bf16* O = (bf16*)(a.ws + WS_XBB);
    const bf16* KB = (const bf16*)(a.ws + WS_KB); const bf16* VB = (const bf16*)(a.ws + WS_VB);
    LAS unsigned char* lds = F.lds; LAS float* wsf = (LAS float*)(lds + ATT_WSF_OFF) + wid * 64;
    const int myNT = rg < nrg_valid ? nt0 + ntstep * (rg >> 1) : 0;
    bf16x8 qr[4];
#pragma unroll
    for (int d0 = 0; d0 < 4; ++d0) qr[d0] = *(const bf16x8*)(Q + (size_t)(qbase + rg * 32 + r32) * DM + (2 * hp + sub) * 64 + d0 * 16 + hi * 8);
    f32x16 o[4];
#pragma unroll
    for (int d = 0; d < 4; ++d)
#pragma unroll
        for (int i = 0; i < 16; ++i) o[d][i] = 0.f;
    float mref = 0.f, lsum = 0.f;
    f32x16 negm;
#pragma unroll
    for (int i = 0; i < 16; ++i) negm[i] = 0.f;
    const bf16* ksrc = KB + (size_t)(kvbase + 8 * wid + (lane >> 3)) * DM + (2 * hp) * 64 + ((lane & 7) ^ ((lane >> 3) & 7)) * 8;
    const bf16* vsrc0 = VB + (size_t)(kvbase + (wid & 3) * 16 + (lane >> 2)) * DM + hp * 128 + (wid >> 2) * 32 + (lane & 3) * 8;
    const bf16* vsrc1 = vsrc0 + 64;
#define AT_DMA(j, slot) do { LAS unsigned char* sb_ = lds + (slot); const size_t to_ = (size_t)(j) * 64 * DM; \
        __builtin_amdgcn_global_load_lds((const unsigned*)(ksrc + to_), (LAS unsigned*)(sb_ + wid * 1024), 16, 0, 0); \
        __builtin_amdgcn_global_load_lds((const unsigned*)(ksrc + to_ + 64), (LAS unsigned*)(sb_ + 8192 + wid * 1024), 16, 0, 0); \
        __builtin_amdgcn_global_load_lds((const unsigned*)(vsrc0 + to_), (LAS unsigned*)(sb_ + 16384 + (wid >> 2) * 4096 + (wid & 3) * 1024), 16, 0, 0); \
        __builtin_amdgcn_global_load_lds((const unsigned*)(vsrc1 + to_), (LAS unsigned*)(sb_ + 16384 + ((wid >> 2) + 2) * 4096 + (wid & 3) * 1024), 16, 0, 0); } while (0)
    AT_DMA(0, 0);
    if (NT > 1) AT_DMA(1, 32768);
    int slot_c = 0, slot_n = 65536;
    const int vtoff = ((lane >> 4) & 1) * 32 + (lane & 3) * 8 + (4 * hi + ((lane & 15) >> 2)) * 64;
    constexpr float ATT_THR = 8.f;
    for (int j = 0; j < NT; ++j) {
        if (j + 1 < NT) asm volatile("s_waitcnt vmcnt(4)" ::: "memory"); else asm volatile("s_waitcnt vmcnt(0)" ::: "memory");
        asm volatile("s_waitcnt lgkmcnt(0)" ::: "memory"); __builtin_amdgcn_s_barrier(); asm volatile("" ::: "memory");
        asm volatile("" : "+s"(slot_c), "+s"(slot_n));
        if (j + 2 < NT) AT_DMA(j + 2, slot_n);
        if (j < myNT && abl != 1) {
            const LAS unsigned char* sb = lds + slot_c; const LAS unsigned char* Ks = sb + sub * 8192; const LAS unsigned char* Vs = sb + 16384;
            f32x16 p0 = negm, p1 = negm;
            bf16x8 kf[4];
#pragma unroll
            for (int d0 = 0; d0 < 2; ++d0) { kf[2 * d0] = *(const LAS bf16x8*)(Ks + r32 * 128 + (((2 * d0 + hi) ^ (r32 & 7)) << 4)); kf[2 * d0 + 1] = *(const LAS bf16x8*)(Ks + 4096 + r32 * 128 + (((2 * d0 + hi) ^ (r32 & 7)) << 4)); }
            __builtin_amdgcn_sched_barrier(0);
#pragma unroll
            for (int d0 = 0; d0 < 2; ++d0) { p0 = __builtin_amdgcn_mfma_f32_32x32x16_bf16(kf[2 * d0], qr[d0], p0, 0, 0, 0); p1 = __builtin_amdgcn_mfma_f32_32x32x16_bf16(kf[2 * d0 + 1], qr[d0], p1, 0, 0, 0); }
#pragma unroll
            for (int d0 = 2; d0 < 4; ++d0) { kf[2 * d0 - 4] = *(const LAS bf16x8*)(Ks + r32 * 128 + (((2 * d0 + hi) ^ (r32 & 7)) << 4)); kf[2 * d0 - 3] = *(const LAS bf16x8*)(Ks + 4096 + r32 * 128 + (((2 * d0 + hi) ^ (r32 & 7)) << 4)); }
#pragma unroll
            for (int d0 = 2; d0 < 4; ++d0) { p0 = __builtin_amdgcn_mfma_f32_32x32x16_bf16(kf[2 * d0 - 4], qr[d0], p0, 0, 0, 0); p1 = __builtin_amdgcn_mfma_f32_32x32x16_bf16(kf[2 * d0 - 3], qr[d0], p1, 0, 0, 0); }
            if ((j + 1) * 64 > nkeys) {
#pragma unroll
                for (int i = 0; i < 16; ++i) { const int kx = j * 64 + crow(i, hi); if (kx >= nkeys) p0[i] = -1e30f; if (kx + 32 >= nkeys) p1[i] = -1e30f; }
            }
            float ra = __builtin_fmaxf(__builtin_fmaxf(p0[0], p0[1]), p1[0]), rb = __builtin_fmaxf(__builtin_fmaxf(p0[2], p0[3]), p1[1]); ra = __builtin_fmaxf(__builtin_fmaxf(ra, p1[2]), p1[3]);
#pragma unroll
            for (int i = 4; i < 16; i += 4) { ra = __builtin_fmaxf(__builtin_fmaxf(ra, p0[i]), p0[i + 1]); rb = __builtin_fmaxf(__builtin_fmaxf(rb, p0[i + 2]), p0[i + 3]);
                ra = __builtin_fmaxf(__builtin_fmaxf(ra, p1[i]), p1[i + 1]); rb = __builtin_fmaxf(__builtin_fmaxf(rb, p1[i + 2]), p1[i + 3]); }
            float rm = __builtin_fmaxf(ra, rb);
            rm = __builtin_fmaxf(rm, __shfl_xor(rm, 32));
            if (j == 0 || __any(rm > ATT_THR)) {
                const float dl = (j == 0) ? rm : __builtin_fmaxf(rm, 0.f);
                mref += dl;
#pragma unroll
                for (int i = 0; i < 16; ++i) { p0[i] -= dl; p1[i] -= dl; negm[i] = -mref; }
                const float f = fexp2(-dl); lsum *= f;
                if (hi == 0) wsf[r32] = f;
                LDS_WAIT();
#pragma unroll
                for (int i = 0; i < 16; ++i) { const float ff = wsf[crow(i, hi)];
#pragma unroll
                    for (int d = 0; d < 4; ++d) o[d][i] *= ff; }
            }
            float ps = 0.f, ps1 = 0.f;
#pragma unroll
            for (int i = 0; i < 16; ++i) { p0[i] = fexp2(p0[i]); p1[i] = fexp2(p1[i]); ps += p0[i]; ps1 += p1[i]; }
            lsum += ps + ps1;
            bf16x8 pa[4];
            { u32x4 t0, t1, t2, t3;
              t0.x = cvt_pk_bf16(p0[0], p0[1]); t0.y = cvt_pk_bf16(p0[2], p0[3]); t0.z = cvt_pk_bf16(p0[4], p0[5]); t0.w = cvt_pk_bf16(p0[6], p0[7]);
              t1.x = cvt_pk_bf16(p0[8], p0[9]); t1.y = cvt_pk_bf16(p0[10], p0[11]); t1.z = cvt_pk_bf16(p0[12], p0[13]); t1.w = cvt_pk_bf16(p0[14], p0[15]);
              t2.x = cvt_pk_bf16(p1[0], p1[1]); t2.y = cvt_pk_bf16(p1[2], p1[3]); t2.z = cvt_pk_bf16(p1[4], p1[5]); t2.w = cvt_pk_bf16(p1[6], p1[7]);
              t3.x = cvt_pk_bf16(p1[8], p1[9]); t3.y = cvt_pk_bf16(p1[10], p1[11]); t3.z = cvt_pk_bf16(p1[12], p1[13]); t3.w = cvt_pk_bf16(p1[14], p1[15]);
              pa[0] = __builtin_bit_cast(bf16x8, t0); pa[1] = __builtin_bit_cast(bf16x8, t1); pa[2] = __builtin_bit_cast(bf16x8, t2); pa[3] = __builtin_bit_cast(bf16x8, t3); }
#define AT_VLD(dst, d) do { _Pragma("unroll") for (int ks = 0; ks < 4; ++ks) { dst[2 * ks] = vtr(Vs + (d) * 4096 + ks * 1024 + vtoff); dst[2 * ks + 1] = vtr(Vs + (d) * 4096 + ks * 1024 + 512 + vtoff); } } while (0)
#define AT_PV(src, d) do { _Pragma("unroll") for (int ks = 0; ks < 4; ++ks) { const bf16x8 vf = (bf16x8){src[2 * ks][0], src[2 * ks][1], src[2 * ks][2], src[2 * ks][3], src[2 * ks + 1][0], src[2 * ks + 1][1], src[2 * ks + 1][2], src[2 * ks + 1][3]}; \
                o[d] = __builtin_amdgcn_mfma_f32_32x32x16_bf16(pa[ks], vf, o[d], 0, 0, 0); } } while (0)
            if (abl != 2) {
            s16x4 va[8], vb2[8];
            AT_VLD(va, 0); __builtin_amdgcn_sched_barrier(0);
            AT_VLD(vb2, 1); __builtin_amdgcn_sched_barrier(0); AT_PV(va, 0); __builtin_amdgcn_sched_barrier(0);
            AT_VLD(va, 2); __builtin_amdgcn_sched_barrier(0); AT_PV(vb2, 1); __builtin_amdgcn_sched_barrier(0);
            AT_VLD(vb2, 3); __builtin_amdgcn_sched_barrier(0); AT_PV(va, 2); __builtin_amdgcn_sched_barrier(0);
            AT_PV(vb2, 3);
            }
#undef AT_VLD
#undef AT_PV
        }
        slot_c = (slot_c == 65536) ? 0 : slot_c + 32768; slot_n = (slot_n == 65536) ? 0 : slot_n + 32768;
    }
    asm volatile("s_waitcnt vmcnt(0) lgkmcnt(0)" ::: "memory"); __builtin_amdgcn_s_barrier(); asm volatile("" ::: "memory");
    lsum += __shfl_xor(lsum, 32);
    if (hi == 0) wsf[32 + r32] = lsum;
    LDS_WAIT();
    LAS float* E = (LAS float*)lds;
    if (myNT > 0) {
#pragma unroll
        for (int i = 0; i < 16; ++i) { const float rl = frcp(wsf[32 + crow(i, hi)]);
#pragma unroll
            for (int d = 0; d < 4; ++d) E[((rg * 2 + sub) * 32 + crow(i, hi)) * 128 + d * 32 + r32] = o[d][i] * rl; }
    }
    __syncthreads();
    if (myNT > 0) {
        const f32x2 sg = *(const f32x2*)(a.in[29] + 2 * lane);
        for (int qq = 0; qq < 16; ++qq) { const int q = 16 * sub + qq;
            if (q >= nq_valid) break;
            const f32x2 e0 = *(const LAS f32x2*)(E + ((rg * 2 + 0) * 32 + q) * 128 + 2 * lane), e1 = *(const LAS f32x2*)(E + ((rg * 2 + 1) * 32 + q) * 128 + 2 * lane);
            const f32x2 ov = e0 - e1 * lam; const float ss = wave_sum_dpp(ov[0] * ov[0] + ov[1] * ov[1]);
            const float sc = __builtin_amdgcn_rsqf(ss * (1.f / 128.f) + LN_EPS) * (1.f - LAMBDA_INIT);
            *(unsigned*)(O + (size_t)(qbase + rg * 32 + q) * DM + hp * 128 + 2 * lane) = pk2(ov[0] * sc * sg[0], ov[1] * sc * sg[1]);
        }
    }
    __syncthreads();
#undef AT_DMA
}

constexpr int NPHASE = 23;
__global__ void __launch_bounds__(NWAVES * 64, 2) mk_fwd(Args args) {
    extern __shared__ __attribute__((aligned(16))) unsigned char lds_raw[];
    Frame F;
    F.lds = (LAS unsigned char*)lds_raw;
    F.MISC = (volatile LAS unsigned*)(F.lds + MISC_OFF);
    F.tid = threadIdx.x; F.lane = F.tid & 63; F.wave = __builtin_amdgcn_readfirstlane(F.tid >> 6);
    F.G = gridDim.x; { const int bx = blockIdx.x; F.vcu = (F.G % 8 == 0) ? (bx % 8) * (F.G / 8) + bx / 8 : bx; }
    unsigned char* ws = args.ws;
    F.ctl = (gu32*)(ws + WS_CTL);
    for (int u = F.tid; u < (LDS_BYTES - LDSCTL_OFF) / 4; u += NWAVES * 64) ((LAS unsigned*)(F.lds + LDSCTL_OFF))[u] = 0u;
    __syncthreads();
    XcdBarrier bar; bar.bar = (unsigned*)(F.ctl + CW_BAR); bar.x = 0; bar.st = nullptr;
    if (MK_SINGLE) bar = xcd_barrier_post((unsigned*)(F.ctl + CW_BAR), F.MISC + 8);
    const int lo = args.ph_lo, hi = args.ph_hi;
#define IN(k) (lo <= (k) && (k) < hi)
#define REP(k) for (int rep_ = 0; rep_ < ((k) == MK_DUP ? 2 : 1); ++rep_)
#define SEAM(k) do { if (IN(k) && IN((k) + 1)) xcd_barrier(bar); } while (0)
    const float* ln_g = args.in[6]; const float* ln_b = args.in[7];
    bf16* VF = (bf16*)(ws + WS_XF); const float* STATS = (const float*)(ws + WS_STATS); float* PART = (float*)(ws + WS_PART);
    bf16* XBA = (bf16*)(ws + WS_XBA); bf16* XBB = (bf16*)(ws + WS_XBB); bf16* HB = (bf16*)(ws + WS_H);
    unsigned char* dob = (unsigned char*)args.out;

#define FFN_G1(mi) do { pg8::Gemm g{(const bf16*)(ws + WS_XQ), (const bf16*)(ws + WS_WIN + (mi) * WIN_STRIDE), MP, 2 * FF, DM / 2, DM / 2, nullptr, nullptr, nullptr}; pg8::StaticOrder S; S.init(MP, 2 * FF, DM / 2, F.G, (int)blockIdx.x, 0); \
        pg8::EpiSwiGLUI8 E{HB, (const float*)(ws + WS_SX), (const float*)(F.ctl + CW_CMAX) + (mi) * 2 * FF}; pg8::gemm_phase<pg8::EpiSwiGLUI8>(F.lds, g, S, E); } while (0)
#define RESID_GEMM(A_, W_, Kk, lnprev, sc, CM_) do { pg8::Gemm g{A_, (const bf16*)(ws + (W_)), MP, DM, (sc) ? (Kk) / 2 : (Kk), (sc) ? (Kk) / 2 : (Kk), nullptr, nullptr, nullptr}; pg8::StaticOrder S; S.init(MP, DM, (sc) ? (Kk) / 2 : (Kk), F.G, (int)blockIdx.x, (sc) ? 2 : 4); \
        pg8::EpiResid<sc> E{VF, (lnprev) >= 0 ? STATS : nullptr, ln_g + ((lnprev) >= 0 ? (lnprev) : 0) * DM, ln_b + ((lnprev) >= 0 ? (lnprev) : 0) * DM, PART, CM_, nullptr}; \
        pg8::gemm_phase<pg8::EpiResid<sc>>(F.lds, g, S, E); } while (0)
#define LN_PASS(lncur, lnprev, sc, XB_, fin, q8_, nsp) ln_pass(F, args, ln_g + (lncur) * DM, ln_b + (lncur) * DM, (lnprev) >= 0 ? ln_g + ((lnprev) >= 0 ? (lnprev) : 0) * DM : nullptr, ln_b + ((lnprev) >= 0 ? (lnprev) : 0) * DM, sc, XB_, fin, q8_, nsp)

    if (IN(0)) { p0_prologue(F, args); xcd_barrier(bar); p0_quant_win(F, args); } SEAM(0);
    if (IN(1)) { REP(1) { FFN_G1(0); } } SEAM(1);
    if (IN(2)) { pg8::Gemm g{HB, (const bf16*)(ws + WS_WOUT), MP, DM, FF / 2, FF / 2, nullptr, nullptr, nullptr}; pg8::StaticOrder S; S.init(MP, DM, FF / 2, F.G, (int)blockIdx.x, 2);
        pg8::EpiResid<1, 1> E{VF, nullptr, ln_g, ln_b, PART, (const float*)(F.ctl + CW_CMAX2), args.in[0]}; pg8::gemm_phase<pg8::EpiResid<1, 1>>(F.lds, g, S, E); } SEAM(2);
    if (IN(3)) { ln_mix_pass(F, args, ln_g + 0 * DM, ln_b + 0 * DM, 0.5f, 2); } SEAM(3);
    if (IN(4)) REP(4) { pg8::Gemm g{XBB, (const bf16*)(ws + WS_WCAT), MP, NCAT, KCAT, DM, (const bf16*)(ws + WS_MIX2), (const bf16*)(ws + WS_MIX3), XBA}; pg8::StaticOrder S; S.init(MP, NCAT, KCAT, F.G, (int)blockIdx.x, 0);
        pg8::EpiRwkv E{(bf16*)(dob + DO_R), (float*)(dob + DO_Z)}; pg8::gemm_phase<pg8::EpiRwkv>(F.lds, g, S, E); } SEAM(4);
    if (IN(5)) { lora_hidden_pass(F, args); } SEAM(5);
    if (IN(6)) { pg8::Gemm g{(const bf16*)(ws + WS_L), (const bf16*)(ws + WS_WL2), MP, NL2, KL2, KL2, nullptr, nullptr, nullptr}; pg8::StaticOrder S; S.init(MP, NL2, KL2, F.G, (int)blockIdx.x, 0, 1);
        pg8::EpiLora2 E{(bf16*)(dob + DO_WLD), XBB, args.in[12], args.in[15]}; pg8::gemm_phase<pg8::EpiLora2>(F.lds, g, S, E); } SEAM(6);
    if (IN(7)) REP(7) {
        const int abl = (MK_DUP == 7 && rep_ == 0) ? MK_ABL : 0;
        for (int u = F.vcu; u < 512; u += F.G) { const int samp = u >= 256, bh = u & 255; scan_unit(F, args, samp, bh >> 5, bh & 31, abl); }
    } SEAM(7);
    if (IN(8)) { RESID_GEMM(XBA, WS_WOR, DM, 0, 0, (const float*)nullptr); } SEAM(8);
    if (IN(9)) { LN_PASS(1, 0, 1.0f, (bf16*)nullptr, 0, 1, 4); } SEAM(9);
    if (IN(10)) { FFN_G1(1); } SEAM(10);
    if (IN(11)) { RESID_GEMM(HB, WS_WOUT + 1 * WOUT_STRIDE, FF, 1, 1, (const float*)(F.ctl + CW_CMAX2) + 1 * DM); } SEAM(11);
    if (IN(12)) { LN_PASS(2, 1, 0.5f, XBA, 0, 1, 2); } SEAM(12);
    if (IN(13)) { FFN_G1(2); } SEAM(13);
    if (IN(14)) { RESID_GEMM(HB, WS_WOUT + 2 * WOUT_STRIDE, FF, 2, 1, (const float*)(F.ctl + CW_CMAX2) + 2 * DM); } SEAM(14);
    if (IN(15)) { LN_PASS(3, 2, 0.5f, XBB, 0, 0, 2); cache_convert(F, args); } SEAM(15);
    if (IN(16)) { pg8::Gemm g{XBA, (const bf16*)(ws + WS_WKV), MP, 3 * DM, DM, DM, XBA, XBB, XBB}; pg8::StaticOrder S; S.init(MP, 3 * DM, DM, F.G, (int)blockIdx.x, 0);
        pg8::EpiKVQ E{args.out, (bf16*)(ws + WS_KB), (bf16*)(dob + DO_Q)}; pg8::gemm_phase<pg8::EpiKVQ>(F.lds, g, S, E); } SEAM(16);
    if (IN(17)) REP(17) {
        const int abl = (MK_DUP == 17 && rep_ == 0) ? MK_ABL : 0;
        const float l0 = args.in[28][F.lane] * args.in[28][64 + F.lane], l1 = args.in[28][128 + F.lane] * args.in[28][192 + F.lane];
        const float lam = __expf(wave_sum(l0)) - __expf(wave_sum(l1)) + LAMBDA_INIT;
        for (int i = 0; i < 8; ++i) { const int pidx = F.vcu + F.G * i; if (pidx >= 2048) break; const int bhp = pidx >> 4, us = pidx & 15, b = bhp >> 4, hp = bhp & 15;
#pragma unroll 1
            for (int k = 0; k < 2; ++k) { const int uq = k ? 31 - us : us;
                attn_unit(F, args, b * RS + 1 + uq * 128, b * T, hp, 2 * uq + 1, 1, 2 * uq + 2, 1 << 30, 4, 32, lam, abl); } }
        for (int u = F.vcu; u < 128; u += F.G) { const int b = u >> 4, hp = u & 15;
            attn_unit(F, args, SROW0 + b * SRS + 1, NB * T + b * KVS, hp, 17, 0, 17, KVS, 1, 16, lam, abl); }
    } SEAM(17);
    if (IN(18)) { RESID_GEMM(XBB, WS_WOD, DM, 3, 0, (const float*)nullptr); } SEAM(18);
    if (IN(19)) { LN_PASS(4, 3, 1.0f, (bf16*)nullptr, 0, 1, 4); } SEAM(19);
    if (IN(20)) { FFN_G1(3); } SEAM(20);
    if (IN(21)) { RESID_GEMM(HB, WS_WOUT + 3 * WOUT_STRIDE, FF, 4, 1, (const float*)(F.ctl + CW_CMAX2) + 3 * DM); } SEAM(21);
    if (IN(22)) REP(22) { LN_PASS(5, 4, 0.5f, XBA, 1, 0, 2); }
#undef IN
#undef SEAM
#undef REP
}

extern "C" void kernel_launch(void* const* d_in, const int* in_sizes, int n_in, void* d_out, int out_size, void* d_ws, size_t ws_size, hipStream_t stream) {
    static int grid = 0;
    if (grid == 0) {
        if (n_in != 31 || (size_t)out_size != O_TOTAL || ws_size < WS_END) { fprintf(stderr, "kernel_launch: unexpected sizes n_in %d out %d ws %zu\n", n_in, out_size, ws_size); grid = -1; return; }
        int dev = 0, cus = 0, per_cu = 0;
        if (hipGetDevice(&dev) != hipSuccess || hipDeviceGetAttribute(&cus, hipDeviceAttributeMultiprocessorCount, dev) != hipSuccess) { grid = -1; return; }
        if (hipFuncSetAttribute((const void*)mk_fwd, hipFuncAttributeMaxDynamicSharedMemorySize, LDS_BYTES) != hipSuccess) { fprintf(stderr, "kernel_launch: hipFuncSetAttribute failed\n"); grid = -1; return; }
        if (hipOccupancyMaxActiveBlocksPerMultiprocessor(&per_cu, (const void*)mk_fwd, NWAVES * 64, LDS_BYTES) != hipSuccess || per_cu < 1) { fprintf(stderr, "kernel_launch: occupancy query says %d\n", per_cu); }
        (void)hipGetLastError();
        grid = cus;
    }
    if (grid < 0) return;
    (void)hipMemsetAsync((char*)d_ws + WS_CTL, 0, CTL_ZERO_BYTES, stream);
    Args a{};
    for (int i = 0; i < 31; ++i) a.in[i] = (const float*)d_in[i];
    a.out = (float*)d_out; a.ws = (unsigned char*)d_ws;
#if MK_SINGLE
    a.ph_lo = 0; a.ph_hi = NPHASE;
    hipLaunchKernelGGL(mk_fwd, dim3(grid), dim3(NWAVES * 64), LDS_BYTES, stream, a);
#else
    for (int p = 0; p < NPHASE; ++p) { a.ph_lo = p; a.ph_hi = p + 1; hipLaunchKernelGGL(mk_fwd, dim3(grid), dim3(NWAVES * 64), LDS_BYTES, stream, a); }
#endif
}
```
